# Optimizing an MI355X kernel written in HIP

```python
import jax, jax.numpy as jnp
from jax import lax
import numpy as np

D_MODEL = 1024
BATCH = 16
SEQ = 2048
DEPTH = 1

N_MEM = 256
GRID_W = 64
HEAD_DIM = 64
N_Q_HEADS = D_MODEL // 128
N_KV_HEADS = N_Q_HEADS // 4
Q_PER_KV = N_Q_HEADS // N_KV_HEADS
ATTN_WIDTH = N_Q_HEADS * HEAD_DIM
KV_WIDTH = N_KV_HEADS * HEAD_DIM
POOL_WINDOWS = (2, 4, 8, 16)
N_POOL_GROUPS = len(POOL_WINDOWS)
POOL_WIDTH = D_MODEL // 2
POOL_GROUP = POOL_WIDTH // N_POOL_GROUPS
N_BRANCHES = 2
IN_WIDTH = ATTN_WIDTH + 2 * KV_WIDTH + POOL_WIDTH + N_BRANCHES * D_MODEL
Q_BLOCK = 128
ROPE_THETA = 10000.0
ROPE_AXIS_DIM = HEAD_DIM // 2
ROPE_FREQS = ROPE_AXIS_DIM // 2
N_X_HEADS = 4
X_HEAD_DIM = D_MODEL // N_X_HEADS
D_FF = 4 * D_MODEL
EPS = 1e-6

kernel_name = "hybrid_gqa_pool_memory_encoder"


def rmsnorm(x, g):
    xf = x.astype(jnp.float32)
    y = xf * lax.rsqrt(jnp.mean(xf * xf, axis=-1, keepdims=True) + EPS)
    return (y * g.astype(jnp.float32)).astype(x.dtype)


def axial_rope_tables(seq_len):
    rows = seq_len // GRID_W
    row = jnp.repeat(jnp.arange(rows), GRID_W)
    col = jnp.tile(jnp.arange(GRID_W), rows)
    inv = ROPE_THETA ** (-jnp.arange(0, ROPE_AXIS_DIM, 2, dtype=jnp.float32) / ROPE_AXIS_DIM)
    ang = jnp.stack([row, col], axis=1).astype(jnp.float32)[:, :, None] * inv
    return jnp.cos(ang)[:, None, :, None, :], jnp.sin(ang)[:, None, :, None, :]


def apply_rope(x, cos, sin):
    b, s, h, _ = x.shape
    xr = x.reshape(b, s, h, 2, 2, ROPE_FREQS).astype(jnp.float32)
    rot = jnp.stack([-xr[..., 1, :], xr[..., 0, :]], axis=-2)
    return (xr * cos + rot * sin).reshape(x.shape).astype(x.dtype)


def gqa_block_attention(q, k, v):
    b, s, kvh, g, hd = q.shape
    nb = s // Q_BLOCK
    qb = q.reshape(b, nb, Q_BLOCK, kvh, g, hd).transpose(1, 0, 2, 3, 4, 5)
    scale = HEAD_DIM ** -0.5

    def one_block(q_blk):
        sc = jnp.einsum('bqkgd,bskd->bkgqs', q_blk, k).astype(jnp.float32) * scale
        p = jax.nn.softmax(sc, axis=-1).astype(v.dtype)
        return jnp.einsum('bkgqs,bskd->bqkgd', p, v)

    o = lax.map(one_block, qb)
    return o.transpose(1, 0, 2, 3, 4, 5).reshape(b, s, kvh * g * hd)


def multiscale_pool(u):
    b, s, ng, c = u.shape
    uf = u.astype(jnp.float32)
    csum = jnp.concatenate([jnp.zeros((b, 1, ng, c), jnp.float32), jnp.cumsum(uf, axis=1)], axis=1)
    t = jnp.arange(s)
    outs = []
    for gi, w in enumerate(POOL_WINDOWS):
        lo = jnp.clip(t - w // 2, 0, s)
        hi = jnp.clip(t + (w - w // 2), 0, s)
        win_sum = csum[:, hi, gi] - csum[:, lo, gi]
        cnt = (hi - lo).astype(jnp.float32)[None, :, None]
        outs.append(win_sum / cnt - uf[:, :, gi])
    return jnp.stack(outs, axis=2).astype(u.dtype)


def setup_inputs(seed: int = 0) -> dict:
    key = jax.random.key(seed)
    ks = jax.random.split(key, 24)
    f32 = jnp.float32

    def w(k, shape, fan_in):
        return jax.random.normal(k, shape, f32) * (fan_in ** -0.5)

    def gain(k, shape):
        return 1.0 + 0.02 * jax.random.normal(k, shape, f32)

    L = DEPTH
    return {
        "x": jax.random.normal(ks[0], (BATCH, SEQ, D_MODEL), f32),
        "mem": jax.random.normal(ks[1], (BATCH, N_MEM, D_MODEL), f32),
        "g_mix": gain(ks[2], (L, D_MODEL)),
        "w_in": w(ks[3], (L, D_MODEL, IN_WIDTH), D_MODEL),
        "b_gate": 0.01 * jax.random.normal(ks[4], (L, N_BRANCHES * D_MODEL), f32),
        "g_q": gain(ks[5], (L, HEAD_DIM)),
        "g_k": gain(ks[6], (L, HEAD_DIM)),
        "w_attn_up": w(ks[7], (L, ATTN_WIDTH, D_MODEL), ATTN_WIDTH),
        "pool_w": w(ks[8], (L, N_POOL_GROUPS, POOL_GROUP, POOL_GROUP), POOL_GROUP),
        "pool_scale": gain(ks[9], (L, POOL_WIDTH)),
        "w_pool_up": w(ks[10], (L, POOL_WIDTH, D_MODEL), POOL_WIDTH),
        "w_out": w(ks[11], (L, D_MODEL, D_MODEL), D_MODEL),
        "g_cross": gain(ks[12], (L, D_MODEL)),
        "g_mem": gain(ks[13], (L, D_MODEL)),
        "w_xq": w(ks[14], (L, D_MODEL, D_MODEL), D_MODEL),
        "w_xkv": w(ks[15], (L, D_MODEL, 2 * D_MODEL), D_MODEL),
        "w_xo": w(ks[16], (L, D_MODEL, D_MODEL), D_MODEL),
        "g_ffn": gain(ks[17], (L, D_MODEL)),
        "w_ff1": w(ks[18], (L, D_MODEL, D_FF), D_MODEL),
        "w_ff2": w(ks[19], (L, D_FF, D_MODEL), D_FF),
        "g_final": gain(ks[20], (D_MODEL,)),
    }


def reference(x, mem, g_mix, w_in, b_gate, g_q, g_k, w_attn_up, pool_w, pool_scale, w_pool_up,
              w_out, g_cross, g_mem, w_xq, w_xkv, w_xo, g_ffn, w_ff1, w_ff2, g_final):
    b, s, d = x.shape
    m_len = mem.shape[1]
    cos, sin = axial_rope_tables(s)
    h = x
    for l in range(DEPTH):
        n1 = rmsnorm(h, g_mix[l])
        proj = n1 @ w_in[l]
        q, k, v, u, gates = jnp.split(
            proj,
            np.cumsum([ATTN_WIDTH, KV_WIDTH, KV_WIDTH, POOL_WIDTH]).tolist(),
            axis=-1)
        q = rmsnorm(q.reshape(b, s, N_Q_HEADS, HEAD_DIM), g_q[l])
        k = rmsnorm(k.reshape(b, s, N_KV_HEADS, HEAD_DIM), g_k[l])
        q = apply_rope(q, cos, sin).reshape(b, s, N_KV_HEADS, Q_PER_KV, HEAD_DIM)
        k = apply_rope(k, cos, sin)
        v = v.reshape(b, s, N_KV_HEADS, HEAD_DIM)
        a = gqa_block_attention(q, k, v) @ w_attn_up[l]
        pooled = multiscale_pool(u.reshape(b, s, N_POOL_GROUPS, POOL_GROUP))
        pm = jnp.einsum('bsgc,gcd->bsgd', pooled, pool_w[l]).reshape(b, s, POOL_WIDTH)
        p = (pm * pool_scale[l]) @ w_pool_up[l]
        gt = jax.nn.sigmoid(gates + b_gate[l])
        g_a, g_p = jnp.split(gt, 2, axis=-1)
        h = h + (g_a * a + g_p * p) @ w_out[l]

        n2 = rmsnorm(h, g_cross[l])
        mn = rmsnorm(mem, g_mem[l])
        xq = (n2 @ w_xq[l]).reshape(b, s, N_X_HEADS, X_HEAD_DIM)
        xk, xv = jnp.split((mn @ w_xkv[l]).reshape(b, m_len, 2, N_X_HEADS, X_HEAD_DIM), 2, axis=2)
        xk, xv = xk[:, :, 0], xv[:, :, 0]
        sc = jnp.einsum('bshd,bmhd->bhsm', xq, xk).astype(jnp.float32) * (X_HEAD_DIM ** -0.5)
        pr = jax.nn.softmax(sc, axis=-1).astype(xv.dtype)
        xo = jnp.einsum('bhsm,bmhd->bshd', pr, xv).reshape(b, s, d)
        h = h + xo @ w_xo[l]

        n3 = rmsnorm(h, g_ffn[l])
        h = h + jnp.square(jax.nn.relu(n3 @ w_ff1[l])) @ w_ff2[l]
    return rmsnorm(h, g_final)
```

```cpp
#include <hip/hip_runtime.h>
#include <hip/hip_cooperative_groups.h>
#include <hip/hip_bf16.h>
#include <cstdio>
#include <cstdint>
#include <cmath>
namespace cg = cooperative_groups;

#ifndef MK_PER_PHASE
#define MK_PER_PHASE 0
#endif

constexpr int DM = 1024, NB = 16, SEQ = 2048, TOK = NB * SEQ, NMEM = 256, MTOK = NB * NMEM;
constexpr int INW = 3328, DFF = 4096;
constexpr float EPS = 1e-6f;
constexpr float LOG2E = 1.4426950408889634f;
constexpr float QSCALE = 0.125f * LOG2E;
constexpr float XSCALE = 0.0625f * LOG2E;

namespace pg8 {
#define PG8_LAS __attribute__((address_space(3)))
typedef unsigned short bf16_t;
typedef short bf16x8 __attribute__((ext_vector_type(8)));
typedef float f32x4 __attribute__((ext_vector_type(4)));
typedef float f32x2 __attribute__((ext_vector_type(2)));
typedef unsigned u32x4 __attribute__((ext_vector_type(4)));
typedef unsigned u32x2 __attribute__((ext_vector_type(2)));
typedef __bf16 bf16x2_t __attribute__((ext_vector_type(2)));
constexpr int BM = 256, BK = 64, HALF = 128, HTB = HALF * BK * 2, STAGE_BYTES = 8 * HTB, NXCD = 8, WGM = 8;

__host__ __device__ __forceinline__ int lds_byte(int r, int c) { const int st = (r >> 4) * 2 + (c >> 5), rr = r & 15, cc = c & 31, ob = rr * 64 + cc * 2; return st * 1024 + (ob ^ (((ob >> 9) & 1) << 5)); }
__host__ __device__ __forceinline__ void stage_rc(int b, int& R, int& C) { const int st = b / 1024, sb = b % 1024, swz = sb ^ (((sb >> 9) & 1) << 5); R = (st >> 1) * 16 + swz / 64; C = (st & 1) * 32 + (swz % 64) / 2; }
__host__ __device__ __forceinline__ int perm32(int rho) { const int n = rho >> 4, i = rho & 15; return 8 * (i >> 2) + 4 * n + (i & 3); }

struct Unit { int pm, pn, id; };
#define PG8_OPAQUE(x) asm volatile("" : "+v"(x))

__device__ __forceinline__ unsigned pk_bf16(float lo, float hi) { f32x2 v = {lo, hi}; bf16x2_t b = __builtin_convertvector(v, bf16x2_t); return __builtin_bit_cast(unsigned, b); }
__device__ __forceinline__ float bf_lo(unsigned w) { return __uint_as_float(w << 16); }
__device__ __forceinline__ float bf_hi(unsigned w) { return __uint_as_float(w & 0xffff0000u); }
#define PG8_FENCE() asm volatile("" ::: "memory")

__device__ __forceinline__ void remap_tile(int wgid, int nM, int nN, int& pm, int& pn) {
    const int nwg = nM * nN;
    { const int q = nwg / NXCD, r = nwg % NXCD, xcd = wgid % NXCD, off = wgid / NXCD; wgid = (xcd < r ? xcd * (q + 1) : r * (q + 1) + (xcd - r) * q) + off; }
    const int nig = WGM * nN, gid = wgid / nig, fm = gid * WGM, gsz = (nM - fm) < WGM ? (nM - fm) : WGM;
    pm = fm + ((wgid % nig) % gsz); pn = (wgid % nig) / gsz;
}

struct ProbMN {
    const bf16_t* A; const bf16_t* B; int nM, nN, G, c; int K, lda, ldb, mid; long a_pm, a_pn, b_pb, b_pn;
    __device__ __forceinline__ bool next(int i, Unit& u) const {
        const long L = (long)i * G + c; if (L >= (long)nM * nN) return false;
        remap_tile((int)L, nM, nN, u.pm, u.pn); u.id = 0; return true; }
    __device__ __forceinline__ const char* aptr(const Unit& u) const { return (const char*)(A + (size_t)u.pm * a_pm + (size_t)u.pn * a_pn); }
    __device__ __forceinline__ const char* bptr(const Unit& u) const { return (const char*)(B + (size_t)(u.pm >> 3) * b_pb + (size_t)u.pn * b_pn); }
};
__device__ __forceinline__ ProbMN make_plain(const bf16_t* A, const bf16_t* Bt, int M, int N, int K, int G, int c) {
    ProbMN p; p.A = A; p.B = Bt; p.nM = M / BM; p.nN = N / BM; p.G = G; p.c = c; p.K = K; p.lda = K; p.ldb = K; p.mid = -1;
    p.a_pm = (long)BM * K; p.a_pn = 0; p.b_pb = 0; p.b_pn = (long)BM * K; return p; }

template <long OFF_N1, long OFF_WIN, long OFF_MN, long OFF_WXKV> struct ProbP1 {
    const char* ws; int G, c; int K, lda, ldb, mid;
    static constexpr int NPROJ = 128 * 13, NXK = 64, NXV = 64;
    __device__ __forceinline__ bool next(int i, Unit& u) const {
        const int L = i * G + c; if (L >= NPROJ + NXK + NXV) return false;
        if (L < NPROJ) { remap_tile(L, 128, 13, u.pm, u.pn); u.id = 0; }
        else if (L < NPROJ + NXK) { const int e = L - NPROJ; u.pm = e >> 2; u.pn = e & 3; u.id = 1; }
        else { const int e = L - NPROJ - NXK; u.pm = e >> 4; u.pn = e & 15; u.id = 2; }
        return true; }
    __device__ __forceinline__ const char* aptr(const Unit& u) const {
        const long off = u.id == 0 ? OFF_N1 : (u.id == 1 ? OFF_MN : OFF_WXKV + 1024L * 1024 * 2); return ws + off + (long)u.pm * (256 * 1024 * 2); }
    __device__ __forceinline__ const char* bptr(const Unit& u) const {
        const long off = u.id == 0 ? OFF_WIN : (u.id == 1 ? OFF_WXKV : OFF_MN); return ws + off + (long)u.pn * (256 * 1024 * 2); }
};

typedef f32x4 Acc[2][2][4][2];

__device__ __forceinline__ void store_tile_bf16_np(const Acc& acc, bf16_t* base, int ldc, int wr, int wc, int fr, int fq) {
#pragma unroll
    for (int ai = 0; ai < 2; ++ai)
#pragma unroll
        for (int m = 0; m < 4; ++m) { bf16_t* rowp = base + (size_t)(ai * HALF + wr * 64 + m * 16 + fr) * ldc + wc * 32 + 4 * fq;
#pragma unroll
            for (int bj = 0; bj < 2; ++bj)
#pragma unroll
                for (int n = 0; n < 2; ++n) { const f32x4 v = acc[ai][bj][m][n]; u32x2 w; w.x = pk_bf16(v[0], v[1]); w.y = pk_bf16(v[2], v[3]); *(u32x2*)(rowp + bj * HALF + n * 16) = w; } }
}

struct EpiP1 {
    static constexpr bool PERM = false, AFTER_DRAIN = false, HAS_MID = false;
    bf16_t *Q, *Kb, *Vb, *U, *Gt, *XK, *XVT; const float *bgate, *gq, *gk, *rope;
    __device__ __forceinline__ void mid(Acc&, const Unit&, int, int, int, int) const {}
    __device__ __forceinline__ void qk_rope(Acc& acc, const Unit& u, int wr, int wc, int fr, int fq, PG8_LAS float* xch, int wid, int bj, const float* gain, float oscale, bf16_t* out, int ldo, int ocol0) const {
#pragma unroll
        for (int ai = 0; ai < 2; ++ai)
#pragma unroll
            for (int m = 0; m < 4; ++m) {
                const f32x4 a = acc[ai][bj][m][0], b = acc[ai][bj][m][1];
                float s = (a[0] * a[0] + a[1] * a[1]) + (a[2] * a[2] + a[3] * a[3]) + (b[0] * b[0] + b[1] * b[1]) + (b[2] * b[2] + b[3] * b[3]);
                s += __shfl_xor(s, 16); s += __shfl_xor(s, 32);
                if (fq == 0) xch[wid * 128 + (ai * 4 + m) * 16 + fr] = s;
            }
        asm volatile("s_waitcnt lgkmcnt(0)" ::: "memory"); __builtin_amdgcn_s_barrier(); PG8_FENCE();
        const int axis = wc & 1;
        const int d0 = axis * 32 + 4 * fq;
        const f32x4 g0 = *(const f32x4*)(gain + d0), g1 = *(const f32x4*)(gain + d0 + 16);
        const int gridrow0 = (u.pm & 7) * 4 + wr;
#pragma unroll
        for (int ai = 0; ai < 2; ++ai)
#pragma unroll
            for (int m = 0; m < 4; ++m) {
                const int xi = (ai * 4 + m) * 16 + fr;
                const float tot = xch[wid * 128 + xi] + xch[(wid ^ 1) * 128 + xi];
                const float rs = __builtin_amdgcn_rsqf(tot * (1.0f / 64.0f) + EPS) ;
                const int pos = axis ? (m * 16 + fr) : (gridrow0 + 2 * ai);
                const f32x4 cs = *(const f32x4*)(rope + pos * 16 + 4 * fq), sn = *(const f32x4*)(rope + 1024 + pos * 16 + 4 * fq);
                const f32x4 x0 = acc[ai][bj][m][0] * rs * g0, x1 = acc[ai][bj][m][1] * rs * g1;
                const f32x4 y0 = (x0 * cs - x1 * sn) * oscale, y1 = (x1 * cs + x0 * sn) * oscale;
                bf16_t* rowp = out + (size_t)(u.pm * BM + ai * HALF + wr * 64 + m * 16 + fr) * ldo + ocol0 + wc * 32 + 4 * fq;
                u32x2 w0, w1; w0.x = pk_bf16(y0[0], y0[1]); w0.y = pk_bf16(y0[2], y0[3]); w1.x = pk_bf16(y1[0], y1[1]); w1.y = pk_bf16(y1[2], y1[3]);
                *(u32x2*)(rowp) = w0; *(u32x2*)(rowp + 16) = w1;
                PG8_FENCE();
            }
        asm volatile("s_waitcnt lgkmcnt(0)" ::: "memory"); __builtin_amdgcn_s_barrier(); PG8_FENCE();
    }
    __device__ __forceinline__ void operator()(Acc& acc, const Unit& u, int wr, int wc, int fr, int fq, PG8_LAS float* xch, int wid) const { PG8_OPAQUE(fr);
        if (u.id == 0) {
            if (u.pn < 2) {
                qk_rope(acc, u, wr, wc, fr, fq, xch, wid, 0, gq, QSCALE, Q, 512, u.pn * 256);
                qk_rope(acc, u, wr, wc, fr, fq, xch, wid, 1, gq, QSCALE, Q, 512, u.pn * 256 + 128);
            } else if (u.pn == 2) {
                qk_rope(acc, u, wr, wc, fr, fq, xch, wid, 0, gk, 1.0f, Kb, 128, 0);
#pragma unroll
                for (int ai = 0; ai < 2; ++ai)
#pragma unroll
                    for (int m = 0; m < 4; ++m) { bf16_t* rowp = Vb + (size_t)(u.pm * BM + ai * HALF + wr * 64 + m * 16 + fr) * 128 + wc * 32 + 4 * fq;
#pragma unroll
                        for (int n = 0; n < 2; ++n) { const f32x4 v = acc[ai][1][m][n]; u32x2 w; w.x = pk_bf16(v[0], v[1]); w.y = pk_bf16(v[2], v[3]); *(u32x2*)(rowp + n * 16) = w; } }
            } else if (u.pn < 5) {
                store_tile_bf16_np(acc, U + (size_t)u.pm * BM * 512 + (u.pn - 3) * 256, 512, wr, wc, fr, fq);
            } else {
                const int gc0 = (u.pn - 5) * 256 + wc * 32 + 4 * fq;
                f32x4 bv[2][2];
#pragma unroll
                for (int bj = 0; bj < 2; ++bj)
#pragma unroll
                    for (int n = 0; n < 2; ++n) bv[bj][n] = *(const f32x4*)(bgate + gc0 + bj * HALF + n * 16);
#pragma unroll
                for (int ai = 0; ai < 2; ++ai)
#pragma unroll
                    for (int m = 0; m < 4; ++m) { bf16_t* rowp = Gt + (size_t)(u.pm * BM + ai * HALF + wr * 64 + m * 16 + fr) * 2048 + gc0;
#pragma unroll
                        for (int bj = 0; bj < 2; ++bj)
#pragma unroll
                            for (int n = 0; n < 2; ++n) { f32x4 z = acc[ai][bj][m][n] + bv[bj][n]; f32x4 s;
#pragma unroll
                                for (int j = 0; j < 4; ++j) { const float zz = fminf(fmaxf(z[j], -30.f), 30.f); s[j] = __builtin_amdgcn_rcpf(1.0f + __builtin_amdgcn_exp2f(-zz * LOG2E)); }
                                u32x2 w; w.x = pk_bf16(s[0], s[1]); w.y = pk_bf16(s[2], s[3]); *(u32x2*)(rowp + bj * HALF + n * 16) = w; }
                        PG8_FENCE(); }
            }
        } else if (u.id == 1) {
            store_tile_bf16_np(acc, XK + (size_t)u.pm * BM * 1024 + u.pn * 256, 1024, wr, wc, fr, fq);
        } else {
            store_tile_bf16_np(acc, XVT + (size_t)u.pm * BM * 4096 + u.pn * 256, 4096, wr, wc, fr, fq);
        }
    }
};

struct EpiMix {
    static constexpr bool PERM = true, AFTER_DRAIN = false, HAS_MID = true;
    const bf16_t* Gt; bf16_t* MIX;
    __device__ __forceinline__ void mid(Acc& acc, const Unit& u, int wr, int wc, int fr, int fq) const { PG8_OPAQUE(fr);
#pragma unroll
        for (int ai = 0; ai < 2; ++ai)
#pragma unroll
            for (int m = 0; m < 4; ++m) { const bf16_t* grow = Gt + (size_t)(u.pm * BM + ai * HALF + wr * 64 + m * 16 + fr) * 2048 + u.pn * 256 + wc * 32 + 8 * fq;
#pragma unroll
                for (int bj = 0; bj < 2; ++bj) { const u32x4 ga = *(const u32x4*)(grow + bj * HALF), gp = *(const u32x4*)(grow + 1024 + bj * HALF);
                    f32x4 r0, r1;
                    r0[0] = bf_lo(ga.x) * __builtin_amdgcn_rcpf(bf_lo(gp.x)); r0[1] = bf_hi(ga.x) * __builtin_amdgcn_rcpf(bf_hi(gp.x));
                    r0[2] = bf_lo(ga.y) * __builtin_amdgcn_rcpf(bf_lo(gp.y)); r0[3] = bf_hi(ga.y) * __builtin_amdgcn_rcpf(bf_hi(gp.y));
                    r1[0] = bf_lo(ga.z) * __builtin_amdgcn_rcpf(bf_lo(gp.z)); r1[1] = bf_hi(ga.z) * __builtin_amdgcn_rcpf(bf_hi(gp.z));
                    r1[2] = bf_lo(ga.w) * __builtin_amdgcn_rcpf(bf_lo(gp.w)); r1[3] = bf_hi(ga.w) * __builtin_amdgcn_rcpf(bf_hi(gp.w));
                    acc[ai][bj][m][0] *= r0; acc[ai][bj][m][1] *= r1; }
                PG8_FENCE(); }
    }
    __device__ __forceinline__ void operator()(Acc& acc, const Unit& u, int wr, int wc, int fr, int fq, PG8_LAS float*, int) const { PG8_OPAQUE(fr);
#pragma unroll
        for (int ai = 0; ai < 2; ++ai)
#pragma unroll
            for (int m = 0; m < 4; ++m) { const size_t ro = (size_t)(u.pm * BM + ai * HALF + wr * 64 + m * 16 + fr); const int co = u.pn * 256 + wc * 32 + 8 * fq;
#pragma unroll
                for (int bj = 0; bj < 2; ++bj) { const u32x4 gp = *(const u32x4*)(Gt + ro * 2048 + 1024 + co + bj * HALF);
                    const f32x4 a = acc[ai][bj][m][0], b = acc[ai][bj][m][1]; u32x4 w;
                    w.x = pk_bf16(a[0] * bf_lo(gp.x), a[1] * bf_hi(gp.x)); w.y = pk_bf16(a[2] * bf_lo(gp.y), a[3] * bf_hi(gp.y));
                    w.z = pk_bf16(b[0] * bf_lo(gp.z), b[1] * bf_hi(gp.z)); w.w = pk_bf16(b[2] * bf_lo(gp.w), b[3] * bf_hi(gp.w));
                    *(u32x4*)(MIX + ro * 1024 + co + bj * HALF) = w; }
                PG8_FENCE(); }
    }
};

template <bool WRITE_HB> struct EpiRes {
    static constexpr bool PERM = false, AFTER_DRAIN = false, HAS_MID = false;
    const float* base; float* out; bf16_t* HB; float* SS;
    __device__ __forceinline__ void mid(Acc&, const Unit&, int, int, int, int) const {}
    __device__ __forceinline__ void operator()(Acc& acc, const Unit& u, int wr, int wc, int fr, int fq, PG8_LAS float*, int) const { PG8_OPAQUE(fr);
        const int col0 = u.pn * BM + wc * 32 + 4 * fq;
#pragma unroll
        for (int ai = 0; ai < 2; ++ai)
#pragma unroll
            for (int m = 0; m < 4; ++m) { const size_t row = (size_t)(u.pm * BM + ai * HALF + wr * 64 + m * 16 + fr); const size_t off = row * 1024 + col0; float ss = 0.f;
#pragma unroll
                for (int bj = 0; bj < 2; ++bj)
#pragma unroll
                    for (int n = 0; n < 2; ++n) { const f32x4 bs = *(const f32x4*)(base + off + bj * HALF + n * 16); const f32x4 h = bs + acc[ai][bj][m][n];
                        *(f32x4*)(out + off + bj * HALF + n * 16) = h; ss += (h[0] * h[0] + h[1] * h[1]) + (h[2] * h[2] + h[3] * h[3]);
                        if (WRITE_HB) { u32x2 w; w.x = pk_bf16(h[0], h[1]); w.y = pk_bf16(h[2], h[3]); *(u32x2*)(HB + off + bj * HALF + n * 16) = w; } }
                ss += __shfl_xor(ss, 16); ss += __shfl_xor(ss, 32);
                if (fq == 0) SS[row * 16 + u.pn * 4 + wc] = ss;
                PG8_FENCE(); }
    }
};

template <int ACT> struct EpiRowScale {
    static constexpr bool PERM = true, AFTER_DRAIN = false, HAS_MID = false;
    const float* SS; bf16_t* O; int ldc; float scale;
    __device__ __forceinline__ void mid(Acc&, const Unit&, int, int, int, int) const {}
    __device__ __forceinline__ void operator()(Acc& acc, const Unit& u, int wr, int wc, int fr, int fq, PG8_LAS float*, int) const { PG8_OPAQUE(fr);
#pragma unroll
        for (int ai = 0; ai < 2; ++ai)
#pragma unroll
            for (int m = 0; m < 4; ++m) { const size_t row = (size_t)(u.pm * BM + ai * HALF + wr * 64 + m * 16 + fr);
                const f32x4 p4 = *(const f32x4*)(SS + row * 16 + 4 * fq); float s = (p4[0] + p4[1]) + (p4[2] + p4[3]); s += __shfl_xor(s, 16); s += __shfl_xor(s, 32);
                const float rs = __builtin_amdgcn_rsqf(s * (1.0f / 1024.0f) + EPS) * scale;
                bf16_t* rowp = O + row * ldc + u.pn * 256 + wc * 32 + 8 * fq;
#pragma unroll
                for (int bj = 0; bj < 2; ++bj) { f32x4 a = acc[ai][bj][m][0] * rs, b = acc[ai][bj][m][1] * rs;
                    if (ACT == 1) {
#pragma unroll
                        for (int j = 0; j < 4; ++j) { const float x = fmaxf(a[j], 0.f), y = fmaxf(b[j], 0.f); a[j] = x * x; b[j] = y * y; } }
                    u32x4 w; w.x = pk_bf16(a[0], a[1]); w.y = pk_bf16(a[2], a[3]); w.z = pk_bf16(b[0], b[1]); w.w = pk_bf16(b[2], b[3]);
                    *(u32x4*)(rowp + bj * HALF) = w; }
                PG8_FENCE(); }
    }
};

struct EpiPlain {
    static constexpr bool PERM = true, AFTER_DRAIN = false, HAS_MID = false;
    bf16_t* O; int ldc;
    __device__ __forceinline__ void mid(Acc&, const Unit&, int, int, int, int) const {}
    __device__ __forceinline__ void operator()(Acc& acc, const Unit& u, int wr, int wc, int fr, int fq, PG8_LAS float*, int) const { PG8_OPAQUE(fr);
#pragma unroll
        for (int ai = 0; ai < 2; ++ai)
#pragma unroll
            for (int m = 0; m < 4; ++m) { bf16_t* rowp = O + (size_t)(u.pm * BM + ai * HALF + wr * 64 + m * 16 + fr) * ldc + u.pn * 256 + wc * 32 + 8 * fq;
#pragma unroll
                for (int bj = 0; bj < 2; ++bj) { const f32x4 a = acc[ai][bj][m][0], b = acc[ai][bj][m][1];
                    u32x4 w; w.x = pk_bf16(a[0], a[1]); w.y = pk_bf16(a[2], a[3]); w.z = pk_bf16(b[0], b[1]); w.w = pk_bf16(b[2], b[3]);
                    *(u32x4*)(rowp + bj * HALF) = w; } }
    }
};

struct EpiSoftmax {
    static constexpr bool PERM = true, AFTER_DRAIN = false, HAS_MID = false;
    bf16_t* P;
    __device__ __forceinline__ void mid(Acc&, const Unit&, int, int, int, int) const {}
    __device__ __forceinline__ void operator()(Acc& acc, const Unit& u, int wr, int wc, int fr, int fq, PG8_LAS float* xch, int) const { PG8_OPAQUE(fr);
        PG8_LAS float* xmax = xch; PG8_LAS float* xsum = xch + 1024;
#pragma unroll
        for (int ai = 0; ai < 2; ++ai)
#pragma unroll
            for (int m = 0; m < 4; ++m) { float mx = -INFINITY;
#pragma unroll
                for (int bj = 0; bj < 2; ++bj)
#pragma unroll
                    for (int n = 0; n < 2; ++n) { const f32x4 v = acc[ai][bj][m][n]; mx = fmaxf(mx, fmaxf(fmaxf(v[0], v[1]), fmaxf(v[2], v[3]))); }
                mx = fmaxf(mx, __shfl_xor(mx, 16)); mx = fmaxf(mx, __shfl_xor(mx, 32));
                if (fq == 0) xmax[(ai * HALF + wr * 64 + m * 16 + fr) * 4 + wc] = mx; }
        asm volatile("s_waitcnt lgkmcnt(0)" ::: "memory"); __builtin_amdgcn_s_barrier(); PG8_FENCE();
#pragma unroll
        for (int ai = 0; ai < 2; ++ai)
#pragma unroll
            for (int m = 0; m < 4; ++m) { const int rl = ai * HALF + wr * 64 + m * 16 + fr; const f32x4 m4 = *(const PG8_LAS f32x4*)(xmax + rl * 4);
                const float mx = fmaxf(fmaxf(m4[0], m4[1]), fmaxf(m4[2], m4[3])); float s = 0.f;
#pragma unroll
                for (int bj = 0; bj < 2; ++bj)
#pragma unroll
                    for (int n = 0; n < 2; ++n) { f32x4 v = acc[ai][bj][m][n];
#pragma unroll
                        for (int j = 0; j < 4; ++j) { v[j] = __builtin_amdgcn_exp2f(v[j] - mx); s += v[j]; }
                        acc[ai][bj][m][n] = v; }
                s += __shfl_xor(s, 16); s += __shfl_xor(s, 32);
                if (fq == 0) xsum[rl * 4 + wc] = s; }
        asm volatile("s_waitcnt lgkmcnt(0)" ::: "memory"); __builtin_amdgcn_s_barrier(); PG8_FENCE();
#pragma unroll
        for (int ai = 0; ai < 2; ++ai)
#pragma unroll
            for (int m = 0; m < 4; ++m) { const int rl = ai * HALF + wr * 64 + m * 16 + fr; const f32x4 s4 = *(const PG8_LAS f32x4*)(xsum + rl * 4);
                const float inv = __builtin_amdgcn_rcpf((s4[0] + s4[1]) + (s4[2] + s4[3]));
                bf16_t* rowp = P + (size_t)(u.pm * BM + rl) * 1024 + u.pn * 256 + wc * 32 + 8 * fq;
#pragma unroll
                for (int bj = 0; bj < 2; ++bj) { const f32x4 a = acc[ai][bj][m][0] * inv, b = acc[ai][bj][m][1] * inv;
                    u32x4 w; w.x = pk_bf16(a[0], a[1]); w.y = pk_bf16(a[2], a[3]); w.z = pk_bf16(b[0], b[1]); w.w = pk_bf16(b[2], b[3]);
                    *(u32x4*)(rowp + bj * HALF) = w; } }
        asm volatile("s_waitcnt lgkmcnt(0)" ::: "memory"); __builtin_amdgcn_s_barrier(); PG8_FENCE();
    }
};

template <class Epi, class Sched, bool ALIGN_EPI, bool SP2>
__device__ __forceinline__ void gemm_phase(PG8_LAS unsigned char* lds, PG8_LAS float* xch, const Sched& S, const Epi& E) {
    const int tid = threadIdx.x, wid = __builtin_amdgcn_readfirstlane(tid >> 6), lane = tid & 63, wr = wid >> 2, wc = wid & 3, fr = lane & 15, fq = lane >> 4;
    const int K = S.K, nt = K / BK, lda = S.lda, ldb = S.ldb; (void)K;
    unsigned voffA[2], voffB[2];
#pragma unroll
    for (int i = 0; i < 2; ++i) { int R, C; stage_rc(tid * 16 + i * 8192, R, C); const int Rb = Epi::PERM ? ((R & ~31) + perm32(R & 31)) : R;
        voffA[i] = (unsigned)(R * lda + C) * 2u; voffB[i] = (unsigned)(Rb * ldb + C) * 2u; }
    const size_t kstep = (size_t)(BK * 2);
    const size_t hstepA = (size_t)HALF * lda * 2, hstepB = (size_t)HALF * ldb * 2;
    const unsigned ldsw = (unsigned)wid * 1024u;
    const int aoff = lds_byte(wr * 64 + fr, fq * 8), boff = lds_byte(wc * 32 + fr, fq * 8);
#define PG8_SA(b, h) (((b) * 2 + (h)) * HTB)
#define PG8_SB(b, h) ((4 + (b) * 2 + (h)) * HTB)
#define PG8_STAGE(bufoff, gbase, voff) do { _Pragma("unroll") for (int _i = 0; _i < 2; ++_i) \
        __builtin_amdgcn_global_load_lds((const unsigned*)((const char*)(gbase) + (voff)[_i]), (PG8_LAS unsigned*)(lds + (bufoff) + ldsw + _i * 8192), 16, 0, 0); } while (0)
#define PG8_LDA(dst, b, h) do { _Pragma("unroll") for (int m = 0; m < 4; ++m) _Pragma("unroll") for (int k = 0; k < 2; ++k) dst[m][k] = *(const PG8_LAS bf16x8*)(lds + PG8_SA(b, h) + aoff + m * 2048 + k * 1024); } while (0)
#define PG8_LDB(dst, b, h) do { _Pragma("unroll") for (int n = 0; n < 2; ++n) _Pragma("unroll") for (int k = 0; k < 2; ++k) dst[n][k] = *(const PG8_LAS bf16x8*)(lds + PG8_SB(b, h) + boff + n * 2048 + k * 1024); } while (0)
#define PG8_MMA(ai, bj, At, Bt) do { __builtin_amdgcn_s_setprio(1); _Pragma("unroll") for (int m = 0; m < 4; ++m) _Pragma("unroll") for (int n = 0; n < 2; ++n) _Pragma("unroll") for (int k = 0; k < 2; ++k) \
        acc[ai][bj][m][n] = __builtin_amdgcn_mfma_f32_16x16x32_bf16(Bt[n][k], At[m][k], acc[ai][bj][m][n], 0, 0, 0); __builtin_amdgcn_s_setprio(0); } while (0)
#define PG8_WAIT_V(n) asm volatile("s_waitcnt vmcnt(" #n ")" ::: "memory")
#define PG8_WAIT_L(n) asm volatile("s_waitcnt lgkmcnt(" #n ")" ::: "memory")
#define PG8_BAR __builtin_amdgcn_s_barrier()
#define PG8_SCHED __builtin_amdgcn_sched_barrier(0)
    Unit cur, nxt; int ui = 0;
    if (!S.next(0, cur)) return;
    f32x4 acc[2][2][4][2];
#pragma unroll
    for (int a = 0; a < 2; ++a)
#pragma unroll
        for (int b = 0; b < 2; ++b)
#pragma unroll
            for (int m = 0; m < 4; ++m)
#pragma unroll
                for (int n = 0; n < 2; ++n) acc[a][b][m][n] = (f32x4){0.f, 0.f, 0.f, 0.f};
    bf16x8 At[4][2], B0[2][2], B1[2][2];
    const char* cA = S.aptr(cur); const char* cB = S.bptr(cur);
    if constexpr (SP2) {
        PG8_STAGE(PG8_SB(0, 0), cB, voffB); PG8_STAGE(PG8_SB(0, 1), cB + hstepB, voffB); PG8_STAGE(PG8_SA(0, 0), cA, voffA); PG8_STAGE(PG8_SA(0, 1), cA + hstepA, voffA);
        if (wr == 1) PG8_BAR;
        PG8_WAIT_V(2); PG8_BAR;
        PG8_STAGE(PG8_SB(1, 0), cB + kstep, voffB); PG8_STAGE(PG8_SA(1, 0), cA + kstep, voffA); PG8_STAGE(PG8_SB(1, 1), cB + hstepB + kstep, voffB);
        PG8_WAIT_V(6); PG8_BAR;
    } else {
        PG8_STAGE(PG8_SB(0, 0), cB, voffB); PG8_STAGE(PG8_SA(0, 0), cA, voffA); PG8_STAGE(PG8_SB(0, 1), cB + hstepB, voffB); PG8_STAGE(PG8_SA(0, 1), cA + hstepA, voffA);
        if (wr == 1) PG8_BAR;
        PG8_WAIT_V(4); PG8_BAR;
        PG8_STAGE(PG8_SB(1, 0), cB + kstep, voffB); PG8_STAGE(PG8_SA(1, 0), cA + kstep, voffA); PG8_STAGE(PG8_SB(1, 1), cB + hstepB + kstep, voffB);
        PG8_WAIT_V(6); PG8_BAR;
    }
    for (;;) {
        const bool has_next = S.next(ui + 1, nxt);
        const char* nA = has_next ? S.aptr(nxt) : cA; const char* nB = has_next ? S.bptr(nxt) : cB;
        for (int t = 0; t < nt; t += 2) {
            const bool last = (t == nt - 2);
            const char* a1 = cA + (size_t)(t + 1) * kstep;
            const char* a2 = last ? nA : cA + (size_t)(t + 2) * kstep; const char* b2 = last ? nB : cB + (size_t)(t + 2) * kstep;
            const char* a3 = a2 + kstep; const char* b3 = b2 + kstep;
            if constexpr (Epi::HAS_MID) { if (t == S.mid) E.mid(acc, cur, wr, wc, fr, fq); }
            if constexpr (SP2) {
            PG8_LDB(B0, 0, 0); PG8_LDB(B1, 0, 1); PG8_SCHED; PG8_LDA(At, 0, 0); PG8_STAGE(PG8_SA(1, 1), a1 + hstepA, voffA);
            PG8_WAIT_V(8); PG8_WAIT_L(0); PG8_BAR; PG8_MMA(0, 0, At, B0); PG8_MMA(0, 1, At, B1); PG8_BAR; PG8_SCHED;
            PG8_LDA(At, 0, 1); PG8_STAGE(PG8_SB(0, 0), b2, voffB); PG8_STAGE(PG8_SB(0, 1), b2 + hstepB, voffB); PG8_STAGE(PG8_SA(0, 0), a2, voffA);
            PG8_WAIT_V(8); PG8_WAIT_L(0); PG8_BAR; PG8_MMA(1, 0, At, B0); PG8_MMA(1, 1, At, B1); PG8_BAR; PG8_SCHED;
            PG8_LDB(B0, 1, 0); PG8_LDB(B1, 1, 1); PG8_SCHED; PG8_LDA(At, 1, 0); PG8_STAGE(PG8_SA(0, 1), a2 + hstepA, voffA);
            PG8_WAIT_V(8); PG8_WAIT_L(0); PG8_BAR; PG8_MMA(0, 0, At, B0); PG8_MMA(0, 1, At, B1); PG8_BAR; PG8_SCHED;
            PG8_LDA(At, 1, 1); PG8_STAGE(PG8_SB(1, 0), b3, voffB); PG8_STAGE(PG8_SB(1, 1), b3 + hstepB, voffB); PG8_STAGE(PG8_SA(1, 0), a3, voffA);
            PG8_WAIT_V(8); PG8_WAIT_L(0); PG8_BAR; PG8_MMA(1, 0, At, B0); PG8_MMA(1, 1, At, B1); PG8_BAR; PG8_SCHED;
            } else {
            PG8_LDB(B0, 0, 0); PG8_SCHED; PG8_LDA(At, 0, 0); PG8_STAGE(PG8_SA(1, 1), a1 + hstepA, voffA);
            PG8_WAIT_L(8); PG8_BAR; PG8_WAIT_L(0); PG8_MMA(0, 0, At, B0); PG8_BAR; PG8_SCHED;
            PG8_LDB(B1, 0, 1); PG8_STAGE(PG8_SB(0, 0), b2, voffB);
            PG8_BAR; PG8_WAIT_L(0); PG8_MMA(0, 1, At, B1); PG8_BAR;
            PG8_LDA(At, 0, 1); PG8_STAGE(PG8_SA(0, 0), a2, voffA);
            PG8_BAR; PG8_WAIT_L(0); PG8_MMA(1, 0, At, B0); PG8_BAR; PG8_SCHED;
            PG8_STAGE(PG8_SB(0, 1), b2 + hstepB, voffB);
            PG8_WAIT_V(6); PG8_BAR; PG8_MMA(1, 1, At, B1); PG8_BAR;
            PG8_LDB(B0, 1, 0); PG8_SCHED; PG8_LDA(At, 1, 0); PG8_STAGE(PG8_SA(0, 1), a2 + hstepA, voffA);
            PG8_WAIT_L(8); PG8_BAR; PG8_WAIT_L(0); PG8_MMA(0, 0, At, B0); PG8_BAR; PG8_SCHED;
            PG8_LDB(B1, 1, 1); PG8_STAGE(PG8_SB(1, 0), b3, voffB);
            PG8_BAR; PG8_WAIT_L(0); PG8_MMA(0, 1, At, B1); PG8_BAR;
            PG8_LDA(At, 1, 1); PG8_STAGE(PG8_SA(1, 0), a3, voffA);
            PG8_BAR; PG8_WAIT_L(0); PG8_MMA(1, 0, At, B0); PG8_BAR; PG8_SCHED;
            PG8_STAGE(PG8_SB(1, 1), b3 + hstepB, voffB);
            PG8_WAIT_V(6); PG8_BAR; PG8_MMA(1, 1, At, B1); PG8_BAR;
            }
        }
        if constexpr (ALIGN_EPI) { if (wr == 0) PG8_BAR; }
        E(acc, cur, wr, wc, fr, fq, xch, wid);
        if (!has_next) break;
#pragma unroll
        for (int a = 0; a < 2; ++a)
#pragma unroll
            for (int b = 0; b < 2; ++b)
#pragma unroll
                for (int m = 0; m < 4; ++m)
#pragma unroll
                    for (int n = 0; n < 2; ++n) acc[a][b][m][n] = (f32x4){0.f, 0.f, 0.f, 0.f};
        cur = nxt; cA = nA; cB = nB; ++ui;
        if constexpr (ALIGN_EPI) { if (wr == 1) PG8_BAR; }
    }
    PG8_WAIT_V(0);
    if constexpr (!ALIGN_EPI) { if (wr == 0) PG8_BAR; }
    PG8_BAR;
#undef PG8_SA
#undef PG8_SB
#undef PG8_STAGE
#undef PG8_LDA
#undef PG8_LDB
#undef PG8_MMA
#undef PG8_WAIT_V
#undef PG8_WAIT_L
#undef PG8_BAR
#undef PG8_SCHED
}
}

#include <hip/hip_bf16.h>
#include <cmath>
namespace attn_body {
using bf16=__hip_bfloat16;
using bf16x8=__attribute__((ext_vector_type(8)))short;
using s16x4=__attribute__((ext_vector_type(4)))short;
using f32x16=__attribute__((ext_vector_type(16)))float;
using u32x4=__attribute__((ext_vector_type(4)))unsigned;
constexpr int BATCH=16,NHEAD=8,SEQ=2048,D=64,QP=512,KP=128,OP=1024;
constexpr int NW=8,QBLK=32,QB=QBLK*NW,KVBLK=64,NQB=SEQ/QB;
__device__ __forceinline__ int crow(int r,int hi){return (r&3)+8*(r>>2)+4*hi;}
#define SBAR() __builtin_amdgcn_sched_barrier(0)
__device__ __forceinline__ void cmask(f32x16&p0,f32x16&p1,int jb,int qrel,int hi){
  const float NEG=-INFINITY; int kb=64*jb+4*hi;
  #pragma unroll
  for(int r=0;r<16;++r){int kv=kb+(r&3)+8*(r>>2); if(kv>qrel)p0[r]=NEG; if(kv+32>qrel)p1[r]=NEG;}
}

constexpr int NSLOT=3, SLOTB=8192;
constexpr int LDS_K=0, LDS_V=NSLOT*SLOTB, LDS_WS=2*NSLOT*SLOTB, LDS_OST=LDS_WS+NW*64*4, LDS_BYTES=LDS_OST+NW*4096;
constexpr float C2=0.125f*1.4426950408889634f;
__device__ __forceinline__ void glds16(const void*gsrc,unsigned lds_dst){unsigned keep;
  asm volatile("s_mov_b32 %0, m0\n\ts_mov_b32 m0, %2\n\ts_nop 0\n\tglobal_load_lds_dwordx4 %1, off\n\ts_mov_b32 m0, %0":"=&s"(keep):"v"(gsrc),"s"(lds_dst):"memory");}
__device__ __forceinline__ float max3f(float a,float b,float c){float r;asm("v_max3_f32 %0, %1, %2, %3":"=v"(r):"v"(a),"v"(b),"v"(c));return r;}
__device__ __forceinline__ float max2f(float a,float b){float r;asm("v_max_f32_e32 %0, %1, %2":"=v"(r):"v"(a),"v"(b));return r;}
__device__ __forceinline__ float fadd_s(float a,float b){float r;asm("v_add_f32_e32 %0, %1, %2":"=v"(r):"v"(a),"v"(b));return r;}
__device__ __forceinline__ float fsub_s(float a,float b){float r;asm("v_sub_f32_e32 %0, %1, %2":"=v"(r):"v"(a),"v"(b));return r;}
typedef float f32x2_t __attribute__((ext_vector_type(2))); typedef __bf16 bf16x2_t __attribute__((ext_vector_type(2)));
__device__ __forceinline__ unsigned cvtpk_s(float lo,float hi){f32x2_t v={lo,hi};bf16x2_t b=__builtin_convertvector(v,bf16x2_t);return __builtin_bit_cast(unsigned,b);}
#define WAIT_BAR(N) asm volatile("s_waitcnt vmcnt(" #N ") lgkmcnt(0)\n\ts_barrier":::"memory")

__device__ __forceinline__ void qkt(f32x16&p0,f32x16&p1,const char*Kslot,const bf16x8*qr,const f32x16&negm,int r32,int hi){
  const char*kb=Kslot+hi*1024+r32*16;
  #pragma unroll
  for(int d0=0;d0<4;++d0){
    const bf16x8 b0=*reinterpret_cast<const bf16x8*>(kb+d0*2048);
    const bf16x8 b1=*reinterpret_cast<const bf16x8*>(kb+d0*2048+512);
    if(d0==0){p0=__builtin_amdgcn_mfma_f32_32x32x16_bf16(b0,qr[0],negm,0,0,0);p1=__builtin_amdgcn_mfma_f32_32x32x16_bf16(b1,qr[0],negm,0,0,0);}
    else{p0=__builtin_amdgcn_mfma_f32_32x32x16_bf16(b0,qr[d0],p0,0,0,0);p1=__builtin_amdgcn_mfma_f32_32x32x16_bf16(b1,qr[d0],p1,0,0,0);}}
}
typedef __attribute__((address_space(3))) const char* lds_cptr;
typedef short v4i16_t __attribute__((ext_vector_type(4)));
__device__ __forceinline__ void kload8(bf16x8*kf,lds_cptr kp){
  kf[0]=*(const __attribute__((address_space(3))) bf16x8*)(kp);      kf[1]=*(const __attribute__((address_space(3))) bf16x8*)(kp+512);
  kf[2]=*(const __attribute__((address_space(3))) bf16x8*)(kp+2048); kf[3]=*(const __attribute__((address_space(3))) bf16x8*)(kp+2560);
  kf[4]=*(const __attribute__((address_space(3))) bf16x8*)(kp+4096); kf[5]=*(const __attribute__((address_space(3))) bf16x8*)(kp+4608);
  kf[6]=*(const __attribute__((address_space(3))) bf16x8*)(kp+6144); kf[7]=*(const __attribute__((address_space(3))) bf16x8*)(kp+6656);
}
__device__ __forceinline__ void kload2(bf16x8*kf,lds_cptr kp,int j){ kf[2*j]=*(const __attribute__((address_space(3))) bf16x8*)(kp+j*2048); kf[2*j+1]=*(const __attribute__((address_space(3))) bf16x8*)(kp+j*2048+512); }
__device__ __forceinline__ s16x4 vtr(lds_cptr p){ return __builtin_bit_cast(s16x4,__builtin_amdgcn_ds_read_tr16_b64_v4i16((__attribute__((address_space(3))) v4i16_t*)p)); }
__device__ __forceinline__ float rowmax(const f32x16&p0,const f32x16&p1){
  float a=max3f(p0[0],p0[1],p1[0]),b=max3f(p0[2],p0[3],p1[1]);a=max3f(a,p1[2],p1[3]);
  #pragma unroll
  for(int r=4;r<16;r+=4){a=max3f(a,p0[r],p0[r+1]);b=max3f(b,p0[r+2],p0[r+3]);a=max3f(a,p1[r],p1[r+1]);b=max3f(b,p1[r+2],p1[r+3]);}
  const float m=max2f(a,b);
  auto rr=__builtin_amdgcn_permlane32_swap(__float_as_uint(m),__float_as_uint(m),false,false);
  return max2f(__uint_as_float(rr[0]),__uint_as_float(rr[1]));
}
__device__ __forceinline__ void pv(f32x16*o,int vb,bf16x8 pa0,bf16x8 pa1,bf16x8 pa2,bf16x8 pa3){
  #pragma unroll
  for(int d0=0;d0<2;++d0){s16x4 lo[4],hi[4];
    #pragma unroll
    for(int ks=0;ks<4;++ks){
      asm volatile("ds_read_b64_tr_b16 %0,%1 offset:%c2":"=&v"(lo[ks]):"v"(vb),"i"(d0*4096+ks*1024):"memory");
      asm volatile("ds_read_b64_tr_b16 %0,%1 offset:%c2":"=&v"(hi[ks]):"v"(vb),"i"(d0*4096+ks*1024+512):"memory");}
    asm volatile("s_waitcnt lgkmcnt(0)":::"memory");SBAR();
    #define PK(k) (bf16x8){lo[k][0],lo[k][1],lo[k][2],lo[k][3],hi[k][0],hi[k][1],hi[k][2],hi[k][3]}
    o[d0]=__builtin_amdgcn_mfma_f32_32x32x16_bf16(pa0,PK(0),o[d0],0,0,0);
    o[d0]=__builtin_amdgcn_mfma_f32_32x32x16_bf16(pa1,PK(1),o[d0],0,0,0);
    o[d0]=__builtin_amdgcn_mfma_f32_32x32x16_bf16(pa2,PK(2),o[d0],0,0,0);
    o[d0]=__builtin_amdgcn_mfma_f32_32x32x16_bf16(pa3,PK(3),o[d0],0,0,0);
    #undef PK
  }
}

#ifndef ATTN_STORE16
#define ATTN_STORE16(p,v) (*(u32x4*)(p)=(v))
#endif
template<int THRL> __device__ __forceinline__ void attn_unit(int b,int h,int qb,const bf16*Q,const bf16*__restrict__ K,const bf16*__restrict__ V,bf16*O,char*shm){
  const int tid=threadIdx.x,lane=tid&63,r32=lane&31,hi=lane>>5; const int wid=__builtin_amdgcn_readfirstlane(tid>>6);
  const long rowbase=(long)b*SEQ; const int q0=qb*QB;
  const bf16*Qw=Q+(rowbase+q0+wid*QBLK)*QP+h*D;
  const bf16*Kh=K+rowbase*KP+(h>>2)*D,*Vh=V+rowbase*KP+(h>>2)*D;
  const unsigned lds0=(unsigned)(uintptr_t)shm;
  float*wsf=(float*)(shm+LDS_WS)+wid*64;
  const bf16*ksrc=Kh+(long)lane*KP+wid*8;
  const bf16*vsrc=Vh+(long)(16*(wid&3)+(lane>>2))*KP+(wid>>2)*32+(lane&3)*8;
  const unsigned kdst=lds0+LDS_K+wid*1024, vdst=lds0+LDS_V+wid*1024;
  #define DMA_K(t,slot) glds16(ksrc+(long)(t)*KVBLK*KP,(unsigned)__builtin_amdgcn_readfirstlane(kdst+(slot)))
  #define DMA_V(t,slot) glds16(vsrc+(long)(t)*KVBLK*KP,(unsigned)__builtin_amdgcn_readfirstlane(vdst+(slot)))
  const int vb0=(int)(lds0+LDS_V)+((lane>>4)&1)*32+(lane&3)*8+(4*hi+((lane&15)>>2))*64;
  const char*Kbase=shm+LDS_K; bf16x8 kf[8];
  const lds_cptr shm3=(lds_cptr)shm; const lds_cptr kp0=shm3+LDS_K+hi*1024+r32*16; const lds_cptr vp0=shm3+LDS_V+((lane>>4)&1)*32+(lane&3)*8+(4*hi+((lane&15)>>2))*64;
  constexpr int NT=SEQ/KVBLK;
  DMA_K(0,0);DMA_V(0,0);DMA_K(1,SLOTB);
  bf16x8 qr[4];
  #pragma unroll
  for(int d0=0;d0<4;++d0)qr[d0]=*reinterpret_cast<const bf16x8*>(&Qw[(long)r32*QP+d0*16+hi*8]);
  float mhat=0.f,l_reg=0.f;f32x16 o[2];o[0]=f32x16{};o[1]=f32x16{};f32x16 negm=f32x16{};asm volatile("":"+v"(negm));
  #define CMASK(P0,P1,t) do{}while(0)
  bool resc=false;
  #define START(P0,P1) do{ const float rm=rowmax(P0,P1); resc=false; \
    { const float dl=rm; mhat=fadd_s(mhat,dl); \
      _Pragma("unroll") for(int r=0;r<16;++r){P0[r]=fsub_s(P0[r],dl);P1[r]=fsub_s(P1[r],dl);} \
      _Pragma("unroll") for(int r=0;r<16;++r)negm[r]=-mhat; asm volatile("":"+v"(negm)); } \
    _Pragma("unroll") for(int r=0;r<16;++r)P0[r]=__builtin_amdgcn_exp2f(P0[r]); }while(0)
  #define RESC() do{ if(resc){ asm volatile("s_waitcnt lgkmcnt(0)":::"memory"); \
      _Pragma("unroll") for(int d_=0;d_<2;++d_) _Pragma("unroll") for(int r=0;r<16;++r)o[d_][r]*=wsf[crow(r,hi)]; } }while(0)
  f32x16 pA0,pA1,pB0,pB1;
  int sl_prev=0,sl_cur=0,sl_next=SLOTB;
  #define ROT() do{sl_prev=sl_cur;sl_cur=sl_next;sl_next=(sl_next==(NSLOT-1)*SLOTB)?0:sl_next+SLOTB;}while(0)
  DMA_K(2,2*SLOTB);
  WAIT_BAR(3);
  qkt(pA0,pA1,Kbase,qr,negm,r32,hi);asm volatile("s_nop 15\n\ts_nop 7":"+v"(pA0),"+v"(pA1));CMASK(pA0,pA1,0);
  START(pA0,pA1);
  _Pragma("unroll") for(int r=0;r<16;++r)pA1[r]=__builtin_amdgcn_exp2f(pA1[r]);
  WAIT_BAR(0);
  DMA_K(3,0);DMA_V(1,SLOTB);
  ROT();
  kload8(kf,kp0+sl_cur);
  WAIT_BAR(2);
  s16x4 vlo[8],vhi[8]; u32x4 pw0,pw1,pw2,pw3;
  #define PKW(P,B) cvtpk_s(P[B],P[B+1])
  #define PAF(k) __builtin_bit_cast(bf16x8,pw##k)
  #define VFR(i) (bf16x8){vlo[i][0],vlo[i][1],vlo[i][2],vlo[i][3],vhi[i][0],vhi[i][1],vhi[i][2],vhi[i][3]}
  #define PIN(x) asm volatile("":"+v"(x))
  #define MX3(a,b,c) __builtin_fmaxf(__builtin_fmaxf((a),(b)),(c))
  #define GAPA(MF,A0,A1,A2,A3,W0,W1,PW) do{ MF; sacc+=A0; sacc+=A1; sacc+=A2; sacc+=A3; PIN(sacc); W0; W1; PIN(PW); SBAR(); }while(0)
  #define EX(v) __builtin_amdgcn_exp2f(v)
  #define GAPB(MF,X,B) do{ MF; X[B]=EX(X[B]); X[B+1]=EX(X[B+1]); X[B+2]=EX(X[B+2]); X[B+3]=EX(X[B+3]); PIN(X); SBAR(); }while(0)
  #define VRD(i) do{ vlo[i]=vtr(vp_+(((i)>>2)*4096+((i)&3)*1024)); vhi[i]=vtr(vp_+(((i)>>2)*4096+((i)&3)*1024+512)); }while(0)
  #define KRD(G,j) do{ if(G){ kload2(kf,kp0+sl_next,j); SBAR(); } }while(0)
  #define STEP(C0,C1,P0,P1,t,GK,GV,GL) do{ SBAR(); \
    const lds_cptr vp_=vp0+sl_prev; \
    VRD(0); SBAR(); float sacc=(P0[0]+P0[1]); \
    GAPA(C0=__builtin_amdgcn_mfma_f32_32x32x16_bf16(kf[0],qr[0],negm,0,0,0), P0[2],P0[3],P0[4],P0[5],     pw0[0]=PKW(P0,0), pw0[1]=PKW(P0,2), pw0); \
    VRD(4); SBAR(); GAPA(C1=__builtin_amdgcn_mfma_f32_32x32x16_bf16(kf[1],qr[0],negm,0,0,0), P0[6],P0[7],P0[8],P0[9],     pw0[2]=PKW(P0,4), pw0[3]=PKW(P0,6), pw0); \
    VRD(1); SBAR(); GAPA(C0=__builtin_amdgcn_mfma_f32_32x32x16_bf16(kf[2],qr[1],C0,0,0,0),   P0[10],P0[11],P0[12],P0[13], pw1[0]=PKW(P0,8), pw1[1]=PKW(P0,10), pw1); \
    VRD(5); SBAR(); GAPA(C1=__builtin_amdgcn_mfma_f32_32x32x16_bf16(kf[3],qr[1],C1,0,0,0),   P0[14],P0[15],P1[0],P1[1],   pw1[2]=PKW(P0,12),pw1[3]=PKW(P0,14), pw1); \
    VRD(2); SBAR(); GAPA(C0=__builtin_amdgcn_mfma_f32_32x32x16_bf16(kf[4],qr[2],C0,0,0,0),   P1[2],P1[3],P1[4],P1[5],     pw2[0]=PKW(P1,0), pw2[1]=PKW(P1,2), pw2); \
    VRD(6); SBAR(); GAPA(C1=__builtin_amdgcn_mfma_f32_32x32x16_bf16(kf[5],qr[2],C1,0,0,0),   P1[6],P1[7],P1[8],P1[9],     pw2[2]=PKW(P1,4), pw2[3]=PKW(P1,6), pw2); \
    VRD(3); SBAR(); GAPA(C0=__builtin_amdgcn_mfma_f32_32x32x16_bf16(kf[6],qr[3],C0,0,0,0),   P1[10],P1[11],P1[12],P1[13], pw3[0]=PKW(P1,8), pw3[1]=PKW(P1,10), pw3); \
    VRD(7); SBAR(); GAPA(C1=__builtin_amdgcn_mfma_f32_32x32x16_bf16(kf[7],qr[3],C1,0,0,0),   P1[14],P1[15],0.f,0.f,       pw3[2]=PKW(P1,12),pw3[3]=PKW(P1,14), pw3); \
    l_reg+=sacc; \
    if(GK){DMA_K((t)+3,sl_cur);} if(GV){DMA_V((t)+1,sl_next);} \
    CMASK(C0,C1,t); \
    { float a=MX3(C0[0],C0[1],C1[0]),b=MX3(C0[2],C0[3],C1[1]); a=MX3(a,C1[2],C1[3]); \
      _Pragma("unroll") for(int r=4;r<16;r+=4){a=MX3(a,C0[r],C0[r+1]);b=MX3(b,C0[r+2],C0[r+3]);a=MX3(a,C1[r],C1[r+1]);b=MX3(b,C1[r+2],C1[r+3]);} \
      float rm=__builtin_fmaxf(a,b); { auto rr=__builtin_amdgcn_permlane32_swap(__float_as_uint(rm),__float_as_uint(rm),false,false); rm=__builtin_fmaxf(__uint_as_float(rr[0]),__uint_as_float(rr[1])); } \
      resc=false; \
      if(__builtin_expect(__any(rm>(float)THRL),0)){ const float dl=__builtin_fmaxf(rm,0.f); mhat+=dl; \
        _Pragma("unroll") for(int r=0;r<16;++r){C0[r]-=dl;C1[r]-=dl;} \
        _Pragma("unroll") for(int r=0;r<16;++r)negm[r]=-mhat; asm volatile("":"+v"(negm)); \
        const float f=__builtin_amdgcn_exp2f(-dl); l_reg*=f; if(hi==0)wsf[r32]=f; resc=true; } } \
    SBAR(); \
    GAPB(o[0]=__builtin_amdgcn_mfma_f32_32x32x16_bf16(PAF(0),VFR(0),o[0],0,0,0), C0,0); \
    GAPB(o[1]=__builtin_amdgcn_mfma_f32_32x32x16_bf16(PAF(0),VFR(4),o[1],0,0,0), C0,4); \
    KRD(GL,0); GAPB(o[0]=__builtin_amdgcn_mfma_f32_32x32x16_bf16(PAF(1),VFR(1),o[0],0,0,0), C0,8); \
    KRD(GL,1); GAPB(o[1]=__builtin_amdgcn_mfma_f32_32x32x16_bf16(PAF(1),VFR(5),o[1],0,0,0), C0,12); \
    KRD(GL,2); GAPB(o[0]=__builtin_amdgcn_mfma_f32_32x32x16_bf16(PAF(2),VFR(2),o[0],0,0,0), C1,0); \
    KRD(GL,3); GAPB(o[1]=__builtin_amdgcn_mfma_f32_32x32x16_bf16(PAF(2),VFR(6),o[1],0,0,0), C1,4); \
    GAPB(o[0]=__builtin_amdgcn_mfma_f32_32x32x16_bf16(PAF(3),VFR(3),o[0],0,0,0), C1,8); \
    GAPB(o[1]=__builtin_amdgcn_mfma_f32_32x32x16_bf16(PAF(3),VFR(7),o[1],0,0,0), C1,12); \
    }while(0)
  int t=1;
  #undef CMASK
  #define CMASK(P0,P1,t) do{}while(0)
  for(;t+5<NT;t+=2){
    STEP(pB0,pB1,pA0,pA1,t,true,true,true);     WAIT_BAR(2); RESC(); ROT();
    STEP(pA0,pA1,pB0,pB1,t+1,true,true,true);   WAIT_BAR(2); RESC(); ROT();
  }
  #undef CMASK
  #define CMASK(P0,P1,t) do{}while(0)
  #define ENDW(tt) do{ if((tt)+3<NT){WAIT_BAR(2);} else if((tt)+2<NT){WAIT_BAR(1);} else {WAIT_BAR(0);} }while(0)
  for(;t+1<NT;t+=2){
    STEP(pB0,pB1,pA0,pA1,t,(t+3<NT),(t+1<NT),(t+1<NT));       ENDW(t);   RESC(); ROT();
    STEP(pA0,pA1,pB0,pB1,t+1,(t+4<NT),(t+2<NT),(t+2<NT));     ENDW(t+1); RESC(); ROT();
  }
  STEP(pB0,pB1,pA0,pA1,NT-1,false,false,false); RESC();
  { float sacc=pB0[0]+pB0[1]; _Pragma("unroll") for(int r=2;r<16;++r)sacc+=pB0[r]; _Pragma("unroll") for(int r=0;r<16;++r)sacc+=pB1[r]; l_reg+=sacc;
    pw0=(u32x4){PKW(pB0,0),PKW(pB0,2),PKW(pB0,4),PKW(pB0,6)};pw1=(u32x4){PKW(pB0,8),PKW(pB0,10),PKW(pB0,12),PKW(pB0,14)};pw2=(u32x4){PKW(pB1,0),PKW(pB1,2),PKW(pB1,4),PKW(pB1,6)};pw3=(u32x4){PKW(pB1,8),PKW(pB1,10),PKW(pB1,12),PKW(pB1,14)};
    SBAR(); pv(o,vb0+sl_cur,PAF(0),PAF(1),PAF(2),PAF(3)); }
  #undef PKW
  #undef PAF
  #undef VFR
  #undef PIN
  #undef MX3
  #undef GAPA
  #undef GAPB
  #undef EX
  #undef VRD
  #undef KRD
  #undef STEP
  #undef ENDW
  {auto rr=__builtin_amdgcn_permlane32_swap(__float_as_uint(l_reg),__float_as_uint(l_reg),false,false);l_reg=__uint_as_float(rr[0])+__uint_as_float(rr[1]);}
  if(hi==0)wsf[32+r32]=l_reg;asm volatile("s_waitcnt lgkmcnt(0)":::"memory");
  float rli[16];
  #pragma unroll
  for(int r=0;r<16;++r)rli[r]=__builtin_amdgcn_rcpf(wsf[32+crow(r,hi)]);
  bf16*Ow=O+(rowbase+q0+wid*QBLK)*OP+h*D;
  { bf16*stg=(bf16*)(shm+LDS_OST)+wid*2048;
    #pragma unroll
    for(int r=0;r<16;++r){const int orow=crow(r,hi);
      #pragma unroll
      for(int d0=0;d0<2;++d0)stg[orow*64+d0*32+r32]=__float2bfloat16(o[d0][r]*rli[r]);}
    asm volatile("s_waitcnt lgkmcnt(0)":::"memory");
    #pragma unroll
    for(int i=0;i<4;++i){const int row=i*8+(lane>>3),ch=lane&7; const u32x4 v=*(const u32x4*)(stg+row*64+ch*8); ATTN_STORE16(Ow+(long)row*OP+ch*8,v);} }
  asm volatile("s_waitcnt lgkmcnt(0)\n\ts_barrier":::"memory");
  #undef DMA_K
  #undef DMA_V
  #undef CMASK
  #undef START
  #undef RESC
  #undef ROT
}
constexpr int ATTN_LDS_BYTES=LDS_BYTES;
template<int THRL=8> __device__ __forceinline__ void attn_phase(char*lds,const bf16*Q,const bf16*K,const bf16*V,bf16*O,int vcu,int G){
  for(int u=vcu;u<BATCH*NHEAD*(SEQ/QB);u+=G){ const int grp=u>>5, r=u&31; const int b=grp>>1, kvh=grp&1, hq=r>>3, qb=r&7; attn_unit<THRL>(b,kvh*4+hq,qb,Q,K,V,O,lds); }
}
#undef SBAR
#undef WAIT_BAR
}

constexpr size_t MiB = 1u << 20;
constexpr size_t WS_ROPE = 1 * MiB, WS_SS = 2 * MiB;
constexpr size_t WS_WIN = 4 * MiB, WS_WXKV = 11 * MiB, WS_WCAT = 15 * MiB, WS_WOUT = 17 * MiB, WS_WXQ = 19 * MiB, WS_WXO = 21 * MiB, WS_WFF1 = 23 * MiB, WS_WFF2 = 31 * MiB;
constexpr size_t WS_MN = 40 * MiB, WS_XK = 48 * MiB, WS_XVT = 56 * MiB, WS_HB = 64 * MiB;
constexpr size_t WS_R1 = 128 * MiB;
constexpr size_t WS_R2 = 192 * MiB;
constexpr size_t WS_R3 = 256 * MiB;
constexpr size_t WS_G = 320 * MiB;
constexpr size_t WS_F = 128 * MiB;
constexpr size_t WS_END = 448 * MiB;

constexpr int NWAVES = 8;
constexpr int RING_BYTES = 131072, XCH_OFF = RING_BYTES, LDS_BYTES = 147456;
#define GAS __attribute__((address_space(1)))
#define LAS __attribute__((address_space(3)))
typedef unsigned short bf16;
typedef unsigned v4u __attribute__((ext_vector_type(4)));
typedef float f32x4 __attribute__((ext_vector_type(4)));

__device__ __forceinline__ unsigned f2bf(float f) { unsigned u = __builtin_bit_cast(unsigned, f); return (u + 0x7fffu + ((u >> 16) & 1u)) >> 16; }
__device__ __forceinline__ unsigned pk2(float lo, float hi) { return f2bf(lo) | (f2bf(hi) << 16); }
__device__ __forceinline__ float wave_sum(float v) {
#pragma unroll
    for (int o = 1; o < 64; o <<= 1) v += __shfl_xor(v, o);
    return v;
}
#define LDS_WAIT() asm volatile("s_waitcnt lgkmcnt(0)" ::: "memory")

__device__ __forceinline__ void p0_transpose_item(const float* W, int ldw, bf16* WT, int ldt, LAS float* scr, int item, int nblk, int lane, const float* gk) {
    const int kb = item / nblk, nb = item % nblk, k0 = 64 * kb, n0 = 32 * nb;
#pragma unroll 8
    for (int i = 0; i < 32; ++i) { const int kk = 2 * i + (lane >> 5); float v = W[(size_t)(k0 + kk) * ldw + n0 + (lane & 31)]; if (gk) v *= gk[k0 + kk]; scr[kk * 33 + (lane & 31)] = v; }
    LDS_WAIT(); asm volatile("" ::: "memory");
    const int c = lane & 7;
#pragma unroll
    for (int j = 0; j < 4; ++j) { const int n = (lane >> 3) + 8 * j; const LAS float* s = scr + (8 * c) * 33 + n;
        v4u o; o.x = pk2(s[0 * 33], s[1 * 33]); o.y = pk2(s[2 * 33], s[3 * 33]); o.z = pk2(s[4 * 33], s[5 * 33]); o.w = pk2(s[6 * 33], s[7 * 33]);
        *(v4u*)(WT + (size_t)(n0 + n) * ldt + k0 + 8 * c) = o; }
    LDS_WAIT(); asm volatile("" ::: "memory");
}
__device__ __forceinline__ void rms_row_to_bf16(const float* xrow, const float* g, bf16* orow, int lane) {
    const f32x4* xr = (const f32x4*)xrow + lane; const f32x4* gr = (const f32x4*)g + lane;
    f32x4 v[4]; float s = 0.f;
#pragma unroll
    for (int j = 0; j < 4; ++j) { v[j] = xr[64 * j]; s += (v[j].x * v[j].x + v[j].y * v[j].y) + (v[j].z * v[j].z + v[j].w * v[j].w); }
    const float rs = 1.0f / sqrtf(wave_sum(s) * (1.f / 1024.f) + EPS);
    unsigned long long* o8 = (unsigned long long*)orow + lane;
#pragma unroll
    for (int j = 0; j < 4; ++j) { const f32x4 gg = gr[64 * j]; o8[64 * j] = (unsigned long long)pk2(v[j].x * rs * gg.x, v[j].y * rs * gg.y) | ((unsigned long long)pk2(v[j].z * rs * gg.z, v[j].w * rs * gg.w) << 32); }
}

struct Args {
    const float* in[21]; float* out; unsigned char* ws; int ph_lo, ph_hi;
};
enum { I_X = 0, I_MEM, I_GMIX, I_WIN, I_BGATE, I_GQ, I_GK, I_WATTN, I_POOLW, I_PSCALE, I_WPOOL, I_WOUT, I_GCROSS, I_GMEM, I_WXQ, I_WXKV, I_WXO, I_GFFN, I_WFF1, I_WFF2, I_GFINAL };
constexpr int N_PHASES = 12;

__global__ void __launch_bounds__(NWAVES * 64, 2) mega_fwd(Args args) {
    extern __shared__ __attribute__((aligned(16))) unsigned char lds[];
    LAS unsigned char* ldsp = (LAS unsigned char*)lds;
    LAS float* xch = (LAS float*)(ldsp + XCH_OFF);
    const int tid = threadIdx.x, lane = tid & 63, wave = __builtin_amdgcn_readfirstlane(tid >> 6);
    const int G = gridDim.x; const int bx = blockIdx.x;
    const int vcu = (G % 8 == 0) ? (bx % 8) * (G / 8) + bx / 8 : bx;
    unsigned char* ws = args.ws;
    const int lo = args.ph_lo, hi = args.ph_hi;
    bf16* Win_t = (bf16*)(ws + WS_WIN); bf16* Wxkv_t = (bf16*)(ws + WS_WXKV); bf16* Wcat_t = (bf16*)(ws + WS_WCAT); bf16* Wout_t = (bf16*)(ws + WS_WOUT);
    bf16* Wxq_t = (bf16*)(ws + WS_WXQ); bf16* Wxo_t = (bf16*)(ws + WS_WXO); bf16* Wff1_t = (bf16*)(ws + WS_WFF1); bf16* Wff2_t = (bf16*)(ws + WS_WFF2);
    float* ROPE = (float*)(ws + WS_ROPE); float* SS = (float*)(ws + WS_SS);
    bf16* MNb = (bf16*)(ws + WS_MN); bf16* XK = (bf16*)(ws + WS_XK); bf16* XVT = (bf16*)(ws + WS_XVT); bf16* HB = (bf16*)(ws + WS_HB);
    bf16* N1 = (bf16*)(ws + WS_R1); bf16* AP = (bf16*)(ws + WS_R1); bf16* Pm = (bf16*)(ws + WS_R1);
    bf16* Qb = (bf16*)(ws + WS_R2); bf16* Kb = (bf16*)(ws + WS_R2 + 32 * MiB); bf16* Vb = (bf16*)(ws + WS_R2 + 40 * MiB); bf16* MIX = (bf16*)(ws + WS_R2); bf16* XO = (bf16*)(ws + WS_R2);
    bf16* Ub = (bf16*)(ws + WS_R3); bf16* XQ = (bf16*)(ws + WS_R3);
    bf16* Gt = (bf16*)(ws + WS_G); bf16* Fb = (bf16*)(ws + WS_F);
    float* OUT = args.out;

#ifndef PHASE_MASK
#define PHASE_MASK 0xFFF
#endif
#define IN(k) (((PHASE_MASK >> (k)) & 1) && lo <= (k) && (k) < hi)
#define SEAM(k) do { if (IN(k) && IN((k) + 1)) { cg::this_grid().sync(); } } while (0)
    const int gw = vcu * NWAVES + wave, NGW = G * NWAVES;

    if (IN(0)) {
        LAS float* scr = (LAS float*)(ldsp + wave * 16384);
        constexpr int I0 = 16 * 104, I1 = 16 * 64, I2 = 8 * 32, I3 = 16 * 32, I4 = 16 * 32, I5 = 16 * 32, I6 = 16 * 128, I7 = 64 * 32, IFOLD = 1024;
        constexpr int NITEMS = I0 + I1 + I2 + I3 + I4 + I5 + I6 + I7 + IFOLD;
        for (int it = gw; it < NITEMS; it += NGW) {
            int r = it;
            if (r < I0) { p0_transpose_item(args.in[I_WIN], INW, Win_t, 1024, scr, r, 104, lane, nullptr); continue; } r -= I0;
            if (r < I1) { p0_transpose_item(args.in[I_WXKV], 2048, Wxkv_t, 1024, scr, r, 64, lane, nullptr); continue; } r -= I1;
            if (r < I2) { p0_transpose_item(args.in[I_WATTN], 1024, Wcat_t, 1024, scr, r, 32, lane, nullptr); continue; } r -= I2;
            if (r < I3) { p0_transpose_item(args.in[I_WOUT], 1024, Wout_t, 1024, scr, r, 32, lane, nullptr); continue; } r -= I3;
            if (r < I4) { p0_transpose_item(args.in[I_WXQ], 1024, Wxq_t, 1024, scr, r, 32, lane, args.in[I_GCROSS]); continue; } r -= I4;
            if (r < I5) { p0_transpose_item(args.in[I_WXO], 1024, Wxo_t, 1024, scr, r, 32, lane, nullptr); continue; } r -= I5;
            if (r < I6) { p0_transpose_item(args.in[I_WFF1], 4096, Wff1_t, 1024, scr, r, 128, lane, args.in[I_GFFN]); continue; } r -= I6;
            if (r < I7) { p0_transpose_item(args.in[I_WFF2], 1024, Wff2_t, 4096, scr, r, 32, lane, nullptr); continue; } r -= I7;
            {
                const int g = r >> 8, cb = (r >> 4) & 15, nb = r & 15, n = nb * 64 + lane, c0 = cb * 8;
                const float* pw = args.in[I_POOLW] + (size_t)g * 128 * 128 + (size_t)c0 * 128; const float* ps = args.in[I_PSCALE] + g * 128; const float* wp = args.in[I_WPOOL] + (size_t)g * 128 * 1024 + n;
                float a[8];
#pragma unroll
                for (int cc = 0; cc < 8; ++cc) a[cc] = 0.f;
                for (int d = 0; d < 128; ++d) { const float w = wp[(size_t)d * 1024] * ps[d];
#pragma unroll
                    for (int cc = 0; cc < 8; ++cc) a[cc] += pw[cc * 128 + d] * w; }
                v4u o; o.x = pk2(a[0], a[1]); o.y = pk2(a[2], a[3]); o.z = pk2(a[4], a[5]); o.w = pk2(a[6], a[7]);
                *(v4u*)(Wcat_t + (size_t)n * 1024 + 512 + g * 128 + c0) = o;
            }
        }
        {
            const int gt = vcu * NWAVES * 64 + tid;
            if (gt < 1024) { const int pos = gt >> 4, f = gt & 15; const float inv = exp2f(-(float)f * (13.287712379549449f / 16.0f));
                const float ang = (float)pos * inv; float rev = ang * 0.15915494309189535f; rev -= floorf(rev);
                ROPE[gt] = __builtin_amdgcn_cosf(rev); ROPE[1024 + gt] = __builtin_amdgcn_sinf(rev); }
        }
        for (int m = gw; m < TOK + MTOK; m += NGW) {
            if (m < TOK) rms_row_to_bf16(args.in[I_X] + (size_t)m * DM, args.in[I_GMIX], N1 + (size_t)m * DM, lane);
            else rms_row_to_bf16(args.in[I_MEM] + (size_t)(m - TOK) * DM, args.in[I_GMEM], MNb + (size_t)(m - TOK) * DM, lane);
        }
    }
    SEAM(0);

    if (IN(1)) {
        typedef pg8::ProbP1<(long)WS_R1, (long)WS_WIN, (long)WS_MN, (long)WS_WXKV> P1; P1 S; S.ws = (const char*)ws; S.G = G; S.c = bx; S.K = 1024; S.lda = 1024; S.ldb = 1024; S.mid = -1;
        pg8::EpiP1 E{Qb, Kb, Vb, Ub, Gt, XK, XVT, args.in[I_BGATE], args.in[I_GQ], args.in[I_GK], ROPE};
        pg8::gemm_phase<pg8::EpiP1, P1, true, true>(ldsp, xch, S, E);
    }
    SEAM(1);

    if (IN(2)) {
        attn_body::attn_phase((char*)lds, (const attn_body::bf16*)Qb, (const attn_body::bf16*)Kb, (const attn_body::bf16*)Vb, (attn_body::bf16*)AP, vcu, G);
        const int grp = lane >> 4, hw = 1 << grp;
        for (int t = gw; t < TOK; t += NGW) {
            const int s = t & (SEQ - 1); const int lo_s = max(s - hw, 0), hi_s = min(s + hw, SEQ);
            const bf16* ub = Ub + (size_t)(t - s) * 512 + lane * 8;
            float a[8];
#pragma unroll
            for (int j = 0; j < 8; ++j) a[j] = 0.f;
            for (int ss = lo_s; ss < hi_s; ++ss) { const v4u w = *(const v4u*)(ub + (size_t)ss * 512);
                a[0] += pg8::bf_lo(w.x); a[1] += pg8::bf_hi(w.x); a[2] += pg8::bf_lo(w.y); a[3] += pg8::bf_hi(w.y); a[4] += pg8::bf_lo(w.z); a[5] += pg8::bf_hi(w.z); a[6] += pg8::bf_lo(w.w); a[7] += pg8::bf_hi(w.w); }
            const v4u w = *(const v4u*)(ub + (size_t)s * 512); const float ic = 1.0f / (float)(hi_s - lo_s);
            v4u o; o.x = pk2(a[0] * ic - pg8::bf_lo(w.x), a[1] * ic - pg8::bf_hi(w.x)); o.y = pk2(a[2] * ic - pg8::bf_lo(w.y), a[3] * ic - pg8::bf_hi(w.y));
            o.z = pk2(a[4] * ic - pg8::bf_lo(w.z), a[5] * ic - pg8::bf_hi(w.z)); o.w = pk2(a[6] * ic - pg8::bf_lo(w.w), a[7] * ic - pg8::bf_hi(w.w));
            *(v4u*)(AP + (size_t)t * 1024 + 512 + lane * 8) = o;
        }
    }
    SEAM(2);

    if (IN(3)) {
        pg8::ProbMN S = pg8::make_plain(AP, Wcat_t, TOK, 1024, 1024, G, bx); S.mid = 8;
        pg8::EpiMix E{Gt, MIX};
        pg8::gemm_phase<pg8::EpiMix, pg8::ProbMN, true, true>(ldsp, xch, S, E);
    }
    SEAM(3);

    if (IN(4)) {
        pg8::ProbMN S = pg8::make_plain(MIX, Wout_t, TOK, 1024, 1024, G, bx);
        pg8::EpiRes<true> E{args.in[I_X], OUT, HB, SS};
        pg8::gemm_phase<pg8::EpiRes<true>, pg8::ProbMN, true, true>(ldsp, xch, S, E);
    }
    SEAM(4);

    if (IN(5)) {
        pg8::ProbMN S = pg8::make_plain(HB, Wxq_t, TOK, 1024, 1024, G, bx);
        pg8::EpiRowScale<0> E{SS, XQ, 1024, XSCALE};
        pg8::gemm_phase<pg8::EpiRowScale<0>, pg8::ProbMN, true, true>(ldsp, xch, S, E);
    }
    SEAM(5);

    if (IN(6)) {
        pg8::ProbMN S; S.A = XQ; S.B = XK; S.nM = TOK / 256; S.nN = 4; S.G = G; S.c = bx; S.K = 256; S.lda = 1024; S.ldb = 1024; S.mid = -1;
        S.a_pm = 256L * 1024; S.a_pn = 256; S.b_pb = 256L * 1024; S.b_pn = 256;
        pg8::EpiSoftmax E{Pm};
        pg8::gemm_phase<pg8::EpiSoftmax, pg8::ProbMN, true, true>(ldsp, xch, S, E);
    }
    SEAM(6);

    if (IN(7)) {
        pg8::ProbMN S; S.A = Pm; S.B = XVT; S.nM = TOK / 256; S.nN = 4; S.G = G; S.c = bx; S.K = 256; S.lda = 1024; S.ldb = 4096; S.mid = -1;
        S.a_pm = 256L * 1024; S.a_pn = 256; S.b_pb = 256; S.b_pn = 256L * 4096;
        pg8::EpiPlain E{XO, 1024};
        pg8::gemm_phase<pg8::EpiPlain, pg8::ProbMN, true, true>(ldsp, xch, S, E);
    }
    SEAM(7);

    if (IN(8)) {
        pg8::ProbMN S = pg8::make_plain(XO, Wxo_t, TOK, 1024, 1024, G, bx);
        pg8::EpiRes<true> E{OUT, OUT, HB, SS};
        pg8::gemm_phase<pg8::EpiRes<true>, pg8::ProbMN, true, true>(ldsp, xch, S, E);
    }
    SEAM(8);

    if (IN(9)) {
        pg8::ProbMN S = pg8::make_plain(HB, Wff1_t, TOK, 4096, 1024, G, bx);
        pg8::EpiRowScale<1> E{SS, Fb, 4096, 1.0f};
        pg8::gemm_phase<pg8::EpiRowScale<1>, pg8::ProbMN, true, true>(ldsp, xch, S, E);
    }
    SEAM(9);

    if (IN(10)) {
        pg8::ProbMN S = pg8::make_plain(Fb, Wff2_t, TOK, 1024, 4096, G, bx);
        pg8::EpiRes<false> E{OUT, OUT, HB, SS};
        pg8::gemm_phase<pg8::EpiRes<false>, pg8::ProbMN, true, true>(ldsp, xch, S, E);
    }
    SEAM(10);

    if (IN(11)) {
        const f32x4* gr = (const f32x4*)args.in[I_GFINAL] + lane;
        for (int m = gw; m < TOK; m += NGW) {
            f32x4* xr = (f32x4*)(OUT + (size_t)m * DM) + lane;
            float s = (lane < 16) ? SS[(size_t)m * 16 + lane] : 0.f; s = wave_sum(s);
            const float rs = 1.0f / sqrtf(s * (1.f / 1024.f) + EPS);
#pragma unroll
            for (int j = 0; j < 4; ++j) { f32x4 v = xr[64 * j]; const f32x4 gg = gr[64 * j]; v = v * rs * gg; xr[64 * j] = v; }
        }
    }
#undef IN
#undef SEAM
}

extern "C" void kernel_launch(void* const* d_in, const int* in_sizes, int n_in, void* d_out, int out_size, void* d_ws, size_t ws_size, hipStream_t stream) {
    static int grid = 0;
    if (grid == 0) {
        if (n_in != 21 || in_sizes[0] != TOK * DM || out_size != TOK * DM || ws_size < WS_END) {
            fprintf(stderr, "kernel_launch: unexpected shapes: n_in %d in0 %d out %d ws %zu (need >= %zu)\n", n_in, n_in > 0 ? in_sizes[0] : -1, out_size, ws_size, (size_t)WS_END); grid = -1; return; }
        int dev = 0, cus = 0, per_cu = 0;
        if (hipGetDevice(&dev) != hipSuccess || hipDeviceGetAttribute(&cus, hipDeviceAttributeMultiprocessorCount, dev) != hipSuccess) { grid = -1; return; }
        if (hipFuncSetAttribute((const void*)mega_fwd, hipFuncAttributeMaxDynamicSharedMemorySize, LDS_BYTES) != hipSuccess) { fprintf(stderr, "kernel_launch: hipFuncSetAttribute failed\n"); grid = -1; return; }
        if (hipOccupancyMaxActiveBlocksPerMultiprocessor(&per_cu, (const void*)mega_fwd, NWAVES * 64, LDS_BYTES) != hipSuccess || per_cu < 1) { fprintf(stderr, "kernel_launch: occupancy query says %d\n", per_cu); per_cu = 1; }
        (void)hipGetLastError();
        grid = cus * per_cu;
    }
    if (grid < 0) return;
    Args a{};
    for (int i = 0; i < 21; ++i) a.in[i] = (const float*)d_in[i];
    a.out = (float*)d_out; a.ws = (unsigned char*)d_ws;
#if MK_PER_PHASE
    for (int p = 0; p < N_PHASES; ++p) { a.ph_lo = p; a.ph_hi = p + 1; hipLaunchKernelGGL(mega_fwd, dim3(grid), dim3(NWAVES * 64), LDS_BYTES, stream, a); }
#else
    a.ph_lo = 0; a.ph_hi = N_PHASES;
    void* kargs[] = {&a};
    hipError_t e = hipLaunchCooperativeKernel((const void*)mega_fwd, dim3(grid), dim3(NWAVES * 64), kargs, LDS_BYTES, stream);
    if (e != hipSuccess) fprintf(stderr, "kernel_launch: cooperative launch failed: %s (grid %d)\n", hipGetErrorString(e), grid);
#endif
}
```

```cpp
#include <hip/hip_runtime.h>
#include <hip/hip_cooperative_groups.h>
#include <hip/hip_bf16.h>
#include <cstdio>
#include <cstdint>
#include <cmath>
namespace cg = cooperative_groups;

#ifndef MK_PER_PHASE
#define MK_PER_PHASE 0
#endif

constexpr int DM = 1024, NB = 16, SEQ = 2048, TOK = NB * SEQ, NMEM = 256, MTOK = NB * NMEM;
constexpr int INW = 3328, DFF = 4096;
constexpr float EPS = 1e-6f;
constexpr float LOG2E = 1.4426950408889634f;
constexpr float QSCALE = 0.125f * LOG2E;
constexpr float XSCALE = 0.0625f * LOG2E;

namespace pg8 {
#define PG8_LAS __attribute__((address_space(3)))
typedef unsigned short bf16_t;
typedef short bf16x8 __attribute__((ext_vector_type(8)));
typedef float f32x4 __attribute__((ext_vector_type(4)));
typedef float f32x2 __attribute__((ext_vector_type(2)));
typedef unsigned u32x4 __attribute__((ext_vector_type(4)));
typedef unsigned u32x2 __attribute__((ext_vector_type(2)));
typedef __bf16 bf16x2_t __attribute__((ext_vector_type(2)));
constexpr int BM = 256, BK = 64, HALF = 128, HTB = HALF * BK * 2, STAGE_BYTES = 8 * HTB, NXCD = 8, WGM = 8;

__host__ __device__ __forceinline__ int lds_byte(int r, int c) { const int st = (r >> 4) * 2 + (c >> 5), rr = r & 15, cc = c & 31, ob = rr * 64 + cc * 2; return st * 1024 + (ob ^ (((ob >> 9) & 1) << 5)); }
__host__ __device__ __forceinline__ void stage_rc(int b, int& R, int& C) { const int st = b / 1024, sb = b % 1024, swz = sb ^ (((sb >> 9) & 1) << 5); R = (st >> 1) * 16 + swz / 64; C = (st & 1) * 32 + (swz % 64) / 2; }
__host__ __device__ __forceinline__ int perm32(int rho) { const int n = rho >> 4, i = rho & 15; return 8 * (i >> 2) + 4 * n + (i & 3); }

struct Unit { int pm, pn, id; };
#define PG8_OPAQUE(x) asm volatile("" : "+v"(x))

__device__ __forceinline__ unsigned pk_bf16(float lo, float hi) { f32x2 v = {lo, hi}; bf16x2_t b = __builtin_convertvector(v, bf16x2_t); return __builtin_bit_cast(unsigned, b); }
__device__ __forceinline__ float bf_lo(unsigned w) { return __uint_as_float(w << 16); }
__device__ __forceinline__ float bf_hi(unsigned w) { return __uint_as_float(w & 0xffff0000u); }
#define PG8_FENCE() asm volatile("" ::: "memory")

__device__ __forceinline__ void remap_tile(int wgid, int nM, int nN, int& pm, int& pn) {
    const int nwg = nM * nN;
    { const int q = nwg / NXCD, r = nwg % NXCD, xcd = wgid % NXCD, off = wgid / NXCD; wgid = (xcd < r ? xcd * (q + 1) : r * (q + 1) + (xcd - r) * q) + off; }
    const int nig = WGM * nN, gid = wgid / nig, fm = gid * WGM, gsz = (nM - fm) < WGM ? (nM - fm) : WGM;
    pm = fm + ((wgid % nig) % gsz); pn = (wgid % nig) / gsz;
}

struct ProbMN {
    const bf16_t* A; const bf16_t* B; int nM, nN, G, c; int K, lda, ldb, mid; long a_pm, a_pn, b_pb, b_pn;
    __device__ __forceinline__ bool next(int i, Unit& u) const {
        const long L = (long)i * G + c; if (L >= (long)nM * nN) return false;
        remap_tile((int)L, nM, nN, u.pm, u.pn); u.id = 0; return true; }
    __device__ __forceinline__ const char* aptr(const Unit& u) const { return (const char*)(A + (size_t)u.pm * a_pm + (size_t)u.pn * a_pn); }
    __device__ __forceinline__ const char* bptr(const Unit& u) const { return (const char*)(B + (size_t)(u.pm >> 3) * b_pb + (size_t)u.pn * b_pn); }
};
__device__ __forceinline__ ProbMN make_plain(const bf16_t* A, const bf16_t* Bt, int M, int N, int K, int G, int c) {
    ProbMN p; p.A = A; p.B = Bt; p.nM = M / BM; p.nN = N / BM; p.G = G; p.c = c; p.K = K; p.lda = K; p.ldb = K; p.mid = -1;
    p.a_pm = (long)BM * K; p.a_pn = 0; p.b_pb = 0; p.b_pn = (long)BM * K; return p; }

template <long OFF_N1, long OFF_WIN, long OFF_MN, long OFF_WXKV> struct ProbP1 {
    const char* ws; int G, c; int K, lda, ldb, mid;
    static constexpr int NPROJ = 128 * 13, NXK = 64, NXV = 64;
    __device__ __forceinline__ bool next(int i, Unit& u) const {
        const int L = i * G + c; if (L >= NPROJ + NXK + NXV) return false;
        if (L < NPROJ) { remap_tile(L, 128, 13, u.pm, u.pn); u.id = 0; }
        else if (L < NPROJ + NXK) { const int e = L - NPROJ; u.pm = e >> 2; u.pn = e & 3; u.id = 1; }
        else { const int e = L - NPROJ - NXK; u.pm = e >> 4; u.pn = e & 15; u.id = 2; }
        return true; }
    __device__ __forceinline__ const char* aptr(const Unit& u) const {
        const long off = u.id == 0 ? OFF_N1 : (u.id == 1 ? OFF_MN : OFF_WXKV + 1024L * 1024 * 2); return ws + off + (long)u.pm * (256 * 1024 * 2); }
    __device__ __forceinline__ const char* bptr(const Unit& u) const {
        const long off = u.id == 0 ? OFF_WIN : (u.id == 1 ? OFF_WXKV : OFF_MN); return ws + off + (long)u.pn * (256 * 1024 * 2); }
};

typedef f32x4 Acc[2][2][4][2];

__device__ __forceinline__ void store_tile_bf16_np(const Acc& acc, bf16_t* base, int ldc, int wr, int wc, int fr, int fq) {
#pragma unroll
    for (int ai = 0; ai < 2; ++ai)
#pragma unroll
        for (int m = 0; m < 4; ++m) { bf16_t* rowp = base + (size_t)(ai * HALF + wr * 64 + m * 16 + fr) * ldc + wc * 32 + 4 * fq;
#pragma unroll
            for (int bj = 0; bj < 2; ++bj)
#pragma unroll
                for (int n = 0; n < 2; ++n) { const f32x4 v = acc[ai][bj][m][n]; u32x2 w; w.x = pk_bf16(v[0], v[1]); w.y = pk_bf16(v[2], v[3]); *(u32x2*)(rowp + bj * HALF + n * 16) = w; } }
}

struct EpiP1 {
    static constexpr bool PERM = false, AFTER_DRAIN = false, HAS_MID = false;
    bf16_t *Q, *Kb, *Vb, *U, *Gt, *XK, *XVT; const float *bgate, *gq, *gk, *rope;
    __device__ __forceinline__ void mid(Acc&, const Unit&, int, int, int, int) const {}
    __device__ __forceinline__ void qk_rope(Acc& acc, const Unit& u, int wr, int wc, int fr, int fq, PG8_LAS float* xch, int wid, int bj, const float* gain, float oscale, bf16_t* out, int ldo, int ocol0) const {
#pragma unroll
        for (int ai = 0; ai < 2; ++ai)
#pragma unroll
            for (int m = 0; m < 4; ++m) {
                const f32x4 a = acc[ai][bj][m][0], b = acc[ai][bj][m][1];
                float s = (a[0] * a[0] + a[1] * a[1]) + (a[2] * a[2] + a[3] * a[3]) + (b[0] * b[0] + b[1] * b[1]) + (b[2] * b[2] + b[3] * b[3]);
                s += __shfl_xor(s, 16); s += __shfl_xor(s, 32);
                if (fq == 0) xch[wid * 128 + (ai * 4 + m) * 16 + fr] = s;
            }
        asm volatile("s_waitcnt lgkmcnt(0)" ::: "memory"); __builtin_amdgcn_s_barrier(); PG8_FENCE();
        const int axis = wc & 1;
        const int d0 = axis * 32 + 4 * fq;
        const f32x4 g0 = *(const f32x4*)(gain + d0), g1 = *(const f32x4*)(gain + d0 + 16);
        const int gridrow0 = (u.pm & 7) * 4 + wr;
#pragma unroll
        for (int ai = 0; ai < 2; ++ai)
#pragma unroll
            for (int m = 0; m < 4; ++m) {
                const int xi = (ai * 4 + m) * 16 + fr;
                const float tot = xch[wid * 128 + xi] + xch[(wid ^ 1) * 128 + xi];
                const float rs = __builtin_amdgcn_rsqf(tot * (1.0f / 64.0f) + EPS) ;
                const int pos = axis ? (m * 16 + fr) : (gridrow0 + 2 * ai);
                const f32x4 cs = *(const f32x4*)(rope + pos * 16 + 4 * fq), sn = *(const f32x4*)(rope + 1024 + pos * 16 + 4 * fq);
                const f32x4 x0 = acc[ai][bj][m][0] * rs * g0, x1 = acc[ai][bj][m][1] * rs * g1;
                const f32x4 y0 = (x0 * cs - x1 * sn) * oscale, y1 = (x1 * cs + x0 * sn) * oscale;
                bf16_t* rowp = out + (size_t)(u.pm * BM + ai * HALF + wr * 64 + m * 16 + fr) * ldo + ocol0 + wc * 32 + 4 * fq;
                u32x2 w0, w1; w0.x = pk_bf16(y0[0], y0[1]); w0.y = pk_bf16(y0[2], y0[3]); w1.x = pk_bf16(y1[0], y1[1]); w1.y = pk_bf16(y1[2], y1[3]);
                *(u32x2*)(rowp) = w0; *(u32x2*)(rowp + 16) = w1;
                PG8_FENCE();
            }
        asm volatile("s_waitcnt lgkmcnt(0)" ::: "memory"); __builtin_amdgcn_s_barrier(); PG8_FENCE();
    }
    __device__ __forceinline__ void operator()(Acc& acc, const Unit& u, int wr, int wc, int fr, int fq, PG8_LAS float* xch, int wid) const { PG8_OPAQUE(fr);
        if (u.id == 0) {
            if (u.pn < 2) {
                qk_rope(acc, u, wr, wc, fr, fq, xch, wid, 0, gq, QSCALE, Q, 512, u.pn * 256);
                qk_rope(acc, u, wr, wc, fr, fq, xch, wid, 1, gq, QSCALE, Q, 512, u.pn * 256 + 128);
            } else if (u.pn == 2) {
                qk_rope(acc, u, wr, wc, fr, fq, xch, wid, 0, gk, 1.0f, Kb, 128, 0);
#pragma unroll
                for (int ai = 0; ai < 2; ++ai)
#pragma unroll
                    for (int m = 0; m < 4; ++m) { bf16_t* rowp = Vb + (size_t)(u.pm * BM + ai * HALF + wr * 64 + m * 16 + fr) * 128 + wc * 32 + 4 * fq;
#pragma unroll
                        for (int n = 0; n < 2; ++n) { const f32x4 v = acc[ai][1][m][n]; u32x2 w; w.x = pk_bf16(v[0], v[1]); w.y = pk_bf16(v[2], v[3]); *(u32x2*)(rowp + n * 16) = w; } }
            } else if (u.pn < 5) {
                store_tile_bf16_np(acc, U + (size_t)u.pm * BM * 512 + (u.pn - 3) * 256, 512, wr, wc, fr, fq);
            } else {
                const int gc0 = (u.pn - 5) * 256 + wc * 32 + 4 * fq;
                f32x4 bv[2][2];
#pragma unroll
                for (int bj = 0; bj < 2; ++bj)
#pragma unroll
                    for (int n = 0; n < 2; ++n) bv[bj][n] = *(const f32x4*)(bgate + gc0 + bj * HALF + n * 16);
#pragma unroll
                for (int ai = 0; ai < 2; ++ai)
#pragma unroll
                    for (int m = 0; m < 4; ++m) { bf16_t* rowp = Gt + (size_t)(u.pm * BM + ai * HALF + wr * 64 + m * 16 + fr) * 2048 + gc0;
#pragma unroll
                        for (int bj = 0; bj < 2; ++bj)
#pragma unroll
                            for (int n = 0; n < 2; ++n) { f32x4 z = acc[ai][bj][m][n] + bv[bj][n]; f32x4 s;
#pragma unroll
                                for (int j = 0; j < 4; ++j) { const float zz = fminf(fmaxf(z[j], -30.f), 30.f); s[j] = __builtin_amdgcn_rcpf(1.0f + __builtin_amdgcn_exp2f(-zz * LOG2E)); }
                                u32x2 w; w.x = pk_bf16(s[0], s[1]); w.y = pk_bf16(s[2], s[3]); *(u32x2*)(rowp + bj * HALF + n * 16) = w; }
                        PG8_FENCE(); }
            }
        } else if (u.id == 1) {
            store_tile_bf16_np(acc, XK + (size_t)u.pm * BM * 1024 + u.pn * 256, 1024, wr, wc, fr, fq);
        } else {
            store_tile_bf16_np(acc, XVT + (size_t)u.pm * BM * 4096 + u.pn * 256, 4096, wr, wc, fr, fq);
        }
    }
};

struct EpiMix {
    static constexpr bool PERM = true, AFTER_DRAIN = false, HAS_MID = true;
    const bf16_t* Gt; bf16_t* MIX;
    __device__ __forceinline__ void mid(Acc& acc, const Unit& u, int wr, int wc, int fr, int fq) const { PG8_OPAQUE(fr);
#pragma unroll
        for (int ai = 0; ai < 2; ++ai)
#pragma unroll
            for (int m = 0; m < 4; ++m) { const bf16_t* grow = Gt + (size_t)(u.pm * BM + ai * HALF + wr * 64 + m * 16 + fr) * 2048 + u.pn * 256 + wc * 32 + 8 * fq;
#pragma unroll
                for (int bj = 0; bj < 2; ++bj) { const u32x4 ga = *(const u32x4*)(grow + bj * HALF), gp = *(const u32x4*)(grow + 1024 + bj * HALF);
                    f32x4 r0, r1;
                    r0[0] = bf_lo(ga.x) * __builtin_amdgcn_rcpf(bf_lo(gp.x)); r0[1] = bf_hi(ga.x) * __builtin_amdgcn_rcpf(bf_hi(gp.x));
                    r0[2] = bf_lo(ga.y) * __builtin_amdgcn_rcpf(bf_lo(gp.y)); r0[3] = bf_hi(ga.y) * __builtin_amdgcn_rcpf(bf_hi(gp.y));
                    r1[0] = bf_lo(ga.z) * __builtin_amdgcn_rcpf(bf_lo(gp.z)); r1[1] = bf_hi(ga.z) * __builtin_amdgcn_rcpf(bf_hi(gp.z));
                    r1[2] = bf_lo(ga.w) * __builtin_amdgcn_rcpf(bf_lo(gp.w)); r1[3] = bf_hi(ga.w) * __builtin_amdgcn_rcpf(bf_hi(gp.w));
                    acc[ai][bj][m][0] *= r0; acc[ai][bj][m][1] *= r1; }
                PG8_FENCE(); }
    }
    __device__ __forceinline__ void operator()(Acc& acc, const Unit& u, int wr, int wc, int fr, int fq, PG8_LAS float*, int) const { PG8_OPAQUE(fr);
#pragma unroll
        for (int ai = 0; ai < 2; ++ai)
#pragma unroll
            for (int m = 0; m < 4; ++m) { const size_t ro = (size_t)(u.pm * BM + ai * HALF + wr * 64 + m * 16 + fr); const int co = u.pn * 256 + wc * 32 + 8 * fq;
#pragma unroll
                for (int bj = 0; bj < 2; ++bj) { const u32x4 gp = *(const u32x4*)(Gt + ro * 2048 + 1024 + co + bj * HALF);
                    const f32x4 a = acc[ai][bj][m][0], b = acc[ai][bj][m][1]; u32x4 w;
                    w.x = pk_bf16(a[0] * bf_lo(gp.x), a[1] * bf_hi(gp.x)); w.y = pk_bf16(a[2] * bf_lo(gp.y), a[3] * bf_hi(gp.y));
                    w.z = pk_bf16(b[0] * bf_lo(gp.z), b[1] * bf_hi(gp.z)); w.w = pk_bf16(b[2] * bf_lo(gp.w), b[3] * bf_hi(gp.w));
                    *(u32x4*)(MIX + ro * 1024 + co + bj * HALF) = w; }
                PG8_FENCE(); }
    }
};

template <bool WRITE_HB> struct EpiRes {
    static constexpr bool PERM = false, AFTER_DRAIN = false, HAS_MID = false;
    const float* base; float* out; bf16_t* HB; float* SS;
    __device__ __forceinline__ void mid(Acc&, const Unit&, int, int, int, int) const {}
    __device__ __forceinline__ void operator()(Acc& acc, const Unit& u, int wr, int wc, int fr, int fq, PG8_LAS float*, int) const { PG8_OPAQUE(fr);
        const int col0 = u.pn * BM + wc * 32 + 4 * fq;
#pragma unroll
        for (int ai = 0; ai < 2; ++ai)
#pragma unroll
            for (int m = 0; m < 4; ++m) { const size_t row = (size_t)(u.pm * BM + ai * HALF + wr * 64 + m * 16 + fr); const size_t off = row * 1024 + col0; float ss = 0.f;
#pragma unroll
                for (int bj = 0; bj < 2; ++bj)
#pragma unroll
                    for (int n = 0; n < 2; ++n) { const f32x4 bs = *(const f32x4*)(base + off + bj * HALF + n * 16); const f32x4 h = bs + acc[ai][bj][m][n];
                        *(f32x4*)(out + off + bj * HALF + n * 16) = h; ss += (h[0] * h[0] + h[1] * h[1]) + (h[2] * h[2] + h[3] * h[3]);
                        if (WRITE_HB) { u32x2 w; w.x = pk_bf16(h[0], h[1]); w.y = pk_bf16(h[2], h[3]); *(u32x2*)(HB + off + bj * HALF + n * 16) = w; } }
                ss += __shfl_xor(ss, 16); ss += __shfl_xor(ss, 32);
                if (fq == 0) SS[row * 16 + u.pn * 4 + wc] = ss;
                PG8_FENCE(); }
    }
};

template <int ACT> struct EpiRowScale {
    static constexpr bool PERM = true, AFTER_DRAIN = false, HAS_MID = false;
    const float* SS; bf16_t* O; int ldc; float scale;
    __device__ __forceinline__ void mid(Acc&, const Unit&, int, int, int, int) const {}
    __device__ __forceinline__ void operator()(Acc& acc, const Unit& u, int wr, int wc, int fr, int fq, PG8_LAS float*, int) const { PG8_OPAQUE(fr);
#pragma unroll
        for (int ai = 0; ai < 2; ++ai)
#pragma unroll
            for (int m = 0; m < 4; ++m) { const size_t row = (size_t)(u.pm * BM + ai * HALF + wr * 64 + m * 16 + fr);
                const f32x4 p4 = *(const f32x4*)(SS + row * 16 + 4 * fq); float s = (p4[0] + p4[1]) + (p4[2] + p4[3]); s += __shfl_xor(s, 16); s += __shfl_xor(s, 32);
                const float rs = __builtin_amdgcn_rsqf(s * (1.0f / 1024.0f) + EPS) * scale;
                bf16_t* rowp = O + row * ldc + u.pn * 256 + wc * 32 + 8 * fq;
#pragma unroll
                for (int bj = 0; bj < 2; ++bj) { f32x4 a = acc[ai][bj][m][0] * rs, b = acc[ai][bj][m][1] * rs;
                    if (ACT == 1) {
#pragma unroll
                        for (int j = 0; j < 4; ++j) { const float x = fmaxf(a[j], 0.f), y = fmaxf(b[j], 0.f); a[j] = x * x; b[j] = y * y; } }
                    u32x4 w; w.x = pk_bf16(a[0], a[1]); w.y = pk_bf16(a[2], a[3]); w.z = pk_bf16(b[0], b[1]); w.w = pk_bf16(b[2], b[3]);
                    *(u32x4*)(rowp + bj * HALF) = w; }
                PG8_FENCE(); }
    }
};

struct EpiPlain {
    static constexpr bool PERM = true, AFTER_DRAIN = false, HAS_MID = false;
    bf16_t* O; int ldc;
    __device__ __forceinline__ void mid(Acc&, const Unit&, int, int, int, int) const {}
    __device__ __forceinline__ void operator()(Acc& acc, const Unit& u, int wr, int wc, int fr, int fq, PG8_LAS float*, int) const { PG8_OPAQUE(fr);
#pragma unroll
        for (int ai = 0; ai < 2; ++ai)
#pragma unroll
            for (int m = 0; m < 4; ++m) { bf16_t* rowp = O + (size_t)(u.pm * BM + ai * HALF + wr * 64 + m * 16 + fr) * ldc + u.pn * 256 + wc * 32 + 8 * fq;
#pragma unroll
                for (int bj = 0; bj < 2; ++bj) { const f32x4 a = acc[ai][bj][m][0], b = acc[ai][bj][m][1];
                    u32x4 w; w.x = pk_bf16(a[0], a[1]); w.y = pk_bf16(a[2], a[3]); w.z = pk_bf16(b[0], b[1]); w.w = pk_bf16(b[2], b[3]);
                    *(u32x4*)(rowp + bj * HALF) = w; } }
    }
};

struct EpiSoftmax {
    static constexpr bool PERM = true, AFTER_DRAIN = false, HAS_MID = false;
    bf16_t* P;
    __device__ __forceinline__ void mid(Acc&, const Unit&, int, int, int, int) const {}
    __device__ __forceinline__ void operator()(Acc& acc, const Unit& u, int wr, int wc, int fr, int fq, PG8_LAS float* xch, int) const { PG8_OPAQUE(fr);
        PG8_LAS float* xmax = xch; PG8_LAS float* xsum = xch + 1024;
#pragma unroll
        for (int ai = 0; ai < 2; ++ai)
#pragma unroll
            for (int m = 0; m < 4; ++m) { float mx = -INFINITY;
#pragma unroll
                for (int bj = 0; bj < 2; ++bj)
#pragma unroll
                    for (int n = 0; n < 2; ++n) { const f32x4 v = acc[ai][bj][m][n]; mx = fmaxf(mx, fmaxf(fmaxf(v[0], v[1]), fmaxf(v[2], v[3]))); }
                mx = fmaxf(mx, __shfl_xor(mx, 16)); mx = fmaxf(mx, __shfl_xor(mx, 32));
                if (fq == 0) xmax[(ai * HALF + wr * 64 + m * 16 + fr) * 4 + wc] = mx; }
        asm volatile("s_waitcnt lgkmcnt(0)" ::: "memory"); __builtin_amdgcn_s_barrier(); PG8_FENCE();
#pragma unroll
        for (int ai = 0; ai < 2; ++ai)
#pragma unroll
            for (int m = 0; m < 4; ++m) { const int rl = ai * HALF + wr * 64 + m * 16 + fr; const f32x4 m4 = *(const PG8_LAS f32x4*)(xmax + rl * 4);
                const float mx = fmaxf(fmaxf(m4[0], m4[1]), fmaxf(m4[2], m4[3])); float s = 0.f;
#pragma unroll
                for (int bj = 0; bj < 2; ++bj)
#pragma unroll
                    for (int n = 0; n < 2; ++n) { f32x4 v = acc[ai][bj][m][n];
#pragma unroll
                        for (int j = 0; j < 4; ++j) { v[j] = __builtin_amdgcn_exp2f(v[j] - mx); s += v[j]; }
                        acc[ai][bj][m][n] = v; }
                s += __shfl_xor(s, 16); s += __shfl_xor(s, 32);
                if (fq == 0) xsum[rl * 4 + wc] = s; }
        asm volatile("s_waitcnt lgkmcnt(0)" ::: "memory"); __builtin_amdgcn_s_barrier(); PG8_FENCE();
#pragma unroll
        for (int ai = 0; ai < 2; ++ai)
#pragma unroll
            for (int m = 0; m < 4; ++m) { const int rl = ai * HALF + wr * 64 + m * 16 + fr; const f32x4 s4 = *(const PG8_LAS f32x4*)(xsum + rl * 4);
                const float inv = __builtin_amdgcn_rcpf((s4[0] + s4[1]) + (s4[2] + s4[3]));
                bf16_t* rowp = P + (size_t)(u.pm * BM + rl) * 1024 + u.pn * 256 + wc * 32 + 8 * fq;
#pragma unroll
                for (int bj = 0; bj < 2; ++bj) { const f32x4 a = acc[ai][bj][m][0] * inv, b = acc[ai][bj][m][1] * inv;
                    u32x4 w; w.x = pk_bf16(a[0], a[1]); w.y = pk_bf16(a[2], a[3]); w.z = pk_bf16(b[0], b[1]); w.w = pk_bf16(b[2], b[3]);
                    *(u32x4*)(rowp + bj * HALF) = w; } }
        asm volatile("s_waitcnt lgkmcnt(0)" ::: "memory"); __builtin_amdgcn_s_barrier(); PG8_FENCE();
    }
};

template <class Epi, class Sched, bool ALIGN_EPI, bool SP2>
__device__ __forceinline__ void gemm_phase(PG8_LAS unsigned char* lds, PG8_LAS float* xch, const Sched& S, const Epi& E) {
    const int tid = threadIdx.x, wid = __builtin_amdgcn_readfirstlane(tid >> 6), lane = tid & 63, wr = wid >> 2, wc = wid & 3, fr = lane & 15, fq = lane >> 4;
    const int K = S.K, nt = K / BK, lda = S.lda, ldb = S.ldb; (void)K;
    unsigned voffA[2], voffB[2];
#pragma unroll
    for (int i = 0; i < 2; ++i) { int R, C; stage_rc(tid * 16 + i * 8192, R, C); const int Rb = Epi::PERM ? ((R & ~31) + perm32(R & 31)) : R;
        voffA[i] = (unsigned)(R * lda + C) * 2u; voffB[i] = (unsigned)(Rb * ldb + C) * 2u; }
    const size_t kstep = (size_t)(BK * 2);
    const size_t hstepA = (size_t)HALF * lda * 2, hstepB = (size_t)HALF * ldb * 2;
    const unsigned ldsw = (unsigned)wid * 1024u;
    const int aoff = lds_byte(wr * 64 + fr, fq * 8), boff = lds_byte(wc * 32 + fr, fq * 8);
#define PG8_SA(b, h) (((b) * 2 + (h)) * HTB)
#define PG8_SB(b, h) ((4 + (b) * 2 + (h)) * HTB)
#define PG8_STAGE(bufoff, gbase, voff) do { _Pragma("unroll") for (int _i = 0; _i < 2; ++_i) \
        __builtin_amdgcn_global_load_lds((const unsigned*)((const char*)(gbase) + (voff)[_i]), (PG8_LAS unsigned*)(lds + (bufoff) + ldsw + _i * 8192), 16, 0, 0); } while (0)
#define PG8_LDA(dst, b, h) do { _Pragma("unroll") for (int m = 0; m < 4; ++m) _Pragma("unroll") for (int k = 0; k < 2; ++k) dst[m][k] = *(const PG8_LAS bf16x8*)(lds + PG8_SA(b, h) + aoff + m * 2048 + k * 1024); } while (0)
#define PG8_LDB(dst, b, h) do { _Pragma("unroll") for (int n = 0; n < 2; ++n) _Pragma("unroll") for (int k = 0; k < 2; ++k) dst[n][k] = *(const PG8_LAS bf16x8*)(lds + PG8_SB(b, h) + boff + n * 2048 + k * 1024); } while (0)
#define PG8_MMA(ai, bj, At, Bt) do { __builtin_amdgcn_s_setprio(1); _Pragma("unroll") for (int m = 0; m < 4; ++m) _Pragma("unroll") for (int n = 0; n < 2; ++n) _Pragma("unroll") for (int k = 0; k < 2; ++k) \
        acc[ai][bj][m][n] = __builtin_amdgcn_mfma_f32_16x16x32_bf16(Bt[n][k], At[m][k], acc[ai][bj][m][n], 0, 0, 0); __builtin_amdgcn_s_setprio(0); } while (0)
#define PG8_WAIT_V(n) asm volatile("s_waitcnt vmcnt(" #n ")" ::: "memory")
#define PG8_WAIT_L(n) asm volatile("s_waitcnt lgkmcnt(" #n ")" ::: "memory")
#define PG8_BAR __builtin_amdgcn_s_barrier()
#define PG8_SCHED __builtin_amdgcn_sched_barrier(0)
    Unit cur, nxt; int ui = 0;
    if (!S.next(0, cur)) return;
    f32x4 acc[2][2][4][2];
#pragma unroll
    for (int a = 0; a < 2; ++a)
#pragma unroll
        for (int b = 0; b < 2; ++b)
#pragma unroll
            for (int m = 0; m < 4; ++m)
#pragma unroll
                for (int n = 0; n < 2; ++n) acc[a][b][m][n] = (f32x4){0.f, 0.f, 0.f, 0.f};
    bf16x8 At[4][2], B0[2][2], B1[2][2];
    const char* cA = S.aptr(cur); const char* cB = S.bptr(cur);
    if constexpr (SP2) {
        PG8_STAGE(PG8_SB(0, 0), cB, voffB); PG8_STAGE(PG8_SB(0, 1), cB + hstepB, voffB); PG8_STAGE(PG8_SA(0, 0), cA, voffA); PG8_STAGE(PG8_SA(0, 1), cA + hstepA, voffA);
        if (wr == 1) PG8_BAR;
        PG8_WAIT_V(2); PG8_BAR;
        PG8_STAGE(PG8_SB(1, 0), cB + kstep, voffB); PG8_STAGE(PG8_SA(1, 0), cA + kstep, voffA); PG8_STAGE(PG8_SB(1, 1), cB + hstepB + kstep, voffB);
        PG8_WAIT_V(6); PG8_BAR;
    } else {
        PG8_STAGE(PG8_SB(0, 0), cB, voffB); PG8_STAGE(PG8_SA(0, 0), cA, voffA); PG8_STAGE(PG8_SB(0, 1), cB + hstepB, voffB); PG8_STAGE(PG8_SA(0, 1), cA + hstepA, voffA);
        if (wr == 1) PG8_BAR;
        PG8_WAIT_V(4); PG8_BAR;
        PG8_STAGE(PG8_SB(1, 0), cB + kstep, voffB); PG8_STAGE(PG8_SA(1, 0), cA + kstep, voffA); PG8_STAGE(PG8_SB(1, 1), cB + hstepB + kstep, voffB);
        PG8_WAIT_V(6); PG8_BAR;
    }
    for (;;) {
        const bool has_next = S.next(ui + 1, nxt);
        const char* nA = has_next ? S.aptr(nxt) : cA; const char* nB = has_next ? S.bptr(nxt) : cB;
        for (int t = 0; t < nt; t += 2) {
            const bool last = (t == nt - 2);
            const char* a1 = cA + (size_t)(t + 1) * kstep;
            const char* a2 = last ? nA : cA + (size_t)(t + 2) * kstep; const char* b2 = last ? nB : cB + (size_t)(t + 2) * kstep;
            const char* a3 = a2 + kstep; const char* b3 = b2 + kstep;
            if constexpr (Epi::HAS_MID) { if (t == S.mid) E.mid(acc, cur, wr, wc, fr, fq); }
            if constexpr (SP2) {
            PG8_LDB(B0, 0, 0); PG8_LDB(B1, 0, 1); PG8_SCHED; PG8_LDA(At, 0, 0); PG8_STAGE(PG8_SA(1, 1), a1 + hstepA, voffA);
            PG8_WAIT_V(8); PG8_WAIT_L(0); PG8_BAR; PG8_MMA(0, 0, At, B0); PG8_MMA(0, 1, At, B1); PG8_BAR; PG8_SCHED;
            PG8_LDA(At, 0, 1); PG8_STAGE(PG8_SB(0, 0), b2, voffB); PG8_STAGE(PG8_SB(0, 1), b2 + hstepB, voffB); PG8_STAGE(PG8_SA(0, 0), a2, voffA);
            PG8_WAIT_V(8); PG8_WAIT_L(0); PG8_BAR; PG8_MMA(1, 0, At, B0); PG8_MMA(1, 1, At, B1); PG8_BAR; PG8_SCHED;
            PG8_LDB(B0, 1, 0); PG8_LDB(B1, 1, 1); PG8_SCHED; PG8_LDA(At, 1, 0); PG8_STAGE(PG8_SA(0, 1), a2 + hstepA, voffA);
            PG8_WAIT_V(8); PG8_WAIT_L(0); PG8_BAR; PG8_MMA(0, 0, At, B0); PG8_MMA(0, 1, At, B1); PG8_BAR; PG8_SCHED;
            PG8_LDA(At, 1, 1); PG8_STAGE(PG8_SB(1, 0), b3, voffB); PG8_STAGE(PG8_SB(1, 1), b3 + hstepB, voffB); PG8_STAGE(PG8_SA(1, 0), a3, voffA);
            PG8_WAIT_V(8); PG8_WAIT_L(0); PG8_BAR; PG8_MMA(1, 0, At, B0); PG8_MMA(1, 1, At, B1); PG8_BAR; PG8_SCHED;
            } else {
            PG8_LDB(B0, 0, 0); PG8_SCHED; PG8_LDA(At, 0, 0); PG8_STAGE(PG8_SA(1, 1), a1 + hstepA, voffA);
            PG8_WAIT_L(8); PG8_BAR; PG8_WAIT_L(0); PG8_MMA(0, 0, At, B0); PG8_BAR; PG8_SCHED;
            PG8_LDB(B1, 0, 1); PG8_STAGE(PG8_SB(0, 0), b2, voffB);
            PG8_BAR; PG8_WAIT_L(0); PG8_MMA(0, 1, At, B1); PG8_BAR;
            PG8_LDA(At, 0, 1); PG8_STAGE(PG8_SA(0, 0), a2, voffA);
            PG8_BAR; PG8_WAIT_L(0); PG8_MMA(1, 0, At, B0); PG8_BAR; PG8_SCHED;
            PG8_STAGE(PG8_SB(0, 1), b2 + hstepB, voffB);
            PG8_WAIT_V(6); PG8_BAR; PG8_MMA(1, 1, At, B1); PG8_BAR;
            PG8_LDB(B0, 1, 0); PG8_SCHED; PG8_LDA(At, 1, 0); PG8_STAGE(PG8_SA(0, 1), a2 + hstepA, voffA);
            PG8_WAIT_L(8); PG8_BAR; PG8_WAIT_L(0); PG8_MMA(0, 0, At, B0); PG8_BAR; PG8_SCHED;
            PG8_LDB(B1, 1, 1); PG8_STAGE(PG8_SB(1, 0), b3, voffB);
            PG8_BAR; PG8_WAIT_L(0); PG8_MMA(0, 1, At, B1); PG8_BAR;
            PG8_LDA(At, 1, 1); PG8_STAGE(PG8_SA(1, 0), a3, voffA);
            PG8_BAR; PG8_WAIT_L(0); PG8_MMA(1, 0, At, B0); PG8_BAR; PG8_SCHED;
            PG8_STAGE(PG8_SB(1, 1), b3 + hstepB, voffB);
            PG8_WAIT_V(6); PG8_BAR; PG8_MMA(1, 1, At, B1); PG8_BAR;
            }
        }
        if constexpr (ALIGN_EPI) { if (wr == 0) PG8_BAR; }
        E(acc, cur, wr, wc, fr, fq, xch, wid);
        if (!has_next) break;
#pragma unroll
        for (int a = 0; a < 2; ++a)
#pragma unroll
            for (int b = 0; b < 2; ++b)
#pragma unroll
                for (int m = 0; m < 4; ++m)
#pragma unroll
                    for (int n = 0; n < 2; ++n) acc[a][b][m][n] = (f32x4){0.f, 0.f, 0.f, 0.f};
        cur = nxt; cA = nA; cB = nB; ++ui;
        if constexpr (ALIGN_EPI) { if (wr == 1) PG8_BAR; }
    }
    PG8_WAIT_V(0);
    if constexpr (!ALIGN_EPI) { if (wr == 0) PG8_BAR; }
    PG8_BAR;
#undef PG8_SA
#undef PG8_SB
#undef PG8_STAGE
#undef PG8_LDA
#undef PG8_LDB
#undef PG8_MMA
#undef PG8_WAIT_V
#undef PG8_WAIT_L
#undef PG8_BAR
#undef PG8_SCHED
}
}

#include <hip/hip_bf16.h>
#include <cmath>
namespace attn_body {
using bf16=__hip_bfloat16;
using bf16x8=__attribute__((ext_vector_type(8)))short;
using s16x4=__attribute__((ext_vector_type(4)))short;
using f32x16=__attribute__((ext_vector_type(16)))float;
using u32x4=__attribute__((ext_vector_type(4)))unsigned;
constexpr int BATCH=16,NHEAD=8,SEQ=2048,D=64,QP=512,KP=128,OP=1024;
constexpr int NW=8,QBLK=32,QB=QBLK*NW,KVBLK=64,NQB=SEQ/QB;
__device__ __forceinline__ int crow(int r,int hi){return (r&3)+8*(r>>2)+4*hi;}
#define SBAR() __builtin_amdgcn_sched_barrier(0)
__device__ __forceinline__ void cmask(f32x16&p0,f32x16&p1,int jb,int qrel,int hi){
  const float NEG=-INFINITY; int kb=64*jb+4*hi;
  #pragma unroll
  for(int r=0;r<16;++r){int kv=kb+(r&3)+8*(r>>2); if(kv>qrel)p0[r]=NEG; if(kv+32>qrel)p1[r]=NEG;}
}

constexpr int NSLOT=3, SLOTB=8192;
constexpr int LDS_K=0, LDS_V=NSLOT*SLOTB, LDS_WS=2*NSLOT*SLOTB, LDS_OST=LDS_WS+NW*64*4, LDS_BYTES=LDS_OST+NW*4096;
constexpr float C2=0.125f*1.4426950408889634f;
__device__ __forceinline__ void glds16(const void*gsrc,unsigned lds_dst){unsigned keep;
  asm volatile("s_mov_b32 %0, m0\n\ts_mov_b32 m0, %2\n\ts_nop 0\n\tglobal_load_lds_dwordx4 %1, off\n\ts_mov_b32 m0, %0":"=&s"(keep):"v"(gsrc),"s"(lds_dst):"memory");}
__device__ __forceinline__ float max3f(float a,float b,float c){float r;asm("v_max3_f32 %0, %1, %2, %3":"=v"(r):"v"(a),"v"(b),"v"(c));return r;}
__device__ __forceinline__ float max2f(float a,float b){float r;asm("v_max_f32_e32 %0, %1, %2":"=v"(r):"v"(a),"v"(b));return r;}
__device__ __forceinline__ float fadd_s(float a,float b){float r;asm("v_add_f32_e32 %0, %1, %2":"=v"(r):"v"(a),"v"(b));return r;}
__device__ __forceinline__ float fsub_s(float a,float b){float r;asm("v_sub_f32_e32 %0, %1, %2":"=v"(r):"v"(a),"v"(b));return r;}
typedef float f32x2_t __attribute__((ext_vector_type(2))); typedef __bf16 bf16x2_t __attribute__((ext_vector_type(2)));
__device__ __forceinline__ unsigned cvtpk_s(float lo,float hi){f32x2_t v={lo,hi};bf16x2_t b=__builtin_convertvector(v,bf16x2_t);return __builtin_bit_cast(unsigned,b);}
#define WAIT_BAR(N) asm volatile("s_waitcnt vmcnt(" #N ") lgkmcnt(0)\n\ts_barrier":::"memory")

__device__ __forceinline__ void qkt(f32x16&p0,f32x16&p1,const char*Kslot,const bf16x8*qr,const f32x16&negm,int r32,int hi){
  const char*kb=Kslot+hi*1024+r32*16;
  #pragma unroll
  for(int d0=0;d0<4;++d0){
    const bf16x8 b0=*reinterpret_cast<const bf16x8*>(kb+d0*2048);
    const bf16x8 b1=*reinterpret_cast<const bf16x8*>(kb+d0*2048+512);
    if(d0==0){p0=__builtin_amdgcn_mfma_f32_32x32x16_bf16(b0,qr[0],negm,0,0,0);p1=__builtin_amdgcn_mfma_f32_32x32x16_bf16(b1,qr[0],negm,0,0,0);}
    else{p0=__builtin_amdgcn_mfma_f32_32x32x16_bf16(b0,qr[d0],p0,0,0,0);p1=__builtin_amdgcn_mfma_f32_32x32x16_bf16(b1,qr[d0],p1,0,0,0);}}
}
typedef __attribute__((address_space(3))) const char* lds_cptr;
typedef short v4i16_t __attribute__((ext_vector_type(4)));
__device__ __forceinline__ void kload8(bf16x8*kf,lds_cptr kp){
  kf[0]=*(const __attribute__((address_space(3))) bf16x8*)(kp);      kf[1]=*(const __attribute__((address_space(3))) bf16x8*)(kp+512);
  kf[2]=*(const __attribute__((address_space(3))) bf16x8*)(kp+2048); kf[3]=*(const __attribute__((address_space(3))) bf16x8*)(kp+2560);
  kf[4]=*(const __attribute__((address_space(3))) bf16x8*)(kp+4096); kf[5]=*(const __attribute__((address_space(3))) bf16x8*)(kp+4608);
  kf[6]=*(const __attribute__((address_space(3))) bf16x8*)(kp+6144); kf[7]=*(const __attribute__((address_space(3))) bf16x8*)(kp+6656);
}
__device__ __forceinline__ void kload2(bf16x8*kf,lds_cptr kp,int j){ kf[2*j]=*(const __attribute__((address_space(3))) bf16x8*)(kp+j*2048); kf[2*j+1]=*(const __attribute__((address_space(3))) bf16x8*)(kp+j*2048+512); }
__device__ __forceinline__ s16x4 vtr(lds_cptr p){ return __builtin_bit_cast(s16x4,__builtin_amdgcn_ds_read_tr16_b64_v4i16((__attribute__((address_space(3))) v4i16_t*)p)); }
__device__ __forceinline__ float rowmax(const f32x16&p0,const f32x16&p1){
  float a=max3f(p0[0],p0[1],p1[0]),b=max3f(p0[2],p0[3],p1[1]);a=max3f(a,p1[2],p1[3]);
  #pragma unroll
  for(int r=4;r<16;r+=4){a=max3f(a,p0[r],p0[r+1]);b=max3f(b,p0[r+2],p0[r+3]);a=max3f(a,p1[r],p1[r+1]);b=max3f(b,p1[r+2],p1[r+3]);}
  const float m=max2f(a,b);
  auto rr=__builtin_amdgcn_permlane32_swap(__float_as_uint(m),__float_as_uint(m),false,false);
  return max2f(__uint_as_float(rr[0]),__uint_as_float(rr[1]));
}
__device__ __forceinline__ void pv(f32x16*o,int vb,bf16x8 pa0,bf16x8 pa1,bf16x8 pa2,bf16x8 pa3){
  #pragma unroll
  for(int d0=0;d0<2;++d0){s16x4 lo[4],hi[4];
    #pragma unroll
    for(int ks=0;ks<4;++ks){
      asm volatile("ds_read_b64_tr_b16 %0,%1 offset:%c2":"=&v"(lo[ks]):"v"(vb),"i"(d0*4096+ks*1024):"memory");
      asm volatile("ds_read_b64_tr_b16 %0,%1 offset:%c2":"=&v"(hi[ks]):"v"(vb),"i"(d0*4096+ks*1024+512):"memory");}
    asm volatile("s_waitcnt lgkmcnt(0)":::"memory");SBAR();
    #define PK(k) (bf16x8){lo[k][0],lo[k][1],lo[k][2],lo[k][3],hi[k][0],hi[k][1],hi[k][2],hi[k][3]}
    o[d0]=__builtin_amdgcn_mfma_f32_32x32x16_bf16(pa0,PK(0),o[d0],0,0,0);
    o[d0]=__builtin_amdgcn_mfma_f32_32x32x16_bf16(pa1,PK(1),o[d0],0,0,0);
    o[d0]=__builtin_amdgcn_mfma_f32_32x32x16_bf16(pa2,PK(2),o[d0],0,0,0);
    o[d0]=__builtin_amdgcn_mfma_f32_32x32x16_bf16(pa3,PK(3),o[d0],0,0,0);
    #undef PK
  }
}

#ifndef ATTN_STORE16
#define ATTN_STORE16(p,v) (*(u32x4*)(p)=(v))
#endif
template<int THRL> __device__ __forceinline__ void attn_unit(int b,int h,int qb,const bf16*Q,const bf16*__restrict__ K,const bf16*__restrict__ V,bf16*O,char*shm){
  const int tid=threadIdx.x,lane=tid&63,r32=lane&31,hi=lane>>5; const int wid=__builtin_amdgcn_readfirstlane(tid>>6);
  const long rowbase=(long)b*SEQ; const int q0=qb*QB;
  const bf16*Qw=Q+(rowbase+q0+wid*QBLK)*QP+h*D;
  const bf16*Kh=K+rowbase*KP+(h>>2)*D,*Vh=V+rowbase*KP+(h>>2)*D;
  const unsigned lds0=(unsigned)(uintptr_t)shm;
  float*wsf=(float*)(shm+LDS_WS)+wid*64;
  const bf16*ksrc=Kh+(long)lane*KP+wid*8;
  const bf16*vsrc=Vh+(long)(16*(wid&3)+(lane>>2))*KP+(wid>>2)*32+(lane&3)*8;
  const unsigned kdst=lds0+LDS_K+wid*1024, vdst=lds0+LDS_V+wid*1024;
  #define DMA_K(t,slot) glds16(ksrc+(long)(t)*KVBLK*KP,(unsigned)__builtin_amdgcn_readfirstlane(kdst+(slot)))
  #define DMA_V(t,slot) glds16(vsrc+(long)(t)*KVBLK*KP,(unsigned)__builtin_amdgcn_readfirstlane(vdst+(slot)))
  const int vb0=(int)(lds0+LDS_V)+((lane>>4)&1)*32+(lane&3)*8+(4*hi+((lane&15)>>2))*64;
  const char*Kbase=shm+LDS_K; bf16x8 kf[8];
  const lds_cptr shm3=(lds_cptr)shm; const lds_cptr kp0=shm3+LDS_K+hi*1024+r32*16; const lds_cptr vp0=shm3+LDS_V+((lane>>4)&1)*32+(lane&3)*8+(4*hi+((lane&15)>>2))*64;
  constexpr int NT=SEQ/KVBLK;
  DMA_K(0,0);DMA_V(0,0);DMA_K(1,SLOTB);
  bf16x8 qr[4];
  #pragma unroll
  for(int d0=0;d0<4;++d0)qr[d0]=*reinterpret_cast<const bf16x8*>(&Qw[(long)r32*QP+d0*16+hi*8]);
  float mhat=0.f,l_reg=0.f;f32x16 o[2];o[0]=f32x16{};o[1]=f32x16{};f32x16 negm=f32x16{};asm volatile("":"+v"(negm));
  #define CMASK(P0,P1,t) do{}while(0)
  bool resc=false;
  #define START(P0,P1) do{ const float rm=rowmax(P0,P1); resc=false; \
    { const float dl=rm; mhat=fadd_s(mhat,dl); \
      _Pragma("unroll") for(int r=0;r<16;++r){P0[r]=fsub_s(P0[r],dl);P1[r]=fsub_s(P1[r],dl);} \
      _Pragma("unroll") for(int r=0;r<16;++r)negm[r]=-mhat; asm volatile("":"+v"(negm)); } \
    _Pragma("unroll") for(int r=0;r<16;++r)P0[r]=__builtin_amdgcn_exp2f(P0[r]); }while(0)
  #define RESC() do{ if(resc){ asm volatile("s_waitcnt lgkmcnt(0)":::"memory"); \
      _Pragma("unroll") for(int d_=0;d_<2;++d_) _Pragma("unroll") for(int r=0;r<16;++r)o[d_][r]*=wsf[crow(r,hi)]; } }while(0)
  f32x16 pA0,pA1,pB0,pB1;
  int sl_prev=0,sl_cur=0,sl_next=SLOTB;
  #define ROT() do{sl_prev=sl_cur;sl_cur=sl_next;sl_next=(sl_next==(NSLOT-1)*SLOTB)?0:sl_next+SLOTB;}while(0)
  DMA_K(2,2*SLOTB);
  WAIT_BAR(3);
  qkt(pA0,pA1,Kbase,qr,negm,r32,hi);asm volatile("s_nop 15\n\ts_nop 7":"+v"(pA0),"+v"(pA1));CMASK(pA0,pA1,0);
  START(pA0,pA1);
  _Pragma("unroll") for(int r=0;r<16;++r)pA1[r]=__builtin_amdgcn_exp2f(pA1[r]);
  WAIT_BAR(0);
  DMA_K(3,0);DMA_V(1,SLOTB);
  ROT();
  kload8(kf,kp0+sl_cur);
  WAIT_BAR(2);
  s16x4 vlo[8],vhi[8]; u32x4 pw0,pw1,pw2,pw3;
  #define PKW(P,B) cvtpk_s(P[B],P[B+1])
  #define PAF(k) __builtin_bit_cast(bf16x8,pw##k)
  #define VFR(i) (bf16x8){vlo[i][0],vlo[i][1],vlo[i][2],vlo[i][3],vhi[i][0],vhi[i][1],vhi[i][2],vhi[i][3]}
  #define PIN(x) asm volatile("":"+v"(x))
  #define MX3(a,b,c) __builtin_fmaxf(__builtin_fmaxf((a),(b)),(c))
  #define GAPA(MF,A0,A1,A2,A3,W0,W1,PW) do{ MF; sacc+=A0; sacc+=A1; sacc+=A2; sacc+=A3; PIN(sacc); W0; W1; PIN(PW); SBAR(); }while(0)
  #define EX(v) __builtin_amdgcn_exp2f(v)
  #define GAPB(MF,X,B) do{ MF; X[B]=EX(X[B]); X[B+1]=EX(X[B+1]); X[B+2]=EX(X[B+2]); X[B+3]=EX(X[B+3]); PIN(X); SBAR(); }while(0)
  #define VRD(i) do{ vlo[i]=vtr(vp_+(((i)>>2)*4096+((i)&3)*1024)); vhi[i]=vtr(vp_+(((i)>>2)*4096+((i)&3)*1024+512)); }while(0)
  #define KRD(G,j) do{ if(G){ kload2(kf,kp0+sl_next,j); SBAR(); } }while(0)
  #define STEP(C0,C1,P0,P1,t,GK,GV,GL) do{ SBAR(); \
    const lds_cptr vp_=vp0+sl_prev; \
    VRD(0); SBAR(); float sacc=(P0[0]+P0[1]); \
    GAPA(C0=__builtin_amdgcn_mfma_f32_32x32x16_bf16(kf[0],qr[0],negm,0,0,0), P0[2],P0[3],P0[4],P0[5],     pw0[0]=PKW(P0,0), pw0[1]=PKW(P0,2), pw0); \
    VRD(4); SBAR(); GAPA(C1=__builtin_amdgcn_mfma_f32_32x32x16_bf16(kf[1],qr[0],negm,0,0,0), P0[6],P0[7],P0[8],P0[9],     pw0[2]=PKW(P0,4), pw0[3]=PKW(P0,6), pw0); \
    VRD(1); SBAR(); GAPA(C0=__builtin_amdgcn_mfma_f32_32x32x16_bf16(kf[2],qr[1],C0,0,0,0),   P0[10],P0[11],P0[12],P0[13], pw1[0]=PKW(P0,8), pw1[1]=PKW(P0,10), pw1); \
    VRD(5); SBAR(); GAPA(C1=__builtin_amdgcn_mfma_f32_32x32x16_bf16(kf[3],qr[1],C1,0,0,0),   P0[14],P0[15],P1[0],P1[1],   pw1[2]=PKW(P0,12),pw1[3]=PKW(P0,14), pw1); \
    VRD(2); SBAR(); GAPA(C0=__builtin_amdgcn_mfma_f32_32x32x16_bf16(kf[4],qr[2],C0,0,0,0),   P1[2],P1[3],P1[4],P1[5],     pw2[0]=PKW(P1,0), pw2[1]=PKW(P1,2), pw2); \
    VRD(6); SBAR(); GAPA(C1=__builtin_amdgcn_mfma_f32_32x32x16_bf16(kf[5],qr[2],C1,0,0,0),   P1[6],P1[7],P1[8],P1[9],     pw2[2]=PKW(P1,4), pw2[3]=PKW(P1,6), pw2); \
    VRD(3); SBAR(); GAPA(C0=__builtin_amdgcn_mfma_f32_32x32x16_bf16(kf[6],qr[3],C0,0,0,0),   P1[10],P1[11],P1[12],P1[13], pw3[0]=PKW(P1,8), pw3[1]=PKW(P1,10), pw3); \
    VRD(7); SBAR(); GAPA(C1=__builtin_amdgcn_mfma_f32_32x32x16_bf16(kf[7],qr[3],C1,0,0,0),   P1[14],P1[15],0.f,0.f,       pw3[2]=PKW(P1,12),pw3[3]=PKW(P1,14), pw3); \
    l_reg+=sacc; \
    if(GK){DMA_K((t)+3,sl_cur);} if(GV){DMA_V((t)+1,sl_next);} \
    CMASK(C0,C1,t); \
    { float a=MX3(C0[0],C0[1],C1[0]),b=MX3(C0[2],C0[3],C1[1]); a=MX3(a,C1[2],C1[3]); \
      _Pragma("unroll") for(int r=4;r<16;r+=4){a=MX3(a,C0[r],C0[r+1]);b=MX3(b,C0[r+2],C0[r+3]);a=MX3(a,C1[r],C1[r+1]);b=MX3(b,C1[r+2],C1[r+3]);} \
      float rm=__builtin_fmaxf(a,b); { auto rr=__builtin_amdgcn_permlane32_swap(__float_as_uint(rm),__float_as_uint(rm),false,false); rm=__builtin_fmaxf(__uint_as_float(rr[0]),__uint_as_float(rr[1])); } \
      resc=false; \
      if(__builtin_expect(__any(rm>(float)THRL),0)){ const float dl=__builtin_fmaxf(rm,0.f); mhat+=dl; \
        _Pragma("unroll") for(int r=0;r<16;++r){C0[r]-=dl;C1[r]-=dl;} \
        _Pragma("unroll") for(int r=0;r<16;++r)negm[r]=-mhat; asm volatile("":"+v"(negm)); \
        const float f=__builtin_amdgcn_exp2f(-dl); l_reg*=f; if(hi==0)wsf[r32]=f; resc=true; } } \
    SBAR(); \
    GAPB(o[0]=__builtin_amdgcn_mfma_f32_32x32x16_bf16(PAF(0),VFR(0),o[0],0,0,0), C0,0); \
    GAPB(o[1]=__builtin_amdgcn_mfma_f32_32x32x16_bf16(PAF(0),VFR(4),o[1],0,0,0), C0,4); \
    KRD(GL,0); GAPB(o[0]=__builtin_amdgcn_mfma_f32_32x32x16_bf16(PAF(1),VFR(1),o[0],0,0,0), C0,8); \
    KRD(GL,1); GAPB(o[1]=__builtin_amdgcn_mfma_f32_32x32x16_bf16(PAF(1),VFR(5),o[1],0,0,0), C0,12); \
    KRD(GL,2); GAPB(o[0]=__builtin_amdgcn_mfma_f32_32x32x16_bf16(PAF(2),VFR(2),o[0],0,0,0), C1,0); \
    KRD(GL,3); GAPB(o[1]=__builtin_amdgcn_mfma_f32_32x32x16_bf16(PAF(2),VFR(6),o[1],0,0,0), C1,4); \
    GAPB(o[0]=__builtin_amdgcn_mfma_f32_32x32x16_bf16(PAF(3),VFR(3),o[0],0,0,0), C1,8); \
    GAPB(o[1]=__builtin_amdgcn_mfma_f32_32x32x16_bf16(PAF(3),VFR(7),o[1],0,0,0), C1,12); \
    }while(0)
  int t=1;
  #undef CMASK
  #define CMASK(P0,P1,t) do{}while(0)
  for(;t+5<NT;t+=2){
    STEP(pB0,pB1,pA0,pA1,t,true,true,true);     WAIT_BAR(2); RESC(); ROT();
    STEP(pA0,pA1,pB0,pB1,t+1,true,true,true);   WAIT_BAR(2); RESC(); ROT();
  }
  #undef CMASK
  #define CMASK(P0,P1,t) do{}while(0)
  #define ENDW(tt) do{ if((tt)+3<NT){WAIT_BAR(2);} else if((tt)+2<NT){WAIT_BAR(1);} else {WAIT_BAR(0);} }while(0)
  for(;t+1<NT;t+=2){
    STEP(pB0,pB1,pA0,pA1,t,(t+3<NT),(t+1<NT),(t+1<NT));       ENDW(t);   RESC(); ROT();
    STEP(pA0,pA1,pB0,pB1,t+1,(t+4<NT),(t+2<NT),(t+2<NT));     ENDW(t+1); RESC(); ROT();
  }
  STEP(pB0,pB1,pA0,pA1,NT-1,false,false,false); RESC();
  { float sacc=pB0[0]+pB0[1]; _Pragma("unroll") for(int r=2;r<16;++r)sacc+=pB0[r]; _Pragma("unroll") for(int r=0;r<16;++r)sacc+=pB1[r]; l_reg+=sacc;
    pw0=(u32x4){PKW(pB0,0),PKW(pB0,2),PKW(pB0,4),PKW(pB0,6)};pw1=(u32x4){PKW(pB0,8),PKW(pB0,10),PKW(pB0,12),PKW(pB0,14)};pw2=(u32x4){PKW(pB1,0),PKW(pB1,2),PKW(pB1,4),PKW(pB1,6)};pw3=(u32x4){PKW(pB1,8),PKW(pB1,10),PKW(pB1,12),PKW(pB1,14)};
    SBAR(); pv(o,vb0+sl_cur,PAF(0),PAF(1),PAF(2),PAF(3)); }
  #undef PKW
  #undef PAF
  #undef VFR
  #undef PIN
  #undef MX3
  #undef GAPA
  #undef GAPB
  #undef EX
  #undef VRD
  #undef KRD
  #undef STEP
  #undef ENDW
  {auto rr=__builtin_amdgcn_permlane32_swap(__float_as_uint(l_reg),__float_as_uint(l_reg),false,false);l_reg=__uint_as_float(rr[0])+__uint_as_float(rr[1]);}
  if(hi==0)wsf[32+r32]=l_reg;asm volatile("s_waitcnt lgkmcnt(0)":::"memory");
  float rli[16];
  #pragma unroll
  for(int r=0;r<16;++r)rli[r]=__builtin_amdgcn_rcpf(wsf[32+crow(r,hi)]);
  bf16*Ow=O+(rowbase+q0+wid*QBLK)*OP+h*D;
  { bf16*stg=(bf16*)(shm+LDS_OST)+wid*2048;
    #pragma unroll
    for(int r=0;r<16;++r){const int orow=crow(r,hi);
      #pragma unroll
      for(int d0=0;d0<2;++d0)stg[orow*64+d0*32+r32]=__float2bfloat16(o[d0][r]*rli[r]);}
    asm volatile("s_waitcnt lgkmcnt(0)":::"memory");
    #pragma unroll
    for(int i=0;i<4;++i){const int row=i*8+(lane>>3),ch=lane&7; const u32x4 v=*(const u32x4*)(stg+row*64+ch*8); ATTN_STORE16(Ow+(long)row*OP+ch*8,v);} }
  asm volatile("s_waitcnt lgkmcnt(0)\n\ts_barrier":::"memory");
  #undef DMA_K
  #undef DMA_V
  #undef CMASK
  #undef START
  #undef RESC
  #undef ROT
}
constexpr int ATTN_LDS_BYTES=LDS_BYTES;
template<int THRL=8> __device__ __forceinline__ void attn_phase(char*lds,const bf16*Q,const bf16*K,const bf16*V,bf16*O,int vcu,int G){
  for(int u=vcu;u<BATCH*NHEAD*(SEQ/QB);u+=G){ const int grp=u>>5, r=u&31; const int b=grp>>1, kvh=grp&1, hq=r>>3, qb=r&7; attn_unit<THRL>(b,kvh*4+hq,qb,Q,K,V,O,lds); }
}
#undef SBAR
#undef WAIT_BAR
}

constexpr size_t MiB = 1u << 20;
constexpr size_t WS_CTL = 0, CTL_ZERO_BYTES = 16384;
constexpr size_t WS_ROPE = 1 * MiB, WS_SS = 2 * MiB;
constexpr size_t WS_WIN = 4 * MiB, WS_WXKV = 11 * MiB, WS_WCAT = 15 * MiB, WS_WOUT = 17 * MiB, WS_WXQ = 19 * MiB, WS_WXO = 21 * MiB, WS_WFF1 = 23 * MiB, WS_WFF2 = 31 * MiB;
constexpr size_t WS_MN = 40 * MiB, WS_XK = 48 * MiB, WS_XVT = 56 * MiB, WS_HB = 64 * MiB;
constexpr size_t WS_R1 = 128 * MiB;
constexpr size_t WS_R2 = 192 * MiB;
constexpr size_t WS_R3 = 256 * MiB;
constexpr size_t WS_G = 320 * MiB;
constexpr size_t WS_F = 128 * MiB;
constexpr size_t WS_END = 448 * MiB;

constexpr int NWAVES = 8;
constexpr int RING_BYTES = 131072, XCH_OFF = RING_BYTES, MISC_OFF = XCH_OFF + 8192, LDS_BYTES = 147456;
#define GAS __attribute__((address_space(1)))
#define LAS __attribute__((address_space(3)))
typedef unsigned short bf16;
typedef unsigned v4u __attribute__((ext_vector_type(4)));
typedef float f32x4 __attribute__((ext_vector_type(4)));

__device__ __forceinline__ unsigned f2bf(float f) { unsigned u = __builtin_bit_cast(unsigned, f); return (u + 0x7fffu + ((u >> 16) & 1u)) >> 16; }
__device__ __forceinline__ unsigned pk2(float lo, float hi) { return f2bf(lo) | (f2bf(hi) << 16); }
__device__ __forceinline__ float wave_sum(float v) {
#pragma unroll
    for (int o = 1; o < 64; o <<= 1) v += __shfl_xor(v, o);
    return v;
}
#define LDS_WAIT() asm volatile("s_waitcnt lgkmcnt(0)" ::: "memory")

__device__ __forceinline__ void p0_transpose_item(const float* W, int ldw, bf16* WT, int ldt, LAS float* scr, int item, int nblk, int lane, const float* gk) {
    const int kb = item / nblk, nb = item % nblk, k0 = 64 * kb, n0 = 32 * nb;
#pragma unroll 8
    for (int i = 0; i < 32; ++i) { const int kk = 2 * i + (lane >> 5); float v = W[(size_t)(k0 + kk) * ldw + n0 + (lane & 31)]; if (gk) v *= gk[k0 + kk]; scr[kk * 33 + (lane & 31)] = v; }
    LDS_WAIT(); asm volatile("" ::: "memory");
    const int c = lane & 7;
#pragma unroll
    for (int j = 0; j < 4; ++j) { const int n = (lane >> 3) + 8 * j; const LAS float* s = scr + (8 * c) * 33 + n;
        v4u o; o.x = pk2(s[0 * 33], s[1 * 33]); o.y = pk2(s[2 * 33], s[3 * 33]); o.z = pk2(s[4 * 33], s[5 * 33]); o.w = pk2(s[6 * 33], s[7 * 33]);
        *(v4u*)(WT + (size_t)(n0 + n) * ldt + k0 + 8 * c) = o; }
    LDS_WAIT(); asm volatile("" ::: "memory");
}
__device__ __forceinline__ void rms_row_to_bf16(const float* xrow, const float* g, bf16* orow, int lane) {
    const f32x4* xr = (const f32x4*)xrow + lane; const f32x4* gr = (const f32x4*)g + lane;
    f32x4 v[4]; float s = 0.f;
#pragma unroll
    for (int j = 0; j < 4; ++j) { v[j] = xr[64 * j]; s += (v[j].x * v[j].x + v[j].y * v[j].y) + (v[j].z * v[j].z + v[j].w * v[j].w); }
    const float rs = 1.0f / sqrtf(wave_sum(s) * (1.f / 1024.f) + EPS);
    unsigned long long* o8 = (unsigned long long*)orow + lane;
#pragma unroll
    for (int j = 0; j < 4; ++j) { const f32x4 gg = gr[64 * j]; o8[64 * j] = (unsigned long long)pk2(v[j].x * rs * gg.x, v[j].y * rs * gg.y) | ((unsigned long long)pk2(v[j].z * rs * gg.z, v[j].w * rs * gg.w) << 32); }
}

typedef GAS unsigned gu32;
#define RLX_AGENT __ATOMIC_RELAXED, __HIP_MEMORY_SCOPE_AGENT
#define XB_TMO      128
#define XB_XCNT(j)  (256  + 64 * (j))
#define XB_XSUB(j)  (1280 + 64 * (j))
#define XB_XGEN(j)  (2304 + 64 * (j))
#define XB_TOP      3328
#define XB_TOPGEN   3392
#define XCD_BAR_WORDS 3456
#define XB_SPIN_CAP (1u << 18)

__device__ __forceinline__ unsigned xb_ld(unsigned* p)              { return __hip_atomic_load(p, __ATOMIC_RELAXED, __HIP_MEMORY_SCOPE_AGENT); }
__device__ __forceinline__ unsigned xb_add(unsigned* p, unsigned v) { return __hip_atomic_fetch_add(p, v, __ATOMIC_RELAXED, __HIP_MEMORY_SCOPE_AGENT); }
__device__ __forceinline__ unsigned xb_xcc_id() { return (unsigned)__builtin_amdgcn_s_getreg((3 << 11) | 20) & 0xFu; }
#define XB_SPIN(cond, bar) do { unsigned _sp = 0; while (cond) { __builtin_amdgcn_s_sleep(1); \
    if ((++_sp & 255u) == 0u) { if (xb_ld(&(bar)[XB_TMO])) break; if (_sp > XB_SPIN_CAP) { atomicAdd(&(bar)[XB_TMO], 1u); break; } } } } while (0)

struct XcdBarrier {
    unsigned* bar; unsigned x;
    volatile LAS unsigned* st;
};

__device__ __forceinline__ XcdBarrier xcd_barrier_post(unsigned* bar, volatile LAS unsigned* st) {
    XcdBarrier b; b.bar = bar; b.x = xb_xcc_id(); b.st = st;
    if (threadIdx.x == 0) (void)xb_add(&bar[XB_XCNT(b.x)], 1u);
    return b;
}
__device__ __forceinline__ void xcd_barrier_complete(unsigned* bar, unsigned x, unsigned& nloc, unsigned& nx) {
    const unsigned G = gridDim.x * gridDim.y * gridDim.z;
    unsigned sum, cnt, mine, sp = 0u;
    for (;;) {
        sum = 0u; cnt = 0u; mine = 0u;
#pragma unroll
        for (unsigned j = 0; j < 16; ++j) { const unsigned c = xb_ld(&bar[XB_XCNT(j)]); sum += c; cnt += (c > 0u) ? 1u : 0u; mine = (j == x) ? c : mine; }
        if (sum == G) break;
        __builtin_amdgcn_s_sleep(1);
        if ((++sp & 255u) == 0u) { if (xb_ld(&bar[XB_TMO])) break; if (sp > XB_SPIN_CAP) { atomicAdd(&bar[XB_TMO], 1u); break; } }
    }
    nloc = mine > 0u ? mine : 1u; nx = cnt > 0u ? cnt : 1u;
}

__device__ __forceinline__ void xcd_barrier(const XcdBarrier& b) {
    asm volatile("s_waitcnt vmcnt(0)" ::: "memory");
    __syncthreads();
    if (threadIdx.x == 0) {
        unsigned* bar = b.bar;
        __builtin_amdgcn_s_waitcnt(0);
        unsigned nloc = b.st[0], nx = b.st[1];
        if (nloc == 0u) { xcd_barrier_complete(bar, b.x, nloc, nx); b.st[0] = nloc; b.st[1] = nx; }
        const unsigned old = xb_add(&bar[XB_XSUB(b.x)], 1u);
        const unsigned gen = old / nloc;
        if (old + 1u == (gen + 1u) * nloc) {
            __builtin_amdgcn_fence(__ATOMIC_RELEASE, "agent");
            asm volatile("s_waitcnt vmcnt(0)" ::: "memory");
            const unsigned og = xb_add(&bar[XB_TOP], 1u);
            const unsigned tg = og / nx;
            if (og + 1u == (tg + 1u) * nx) xb_add(&bar[XB_TOPGEN], 1u);
            else XB_SPIN(xb_ld(&bar[XB_TOPGEN]) == tg, bar);
            __builtin_amdgcn_fence(__ATOMIC_ACQUIRE, "agent");
            xb_add(&bar[XB_XGEN(b.x)], 1u);
            asm volatile("s_waitcnt vmcnt(0)" ::: "memory");
        } else {
            XB_SPIN(xb_ld(&bar[XB_XGEN(b.x)]) == gen, bar);
            __builtin_amdgcn_fence(__ATOMIC_ACQUIRE, "agent");
            asm volatile("s_waitcnt vmcnt(0)" ::: "memory");
        }
    }
    __syncthreads();
}

struct Args {
    const float* in[21]; float* out; unsigned char* ws; int ph_lo, ph_hi;
};
enum { I_X = 0, I_MEM, I_GMIX, I_WIN, I_BGATE, I_GQ, I_GK, I_WATTN, I_POOLW, I_PSCALE, I_WPOOL, I_WOUT, I_GCROSS, I_GMEM, I_WXQ, I_WXKV, I_WXO, I_GFFN, I_WFF1, I_WFF2, I_GFINAL };
constexpr int N_PHASES = 12;

__global__ void __launch_bounds__(NWAVES * 64, 2) mega_fwd(Args args) {
    extern __shared__ __attribute__((aligned(16))) unsigned char lds[];
    LAS unsigned char* ldsp = (LAS unsigned char*)lds;
    LAS float* xch = (LAS float*)(ldsp + XCH_OFF);
    const int tid = threadIdx.x, lane = tid & 63, wave = __builtin_amdgcn_readfirstlane(tid >> 6);
    const int G = gridDim.x; const int bx = blockIdx.x;
    const int vcu = (G % 8 == 0) ? (bx % 8) * (G / 8) + bx / 8 : bx;
    unsigned char* ws = args.ws;
    const int lo = args.ph_lo, hi = args.ph_hi;
    bf16* Win_t = (bf16*)(ws + WS_WIN); bf16* Wxkv_t = (bf16*)(ws + WS_WXKV); bf16* Wcat_t = (bf16*)(ws + WS_WCAT); bf16* Wout_t = (bf16*)(ws + WS_WOUT);
    bf16* Wxq_t = (bf16*)(ws + WS_WXQ); bf16* Wxo_t = (bf16*)(ws + WS_WXO); bf16* Wff1_t = (bf16*)(ws + WS_WFF1); bf16* Wff2_t = (bf16*)(ws + WS_WFF2);
    float* ROPE = (float*)(ws + WS_ROPE); float* SS = (float*)(ws + WS_SS);
    bf16* MNb = (bf16*)(ws + WS_MN); bf16* XK = (bf16*)(ws + WS_XK); bf16* XVT = (bf16*)(ws + WS_XVT); bf16* HB = (bf16*)(ws + WS_HB);
    bf16* N1 = (bf16*)(ws + WS_R1); bf16* AP = (bf16*)(ws + WS_R1); bf16* Pm = (bf16*)(ws + WS_R1);
    bf16* Qb = (bf16*)(ws + WS_R2); bf16* Kb = (bf16*)(ws + WS_R2 + 32 * MiB); bf16* Vb = (bf16*)(ws + WS_R2 + 40 * MiB); bf16* MIX = (bf16*)(ws + WS_R2); bf16* XO = (bf16*)(ws + WS_R2);
    bf16* Ub = (bf16*)(ws + WS_R3); bf16* XQ = (bf16*)(ws + WS_R3);
    bf16* Gt = (bf16*)(ws + WS_G); bf16* Fb = (bf16*)(ws + WS_F);
    float* OUT = args.out;

    volatile LAS unsigned* MISC = (volatile LAS unsigned*)(ldsp + MISC_OFF);
    if (tid < 32) MISC[tid] = 0u;
    __syncthreads();
    XcdBarrier bar; bar.bar = (unsigned*)(ws + WS_CTL); bar.x = 0; bar.st = nullptr;
    if (!MK_PER_PHASE) bar = xcd_barrier_post((unsigned*)(ws + WS_CTL), MISC + 8);
    if (hi > 1000) cg::this_grid().sync();
#ifndef PHASE_MASK
#define PHASE_MASK 0xFFF
#endif
#define IN(k) (((PHASE_MASK >> (k)) & 1) && lo <= (k) && (k) < hi)
#ifndef REPEAT_MASK
#define REPEAT_MASK 0
#endif
#ifndef EXTRA_SYNCS
#define EXTRA_SYNCS 0
#endif
#define PHASE(k) if (IN(k)) for (int rep_ = 0; rep_ <= ((REPEAT_MASK >> (k)) & 1); ++rep_)
#define REP_SYNC() do { if (rep_) xcd_barrier(bar); } while (0)
#define SEAM(k) do { if (IN(k) && IN((k) + 1)) { xcd_barrier(bar); } } while (0)
    const int gw = vcu * NWAVES + wave, NGW = G * NWAVES;

    PHASE(0) { REP_SYNC();
        LAS float* scr = (LAS float*)(ldsp + wave * 16384);
        constexpr int I0 = 16 * 104, I1 = 16 * 64, I2 = 8 * 32, I3 = 16 * 32, I4 = 16 * 32, I5 = 16 * 32, I6 = 16 * 128, I7 = 64 * 32, IFOLD = 1024;
        constexpr int NITEMS = I0 + I1 + I2 + I3 + I4 + I5 + I6 + I7 + IFOLD;
        for (int it = gw; it < NITEMS; it += NGW) {
            int r = it;
            if (r < I0) { p0_transpose_item(args.in[I_WIN], INW, Win_t, 1024, scr, r, 104, lane, nullptr); continue; } r -= I0;
            if (r < I1) { p0_transpose_item(args.in[I_WXKV], 2048, Wxkv_t, 1024, scr, r, 64, lane, nullptr); continue; } r -= I1;
            if (r < I2) { p0_transpose_item(args.in[I_WATTN], 1024, Wcat_t, 1024, scr, r, 32, lane, nullptr); continue; } r -= I2;
            if (r < I3) { p0_transpose_item(args.in[I_WOUT], 1024, Wout_t, 1024, scr, r, 32, lane, nullptr); continue; } r -= I3;
            if (r < I4) { p0_transpose_item(args.in[I_WXQ], 1024, Wxq_t, 1024, scr, r, 32, lane, args.in[I_GCROSS]); continue; } r -= I4;
            if (r < I5) { p0_transpose_item(args.in[I_WXO], 1024, Wxo_t, 1024, scr, r, 32, lane, nullptr); continue; } r -= I5;
            if (r < I6) { p0_transpose_item(args.in[I_WFF1], 4096, Wff1_t, 1024, scr, r, 128, lane, args.in[I_GFFN]); continue; } r -= I6;
            if (r < I7) { p0_transpose_item(args.in[I_WFF2], 1024, Wff2_t, 4096, scr, r, 32, lane, nullptr); continue; } r -= I7;
            {
                const int g = r >> 8, cb = (r >> 4) & 15, nb = r & 15, n = nb * 64 + lane, c0 = cb * 8;
                const float* pw = args.in[I_POOLW] + (size_t)g * 128 * 128 + (size_t)c0 * 128; const float* ps = args.in[I_PSCALE] + g * 128; const float* wp = args.in[I_WPOOL] + (size_t)g * 128 * 1024 + n;
                float a[8];
#pragma unroll
                for (int cc = 0; cc < 8; ++cc) a[cc] = 0.f;
                for (int d = 0; d < 128; ++d) { const float w = wp[(size_t)d * 1024] * ps[d];
#pragma unroll
                    for (int cc = 0; cc < 8; ++cc) a[cc] += pw[cc * 128 + d] * w; }
                v4u o; o.x = pk2(a[0], a[1]); o.y = pk2(a[2], a[3]); o.z = pk2(a[4], a[5]); o.w = pk2(a[6], a[7]);
                *(v4u*)(Wcat_t + (size_t)n * 1024 + 512 + g * 128 + c0) = o;
            }
        }
        {
            const int gt = vcu * NWAVES * 64 + tid;
            if (gt < 1024) { const int pos = gt >> 4, f = gt & 15; const float inv = exp2f(-(float)f * (13.287712379549449f / 16.0f));
                const float ang = (float)pos * inv; float rev = ang * 0.15915494309189535f; rev -= floorf(rev);
                ROPE[gt] = __builtin_amdgcn_cosf(rev); ROPE[1024 + gt] = __builtin_amdgcn_sinf(rev); }
        }
        for (int m = gw; m < TOK + MTOK; m += NGW) {
            if (m < TOK) rms_row_to_bf16(args.in[I_X] + (size_t)m * DM, args.in[I_GMIX], N1 + (size_t)m * DM, lane);
            else rms_row_to_bf16(args.in[I_MEM] + (size_t)(m - TOK) * DM, args.in[I_GMEM], MNb + (size_t)(m - TOK) * DM, lane);
        }
    }
    SEAM(0);

    PHASE(1) { REP_SYNC();
        typedef pg8::ProbP1<(long)WS_R1, (long)WS_WIN, (long)WS_MN, (long)WS_WXKV> P1; P1 S; S.ws = (const char*)ws; S.G = G; S.c = bx; S.K = 1024; S.lda = 1024; S.ldb = 1024; S.mid = -1;
        pg8::EpiP1 E{Qb, Kb, Vb, Ub, Gt, XK, XVT, args.in[I_BGATE], args.in[I_GQ], args.in[I_GK], ROPE};
        pg8::gemm_phase<pg8::EpiP1, P1, true, true>(ldsp, xch, S, E);
    }
    SEAM(1);

    PHASE(2) { REP_SYNC();
        attn_body::attn_phase((char*)lds, (const attn_body::bf16*)Qb, (const attn_body::bf16*)Kb, (const attn_body::bf16*)Vb, (attn_body::bf16*)AP, vcu, G);
        const int grp = lane >> 4, hw = 1 << grp;
        for (int t = gw; t < TOK; t += NGW) {
            const int s = t & (SEQ - 1); const int lo_s = max(s - hw, 0), hi_s = min(s + hw, SEQ);
            const bf16* ub = Ub + (size_t)(t - s) * 512 + lane * 8;
            float a[8];
#pragma unroll
            for (int j = 0; j < 8; ++j) a[j] = 0.f;
            for (int ss = lo_s; ss < hi_s; ++ss) { const v4u w = *(const v4u*)(ub + (size_t)ss * 512);
                a[0] += pg8::bf_lo(w.x); a[1] += pg8::bf_hi(w.x); a[2] += pg8::bf_lo(w.y); a[3] += pg8::bf_hi(w.y); a[4] += pg8::bf_lo(w.z); a[5] += pg8::bf_hi(w.z); a[6] += pg8::bf_lo(w.w); a[7] += pg8::bf_hi(w.w); }
            const v4u w = *(const v4u*)(ub + (size_t)s * 512); const float ic = 1.0f / (float)(hi_s - lo_s);
            v4u o; o.x = pk2(a[0] * ic - pg8::bf_lo(w.x), a[1] * ic - pg8::bf_hi(w.x)); o.y = pk2(a[2] * ic - pg8::bf_lo(w.y), a[3] * ic - pg8::bf_hi(w.y));
            o.z = pk2(a[4] * ic - pg8::bf_lo(w.z), a[5] * ic - pg8::bf_hi(w.z)); o.w = pk2(a[6] * ic - pg8::bf_lo(w.w), a[7] * ic - pg8::bf_hi(w.w));
            *(v4u*)(AP + (size_t)t * 1024 + 512 + lane * 8) = o;
        }
    }
    SEAM(2);

    PHASE(3) { REP_SYNC();
        pg8::ProbMN S = pg8::make_plain(AP, Wcat_t, TOK, 1024, 1024, G, bx); S.mid = 8;
        pg8::EpiMix E{Gt, MIX};
        pg8::gemm_phase<pg8::EpiMix, pg8::ProbMN, true, true>(ldsp, xch, S, E);
    }
    SEAM(3);

    PHASE(4) { REP_SYNC();
        pg8::ProbMN S = pg8::make_plain(MIX, Wout_t, TOK, 1024, 1024, G, bx);
        pg8::EpiRes<true> E{args.in[I_X], OUT, HB, SS};
        pg8::gemm_phase<pg8::EpiRes<true>, pg8::ProbMN, true, true>(ldsp, xch, S, E);
    }
    SEAM(4);

    PHASE(5) { REP_SYNC();
        pg8::ProbMN S = pg8::make_plain(HB, Wxq_t, TOK, 1024, 1024, G, bx);
        pg8::EpiRowScale<0> E{SS, XQ, 1024, XSCALE};
        pg8::gemm_phase<pg8::EpiRowScale<0>, pg8::ProbMN, true, true>(ldsp, xch, S, E);
    }
    SEAM(5);

    PHASE(6) { REP_SYNC();
        pg8::ProbMN S; S.A = XQ; S.B = XK; S.nM = TOK / 256; S.nN = 4; S.G = G; S.c = bx; S.K = 256; S.lda = 1024; S.ldb = 1024; S.mid = -1;
        S.a_pm = 256L * 1024; S.a_pn = 256; S.b_pb = 256L * 1024; S.b_pn = 256;
        pg8::EpiSoftmax E{Pm};
        pg8::gemm_phase<pg8::EpiSoftmax, pg8::ProbMN, true, true>(ldsp, xch, S, E);
    }
    SEAM(6);

    PHASE(7) { REP_SYNC();
        pg8::ProbMN S; S.A = Pm; S.B = XVT; S.nM = TOK / 256; S.nN = 4; S.G = G; S.c = bx; S.K = 256; S.lda = 1024; S.ldb = 4096; S.mid = -1;
        S.a_pm = 256L * 1024; S.a_pn = 256; S.b_pb = 256; S.b_pn = 256L * 4096;
        pg8::EpiPlain E{XO, 1024};
        pg8::gemm_phase<pg8::EpiPlain, pg8::ProbMN, true, true>(ldsp, xch, S, E);
    }
    SEAM(7);

    PHASE(8) { REP_SYNC();
        pg8::ProbMN S = pg8::make_plain(XO, Wxo_t, TOK, 1024, 1024, G, bx);
        pg8::EpiRes<true> E{OUT, OUT, HB, SS};
        pg8::gemm_phase<pg8::EpiRes<true>, pg8::ProbMN, true, true>(ldsp, xch, S, E);
    }
    SEAM(8);

    PHASE(9) { REP_SYNC();
        pg8::ProbMN S = pg8::make_plain(HB, Wff1_t, TOK, 4096, 1024, G, bx);
        pg8::EpiRowScale<1> E{SS, Fb, 4096, 1.0f};
        pg8::gemm_phase<pg8::EpiRowScale<1>, pg8::ProbMN, true, true>(ldsp, xch, S, E);
    }
    SEAM(9);

    PHASE(10) { REP_SYNC();
        pg8::ProbMN S = pg8::make_plain(Fb, Wff2_t, TOK, 1024, 4096, G, bx);
        pg8::EpiRes<false> E{OUT, OUT, HB, SS};
        pg8::gemm_phase<pg8::EpiRes<false>, pg8::ProbMN, true, true>(ldsp, xch, S, E);
    }
    SEAM(10);

    PHASE(11) { REP_SYNC();
        const f32x4* gr = (const f32x4*)args.in[I_GFINAL] + lane;
        for (int m = gw; m < TOK; m += NGW) {
            f32x4* xr = (f32x4*)(OUT + (size_t)m * DM) + lane;
            float s = (lane < 16) ? SS[(size_t)m * 16 + lane] : 0.f; s = wave_sum(s);
            const float rs = 1.0f / sqrtf(s * (1.f / 1024.f) + EPS);
#pragma unroll
            for (int j = 0; j < 4; ++j) { f32x4 v = xr[64 * j]; const f32x4 gg = gr[64 * j]; v = v * rs * gg; xr[64 * j] = v; }
        }
    }
    for (int e_ = 0; e_ < EXTRA_SYNCS; ++e_) xcd_barrier(bar);
#undef IN
#undef SEAM
}

extern "C" void kernel_launch(void* const* d_in, const int* in_sizes, int n_in, void* d_out, int out_size, void* d_ws, size_t ws_size, hipStream_t stream) {
    static int grid = 0;
    if (grid == 0) {
        if (n_in != 21 || in_sizes[0] != TOK * DM || out_size != TOK * DM || ws_size < WS_END) {
            fprintf(stderr, "kernel_launch: unexpected shapes: n_in %d in0 %d out %d ws %zu (need >= %zu)\n", n_in, n_in > 0 ? in_sizes[0] : -1, out_size, ws_size, (size_t)WS_END); grid = -1; return; }
        int dev = 0, cus = 0, per_cu = 0;
        if (hipGetDevice(&dev) != hipSuccess || hipDeviceGetAttribute(&cus, hipDeviceAttributeMultiprocessorCount, dev) != hipSuccess) { grid = -1; return; }
        if (hipFuncSetAttribute((const void*)mega_fwd, hipFuncAttributeMaxDynamicSharedMemorySize, LDS_BYTES) != hipSuccess) { fprintf(stderr, "kernel_launch: hipFuncSetAttribute failed\n"); grid = -1; return; }
        if (hipOccupancyMaxActiveBlocksPerMultiprocessor(&per_cu, (const void*)mega_fwd, NWAVES * 64, LDS_BYTES) != hipSuccess || per_cu < 1) { fprintf(stderr, "kernel_launch: occupancy query says %d\n", per_cu); per_cu = 1; }
        (void)hipGetLastError();
        grid = cus * per_cu;
    }
    if (grid < 0) return;
    if (hipMemsetAsync((char*)d_ws + WS_CTL, 0, CTL_ZERO_BYTES, stream) != hipSuccess) { fprintf(stderr, "kernel_launch: memset failed\n"); return; }
    Args a{};
    for (int i = 0; i < 21; ++i) a.in[i] = (const float*)d_in[i];
    a.out = (float*)d_out; a.ws = (unsigned char*)d_ws;
#if MK_PER_PHASE
    for (int p = 0; p < N_PHASES; ++p) { a.ph_lo = p; a.ph_hi = p + 1; hipLaunchKernelGGL(mega_fwd, dim3(grid), dim3(NWAVES * 64), LDS_BYTES, stream, a); }
#else
    a.ph_lo = 0; a.ph_hi = N_PHASES;
    void* kargs[] = {&a};
    hipError_t e = hipLaunchCooperativeKernel((const void*)mega_fwd, dim3(grid), dim3(NWAVES * 64), kargs, LDS_BYTES, stream);
    if (e != hipSuccess) fprintf(stderr, "kernel_launch: cooperative launch failed: %s (grid %d)\n", hipGetErrorString(e), grid);
#endif
}
```

```cpp
#include <hip/hip_runtime.h>
#include <hip/hip_cooperative_groups.h>
#include <hip/hip_bf16.h>
#include <cstdio>
#include <cstdint>
#include <cmath>
namespace cg = cooperative_groups;

#ifndef MK_PER_PHASE
#define MK_PER_PHASE 0
#endif

constexpr int DM = 1024, NB = 16, SEQ = 2048, TOK = NB * SEQ, NMEM = 256, MTOK = NB * NMEM;
constexpr int INW = 3328, DFF = 4096;
constexpr float EPS = 1e-6f;
constexpr float LOG2E = 1.4426950408889634f;
constexpr float QSCALE = 0.125f * LOG2E;
constexpr float XSCALE = 0.0625f * LOG2E;

namespace pg8 {
#define PG8_LAS __attribute__((address_space(3)))
typedef unsigned short bf16_t;
typedef short bf16x8 __attribute__((ext_vector_type(8)));
typedef float f32x4 __attribute__((ext_vector_type(4)));
typedef float f32x2 __attribute__((ext_vector_type(2)));
typedef unsigned u32x4 __attribute__((ext_vector_type(4)));
typedef unsigned u32x2 __attribute__((ext_vector_type(2)));
typedef __bf16 bf16x2_t __attribute__((ext_vector_type(2)));
constexpr int BM = 256, BK = 64, HALF = 128, HTB = HALF * BK * 2, STAGE_BYTES = 8 * HTB, NXCD = 8, WGM = 8;

__host__ __device__ __forceinline__ int lds_byte(int r, int c) { const int st = (r >> 4) * 2 + (c >> 5), rr = r & 15, cc = c & 31, ob = rr * 64 + cc * 2; return st * 1024 + (ob ^ (((ob >> 9) & 1) << 5)); }
__host__ __device__ __forceinline__ void stage_rc(int b, int& R, int& C) { const int st = b / 1024, sb = b % 1024, swz = sb ^ (((sb >> 9) & 1) << 5); R = (st >> 1) * 16 + swz / 64; C = (st & 1) * 32 + (swz % 64) / 2; }
__host__ __device__ __forceinline__ int perm32(int rho) { const int n = rho >> 4, i = rho & 15; return 8 * (i >> 2) + 4 * n + (i & 3); }

struct Unit { int pm, pn, id; };
#define PG8_OPAQUE(x) asm volatile("" : "+v"(x))

__device__ __forceinline__ unsigned pk_bf16(float lo, float hi) { f32x2 v = {lo, hi}; bf16x2_t b = __builtin_convertvector(v, bf16x2_t); return __builtin_bit_cast(unsigned, b); }
__device__ __forceinline__ float bf_lo(unsigned w) { return __uint_as_float(w << 16); }
__device__ __forceinline__ float bf_hi(unsigned w) { return __uint_as_float(w & 0xffff0000u); }
#define PG8_FENCE() asm volatile("" ::: "memory")

__device__ __forceinline__ void remap_tile(int wgid, int nM, int nN, int& pm, int& pn) {
    const int nwg = nM * nN;
    { const int q = nwg / NXCD, r = nwg % NXCD, xcd = wgid % NXCD, off = wgid / NXCD; wgid = (xcd < r ? xcd * (q + 1) : r * (q + 1) + (xcd - r) * q) + off; }
    const int nig = WGM * nN, gid = wgid / nig, fm = gid * WGM, gsz = (nM - fm) < WGM ? (nM - fm) : WGM;
    pm = fm + ((wgid % nig) % gsz); pn = (wgid % nig) / gsz;
}

struct ProbMN {
    const bf16_t* A; const bf16_t* B; int nM, nN, G, c; int K, lda, ldb, mid; long a_pm, a_pn, b_pb, b_pn;
    __device__ __forceinline__ bool next(int i, Unit& u) const {
        const long L = (long)i * G + c; if (L >= (long)nM * nN) return false;
        remap_tile((int)L, nM, nN, u.pm, u.pn); u.id = 0; return true; }
    __device__ __forceinline__ const char* aptr(const Unit& u) const { return (const char*)(A + (size_t)u.pm * a_pm + (size_t)u.pn * a_pn); }
    __device__ __forceinline__ const char* bptr(const Unit& u) const { return (const char*)(B + (size_t)(u.pm >> 3) * b_pb + (size_t)u.pn * b_pn); }
};
__device__ __forceinline__ ProbMN make_plain(const bf16_t* A, const bf16_t* Bt, int M, int N, int K, int G, int c) {
    ProbMN p; p.A = A; p.B = Bt; p.nM = M / BM; p.nN = N / BM; p.G = G; p.c = c; p.K = K; p.lda = K; p.ldb = K; p.mid = -1;
    p.a_pm = (long)BM * K; p.a_pn = 0; p.b_pb = 0; p.b_pn = (long)BM * K; return p; }

template <long OFF_N1, long OFF_WIN, long OFF_MN, long OFF_WXKV> struct ProbP1 {
    const char* ws; int G, c; int K, lda, ldb, mid;
    static constexpr int NPROJ = 128 * 13, NXK = 64, NXV = 64;
    __device__ __forceinline__ bool next(int i, Unit& u) const {
        const int L = i * G + c; if (L >= NPROJ + NXK + NXV) return false;
        if (L < NPROJ) { remap_tile(L, 128, 13, u.pm, u.pn); u.id = 0; }
        else if (L < NPROJ + NXK) { const int e = L - NPROJ; u.pm = e >> 2; u.pn = e & 3; u.id = 1; }
        else { const int e = L - NPROJ - NXK; u.pm = e >> 4; u.pn = e & 15; u.id = 2; }
        return true; }
    __device__ __forceinline__ const char* aptr(const Unit& u) const {
        const long off = u.id == 0 ? OFF_N1 : (u.id == 1 ? OFF_MN : OFF_WXKV + 1024L * 1024 * 2); return ws + off + (long)u.pm * (256 * 1024 * 2); }
    __device__ __forceinline__ const char* bptr(const Unit& u) const {
        const long off = u.id == 0 ? OFF_WIN : (u.id == 1 ? OFF_WXKV : OFF_MN); return ws + off + (long)u.pn * (256 * 1024 * 2); }
};

typedef f32x4 Acc[2][2][4][2];

__device__ __forceinline__ void store_tile_bf16_np(const Acc& acc, bf16_t* base, int ldc, int wr, int wc, int fr, int fq) {
#pragma unroll
    for (int ai = 0; ai < 2; ++ai)
#pragma unroll
        for (int m = 0; m < 4; ++m) { bf16_t* rowp = base + (size_t)(ai * HALF + wr * 64 + m * 16 + fr) * ldc + wc * 32 + 4 * fq;
#pragma unroll
            for (int bj = 0; bj < 2; ++bj)
#pragma unroll
                for (int n = 0; n < 2; ++n) { const f32x4 v = acc[ai][bj][m][n]; u32x2 w; w.x = pk_bf16(v[0], v[1]); w.y = pk_bf16(v[2], v[3]); *(u32x2*)(rowp + bj * HALF + n * 16) = w; } }
}

struct EpiP1 {
    static constexpr bool PERM = false, AFTER_DRAIN = false, HAS_MID = false;
    bf16_t *Q, *Kb, *Vb, *U, *Gt, *XK, *XVT; const float *bgate, *gq, *gk, *rope;
    __device__ __forceinline__ void mid(Acc&, const Unit&, int, int, int, int) const {}
    __device__ __forceinline__ void qk_rope(Acc& acc, const Unit& u, int wr, int wc, int fr, int fq, PG8_LAS float* xch, int wid, int bj, const float* gain, float oscale, bf16_t* out, int ldo, int ocol0) const {
#pragma unroll
        for (int ai = 0; ai < 2; ++ai)
#pragma unroll
            for (int m = 0; m < 4; ++m) {
                const f32x4 a = acc[ai][bj][m][0], b = acc[ai][bj][m][1];
                float s = (a[0] * a[0] + a[1] * a[1]) + (a[2] * a[2] + a[3] * a[3]) + (b[0] * b[0] + b[1] * b[1]) + (b[2] * b[2] + b[3] * b[3]);
                s += __shfl_xor(s, 16); s += __shfl_xor(s, 32);
                if (fq == 0) xch[wid * 128 + (ai * 4 + m) * 16 + fr] = s;
            }
        asm volatile("s_waitcnt lgkmcnt(0)" ::: "memory"); __builtin_amdgcn_s_barrier(); PG8_FENCE();
        const int axis = wc & 1;
        const int d0 = axis * 32 + 4 * fq;
        const f32x4 g0 = *(const f32x4*)(gain + d0), g1 = *(const f32x4*)(gain + d0 + 16);
        const int gridrow0 = (u.pm & 7) * 4 + wr;
#pragma unroll
        for (int ai = 0; ai < 2; ++ai)
#pragma unroll
            for (int m = 0; m < 4; ++m) {
                const int xi = (ai * 4 + m) * 16 + fr;
                const float tot = xch[wid * 128 + xi] + xch[(wid ^ 1) * 128 + xi];
                const float rs = __builtin_amdgcn_rsqf(tot * (1.0f / 64.0f) + EPS) ;
                const int pos = axis ? (m * 16 + fr) : (gridrow0 + 2 * ai);
                const f32x4 cs = *(const f32x4*)(rope + pos * 16 + 4 * fq), sn = *(const f32x4*)(rope + 1024 + pos * 16 + 4 * fq);
                const f32x4 x0 = acc[ai][bj][m][0] * rs * g0, x1 = acc[ai][bj][m][1] * rs * g1;
                const f32x4 y0 = (x0 * cs - x1 * sn) * oscale, y1 = (x1 * cs + x0 * sn) * oscale;
                bf16_t* rowp = out + (size_t)(u.pm * BM + ai * HALF + wr * 64 + m * 16 + fr) * ldo + ocol0 + wc * 32 + 4 * fq;
                u32x2 w0, w1; w0.x = pk_bf16(y0[0], y0[1]); w0.y = pk_bf16(y0[2], y0[3]); w1.x = pk_bf16(y1[0], y1[1]); w1.y = pk_bf16(y1[2], y1[3]);
                *(u32x2*)(rowp) = w0; *(u32x2*)(rowp + 16) = w1;
                PG8_FENCE();
            }
        asm volatile("s_waitcnt lgkmcnt(0)" ::: "memory"); __builtin_amdgcn_s_barrier(); PG8_FENCE();
    }
    __device__ __forceinline__ void operator()(Acc& acc, const Unit& u, int wr, int wc, int fr, int fq, PG8_LAS float* xch, int wid) const { PG8_OPAQUE(fr);
        if (u.id == 0) {
            if (u.pn < 2) {
                qk_rope(acc, u, wr, wc, fr, fq, xch, wid, 0, gq, QSCALE, Q, 512, u.pn * 256);
                qk_rope(acc, u, wr, wc, fr, fq, xch, wid, 1, gq, QSCALE, Q, 512, u.pn * 256 + 128);
            } else if (u.pn == 2) {
                qk_rope(acc, u, wr, wc, fr, fq, xch, wid, 0, gk, 1.0f, Kb, 128, 0);
#pragma unroll
                for (int ai = 0; ai < 2; ++ai)
#pragma unroll
                    for (int m = 0; m < 4; ++m) { bf16_t* rowp = Vb + (size_t)(u.pm * BM + ai * HALF + wr * 64 + m * 16 + fr) * 128 + wc * 32 + 4 * fq;
#pragma unroll
                        for (int n = 0; n < 2; ++n) { const f32x4 v = acc[ai][1][m][n]; u32x2 w; w.x = pk_bf16(v[0], v[1]); w.y = pk_bf16(v[2], v[3]); *(u32x2*)(rowp + n * 16) = w; } }
            } else if (u.pn < 5) {
                store_tile_bf16_np(acc, U + (size_t)u.pm * BM * 512 + (u.pn - 3) * 256, 512, wr, wc, fr, fq);
            } else {
                const int gc0 = (u.pn - 5) * 256 + wc * 32 + 4 * fq;
                f32x4 bv[2][2];
#pragma unroll
                for (int bj = 0; bj < 2; ++bj)
#pragma unroll
                    for (int n = 0; n < 2; ++n) bv[bj][n] = *(const f32x4*)(bgate + gc0 + bj * HALF + n * 16);
#pragma unroll
                for (int ai = 0; ai < 2; ++ai)
#pragma unroll
                    for (int m = 0; m < 4; ++m) { bf16_t* rowp = Gt + (size_t)(u.pm * BM + ai * HALF + wr * 64 + m * 16 + fr) * 2048 + gc0;
#pragma unroll
                        for (int bj = 0; bj < 2; ++bj)
#pragma unroll
                            for (int n = 0; n < 2; ++n) { f32x4 z = acc[ai][bj][m][n] + bv[bj][n]; f32x4 s;
#pragma unroll
                                for (int j = 0; j < 4; ++j) { const float zz = fminf(fmaxf(z[j], -30.f), 30.f); s[j] = __builtin_amdgcn_rcpf(1.0f + __builtin_amdgcn_exp2f(-zz * LOG2E)); }
                                u32x2 w; w.x = pk_bf16(s[0], s[1]); w.y = pk_bf16(s[2], s[3]); *(u32x2*)(rowp + bj * HALF + n * 16) = w; }
                        PG8_FENCE(); }
            }
        } else if (u.id == 1) {
            store_tile_bf16_np(acc, XK + (size_t)u.pm * BM * 1024 + u.pn * 256, 1024, wr, wc, fr, fq);
        } else {
            store_tile_bf16_np(acc, XVT + (size_t)u.pm * BM * 4096 + u.pn * 256, 4096, wr, wc, fr, fq);
        }
    }
};

struct EpiMix {
    static constexpr bool PERM = true, AFTER_DRAIN = false, HAS_MID = true;
    const bf16_t* Gt; bf16_t* MIX;
    __device__ __forceinline__ void mid(Acc& acc, const Unit& u, int wr, int wc, int fr, int fq) const { PG8_OPAQUE(fr);
#pragma unroll
        for (int ai = 0; ai < 2; ++ai)
#pragma unroll
            for (int m = 0; m < 4; ++m) { const bf16_t* grow = Gt + (size_t)(u.pm * BM + ai * HALF + wr * 64 + m * 16 + fr) * 2048 + u.pn * 256 + wc * 32 + 8 * fq;
#pragma unroll
                for (int bj = 0; bj < 2; ++bj) { const u32x4 ga = *(const u32x4*)(grow + bj * HALF), gp = *(const u32x4*)(grow + 1024 + bj * HALF);
                    f32x4 r0, r1;
                    r0[0] = bf_lo(ga.x) * __builtin_amdgcn_rcpf(bf_lo(gp.x)); r0[1] = bf_hi(ga.x) * __builtin_amdgcn_rcpf(bf_hi(gp.x));
                    r0[2] = bf_lo(ga.y) * __builtin_amdgcn_rcpf(bf_lo(gp.y)); r0[3] = bf_hi(ga.y) * __builtin_amdgcn_rcpf(bf_hi(gp.y));
                    r1[0] = bf_lo(ga.z) * __builtin_amdgcn_rcpf(bf_lo(gp.z)); r1[1] = bf_hi(ga.z) * __builtin_amdgcn_rcpf(bf_hi(gp.z));
                    r1[2] = bf_lo(ga.w) * __builtin_amdgcn_rcpf(bf_lo(gp.w)); r1[3] = bf_hi(ga.w) * __builtin_amdgcn_rcpf(bf_hi(gp.w));
                    acc[ai][bj][m][0] *= r0; acc[ai][bj][m][1] *= r1; }
                PG8_FENCE(); }
    }
    __device__ __forceinline__ void operator()(Acc& acc, const Unit& u, int wr, int wc, int fr, int fq, PG8_LAS float*, int) const { PG8_OPAQUE(fr);
#pragma unroll
        for (int ai = 0; ai < 2; ++ai)
#pragma unroll
            for (int m = 0; m < 4; ++m) { const size_t ro = (size_t)(u.pm * BM + ai * HALF + wr * 64 + m * 16 + fr); const int co = u.pn * 256 + wc * 32 + 8 * fq;
#pragma unroll
                for (int bj = 0; bj < 2; ++bj) { const u32x4 gp = *(const u32x4*)(Gt + ro * 2048 + 1024 + co + bj * HALF);
                    const f32x4 a = acc[ai][bj][m][0], b = acc[ai][bj][m][1]; u32x4 w;
                    w.x = pk_bf16(a[0] * bf_lo(gp.x), a[1] * bf_hi(gp.x)); w.y = pk_bf16(a[2] * bf_lo(gp.y), a[3] * bf_hi(gp.y));
                    w.z = pk_bf16(b[0] * bf_lo(gp.z), b[1] * bf_hi(gp.z)); w.w = pk_bf16(b[2] * bf_lo(gp.w), b[3] * bf_hi(gp.w));
                    *(u32x4*)(MIX + ro * 1024 + co + bj * HALF) = w; }
                PG8_FENCE(); }
    }
};

template <int MODE> struct EpiRes {
    static constexpr bool PERM = true, AFTER_DRAIN = false, HAS_MID = false;
    const float* basef; bf16_t* HB; float* SS;
    __device__ __forceinline__ void mid(Acc&, const Unit&, int, int, int, int) const {}
    __device__ __forceinline__ void operator()(Acc& acc, const Unit& u, int wr, int wc, int fr, int fq, PG8_LAS float*, int) const {
        const int col0 = u.pn * BM + wc * 32 + 8 * fq;
#pragma unroll
        for (int ai = 0; ai < 2; ++ai)
#pragma unroll
            for (int m = 0; m < 4; ++m) { const size_t row = (size_t)(u.pm * BM + ai * HALF + wr * 64 + m * 16 + fr); const size_t off = row * 1024 + col0; float ss = 0.f;
#pragma unroll
                for (int bj = 0; bj < 2; ++bj) { f32x4 b0, b1;
                    if (MODE == 0) { b0 = *(const f32x4*)(basef + off + bj * HALF); b1 = *(const f32x4*)(basef + off + bj * HALF + 4); }
                    else { const u32x4 w = *(const u32x4*)(HB + off + bj * HALF); b0 = (f32x4){bf_lo(w.x), bf_hi(w.x), bf_lo(w.y), bf_hi(w.y)}; b1 = (f32x4){bf_lo(w.z), bf_hi(w.z), bf_lo(w.w), bf_hi(w.w)}; }
                    const f32x4 h0 = b0 + acc[ai][bj][m][0], h1 = b1 + acc[ai][bj][m][1];
                    ss += (h0[0] * h0[0] + h0[1] * h0[1]) + (h0[2] * h0[2] + h0[3] * h0[3]) + (h1[0] * h1[0] + h1[1] * h1[1]) + (h1[2] * h1[2] + h1[3] * h1[3]);
                    u32x4 o; o.x = pk_bf16(h0[0], h0[1]); o.y = pk_bf16(h0[2], h0[3]); o.z = pk_bf16(h1[0], h1[1]); o.w = pk_bf16(h1[2], h1[3]);
                    *(u32x4*)(HB + off + bj * HALF) = o; }
                ss += __shfl_xor(ss, 16); ss += __shfl_xor(ss, 32);
                if (fq == 0) SS[row * 16 + u.pn * 4 + wc] = ss;
                PG8_FENCE(); }
    }
};

template <int ACT> struct EpiRowScale {
    static constexpr bool PERM = true, AFTER_DRAIN = false, HAS_MID = false;
    const float* SS; bf16_t* O; int ldc; float scale;
    __device__ __forceinline__ void mid(Acc&, const Unit&, int, int, int, int) const {}
    __device__ __forceinline__ void operator()(Acc& acc, const Unit& u, int wr, int wc, int fr, int fq, PG8_LAS float*, int) const { PG8_OPAQUE(fr);
#pragma unroll
        for (int ai = 0; ai < 2; ++ai)
#pragma unroll
            for (int m = 0; m < 4; ++m) { const size_t row = (size_t)(u.pm * BM + ai * HALF + wr * 64 + m * 16 + fr);
                const f32x4 p4 = *(const f32x4*)(SS + row * 16 + 4 * fq); float s = (p4[0] + p4[1]) + (p4[2] + p4[3]); s += __shfl_xor(s, 16); s += __shfl_xor(s, 32);
                const float rs = __builtin_amdgcn_rsqf(s * (1.0f / 1024.0f) + EPS) * scale;
                bf16_t* rowp = O + row * ldc + u.pn * 256 + wc * 32 + 8 * fq;
#pragma unroll
                for (int bj = 0; bj < 2; ++bj) { f32x4 a = acc[ai][bj][m][0] * rs, b = acc[ai][bj][m][1] * rs;
                    if (ACT == 1) {
#pragma unroll
                        for (int j = 0; j < 4; ++j) { const float x = fmaxf(a[j], 0.f), y = fmaxf(b[j], 0.f); a[j] = x * x; b[j] = y * y; } }
                    u32x4 w; w.x = pk_bf16(a[0], a[1]); w.y = pk_bf16(a[2], a[3]); w.z = pk_bf16(b[0], b[1]); w.w = pk_bf16(b[2], b[3]);
                    *(u32x4*)(rowp + bj * HALF) = w; }
                PG8_FENCE(); }
    }
};

struct EpiPlain {
    static constexpr bool PERM = true, AFTER_DRAIN = false, HAS_MID = false;
    bf16_t* O; int ldc;
    __device__ __forceinline__ void mid(Acc&, const Unit&, int, int, int, int) const {}
    __device__ __forceinline__ void operator()(Acc& acc, const Unit& u, int wr, int wc, int fr, int fq, PG8_LAS float*, int) const { PG8_OPAQUE(fr);
#pragma unroll
        for (int ai = 0; ai < 2; ++ai)
#pragma unroll
            for (int m = 0; m < 4; ++m) { bf16_t* rowp = O + (size_t)(u.pm * BM + ai * HALF + wr * 64 + m * 16 + fr) * ldc + u.pn * 256 + wc * 32 + 8 * fq;
#pragma unroll
                for (int bj = 0; bj < 2; ++bj) { const f32x4 a = acc[ai][bj][m][0], b = acc[ai][bj][m][1];
                    u32x4 w; w.x = pk_bf16(a[0], a[1]); w.y = pk_bf16(a[2], a[3]); w.z = pk_bf16(b[0], b[1]); w.w = pk_bf16(b[2], b[3]);
                    *(u32x4*)(rowp + bj * HALF) = w; } }
    }
};

struct EpiSoftmax {
    static constexpr bool PERM = true, AFTER_DRAIN = false, HAS_MID = false;
    bf16_t* P;
    __device__ __forceinline__ void mid(Acc&, const Unit&, int, int, int, int) const {}
    __device__ __forceinline__ void operator()(Acc& acc, const Unit& u, int wr, int wc, int fr, int fq, PG8_LAS float* xch, int) const { PG8_OPAQUE(fr);
        PG8_LAS float* xmax = xch; PG8_LAS float* xsum = xch + 1024;
#pragma unroll
        for (int ai = 0; ai < 2; ++ai)
#pragma unroll
            for (int m = 0; m < 4; ++m) { float mx = -INFINITY;
#pragma unroll
                for (int bj = 0; bj < 2; ++bj)
#pragma unroll
                    for (int n = 0; n < 2; ++n) { const f32x4 v = acc[ai][bj][m][n]; mx = fmaxf(mx, fmaxf(fmaxf(v[0], v[1]), fmaxf(v[2], v[3]))); }
                mx = fmaxf(mx, __shfl_xor(mx, 16)); mx = fmaxf(mx, __shfl_xor(mx, 32));
                if (fq == 0) xmax[(ai * HALF + wr * 64 + m * 16 + fr) * 4 + wc] = mx; }
        asm volatile("s_waitcnt lgkmcnt(0)" ::: "memory"); __builtin_amdgcn_s_barrier(); PG8_FENCE();
#pragma unroll
        for (int ai = 0; ai < 2; ++ai)
#pragma unroll
            for (int m = 0; m < 4; ++m) { const int rl = ai * HALF + wr * 64 + m * 16 + fr; const f32x4 m4 = *(const PG8_LAS f32x4*)(xmax + rl * 4);
                const float mx = fmaxf(fmaxf(m4[0], m4[1]), fmaxf(m4[2], m4[3])); float s = 0.f;
#pragma unroll
                for (int bj = 0; bj < 2; ++bj)
#pragma unroll
                    for (int n = 0; n < 2; ++n) { f32x4 v = acc[ai][bj][m][n];
#pragma unroll
                        for (int j = 0; j < 4; ++j) { v[j] = __builtin_amdgcn_exp2f(v[j] - mx); s += v[j]; }
                        acc[ai][bj][m][n] = v; }
                s += __shfl_xor(s, 16); s += __shfl_xor(s, 32);
                if (fq == 0) xsum[rl * 4 + wc] = s; }
        asm volatile("s_waitcnt lgkmcnt(0)" ::: "memory"); __builtin_amdgcn_s_barrier(); PG8_FENCE();
#pragma unroll
        for (int ai = 0; ai < 2; ++ai)
#pragma unroll
            for (int m = 0; m < 4; ++m) { const int rl = ai * HALF + wr * 64 + m * 16 + fr; const f32x4 s4 = *(const PG8_LAS f32x4*)(xsum + rl * 4);
                const float inv = __builtin_amdgcn_rcpf((s4[0] + s4[1]) + (s4[2] + s4[3]));
                bf16_t* rowp = P + (size_t)(u.pm * BM + rl) * 1024 + u.pn * 256 + wc * 32 + 8 * fq;
#pragma unroll
                for (int bj = 0; bj < 2; ++bj) { const f32x4 a = acc[ai][bj][m][0] * inv, b = acc[ai][bj][m][1] * inv;
                    u32x4 w; w.x = pk_bf16(a[0], a[1]); w.y = pk_bf16(a[2], a[3]); w.z = pk_bf16(b[0], b[1]); w.w = pk_bf16(b[2], b[3]);
                    *(u32x4*)(rowp + bj * HALF) = w; } }
        asm volatile("s_waitcnt lgkmcnt(0)" ::: "memory"); __builtin_amdgcn_s_barrier(); PG8_FENCE();
    }
};

template <class Epi, class Sched, bool ALIGN_EPI, bool SP2>
__device__ __forceinline__ void gemm_phase(PG8_LAS unsigned char* lds, PG8_LAS float* xch, const Sched& S, const Epi& E) {
    const int tid = threadIdx.x, wid = __builtin_amdgcn_readfirstlane(tid >> 6), lane = tid & 63, wr = wid >> 2, wc = wid & 3, fr = lane & 15, fq = lane >> 4;
    const int K = S.K, nt = K / BK, lda = S.lda, ldb = S.ldb; (void)K;
    unsigned voffA[2], voffB[2];
#pragma unroll
    for (int i = 0; i < 2; ++i) { int R, C; stage_rc(tid * 16 + i * 8192, R, C); const int Rb = Epi::PERM ? ((R & ~31) + perm32(R & 31)) : R;
        voffA[i] = (unsigned)(R * lda + C) * 2u; voffB[i] = (unsigned)(Rb * ldb + C) * 2u; }
    const size_t kstep = (size_t)(BK * 2);
    const size_t hstepA = (size_t)HALF * lda * 2, hstepB = (size_t)HALF * ldb * 2;
    const unsigned ldsw = (unsigned)wid * 1024u;
    const int aoff = lds_byte(wr * 64 + fr, fq * 8), boff = lds_byte(wc * 32 + fr, fq * 8);
#define PG8_SA(b, h) (((b) * 2 + (h)) * HTB)
#define PG8_SB(b, h) ((4 + (b) * 2 + (h)) * HTB)
#define PG8_STAGE(bufoff, gbase, voff) do { _Pragma("unroll") for (int _i = 0; _i < 2; ++_i) \
        __builtin_amdgcn_global_load_lds((const unsigned*)((const char*)(gbase) + (voff)[_i]), (PG8_LAS unsigned*)(lds + (bufoff) + ldsw + _i * 8192), 16, 0, 0); } while (0)
#define PG8_LDA(dst, b, h) do { _Pragma("unroll") for (int m = 0; m < 4; ++m) _Pragma("unroll") for (int k = 0; k < 2; ++k) dst[m][k] = *(const PG8_LAS bf16x8*)(lds + PG8_SA(b, h) + aoff + m * 2048 + k * 1024); } while (0)
#define PG8_LDB(dst, b, h) do { _Pragma("unroll") for (int n = 0; n < 2; ++n) _Pragma("unroll") for (int k = 0; k < 2; ++k) dst[n][k] = *(const PG8_LAS bf16x8*)(lds + PG8_SB(b, h) + boff + n * 2048 + k * 1024); } while (0)
#define PG8_MMA(ai, bj, At, Bt) do { __builtin_amdgcn_s_setprio(1); _Pragma("unroll") for (int m = 0; m < 4; ++m) _Pragma("unroll") for (int n = 0; n < 2; ++n) _Pragma("unroll") for (int k = 0; k < 2; ++k) \
        acc[ai][bj][m][n] = __builtin_amdgcn_mfma_f32_16x16x32_bf16(Bt[n][k], At[m][k], acc[ai][bj][m][n], 0, 0, 0); __builtin_amdgcn_s_setprio(0); } while (0)
#define PG8_WAIT_V(n) asm volatile("s_waitcnt vmcnt(" #n ")" ::: "memory")
#define PG8_WAIT_L(n) asm volatile("s_waitcnt lgkmcnt(" #n ")" ::: "memory")
#define PG8_BAR __builtin_amdgcn_s_barrier()
#define PG8_SCHED __builtin_amdgcn_sched_barrier(0)
    Unit cur, nxt; int ui = 0;
    if (!S.next(0, cur)) return;
    f32x4 acc[2][2][4][2];
#pragma unroll
    for (int a = 0; a < 2; ++a)
#pragma unroll
        for (int b = 0; b < 2; ++b)
#pragma unroll
            for (int m = 0; m < 4; ++m)
#pragma unroll
                for (int n = 0; n < 2; ++n) acc[a][b][m][n] = (f32x4){0.f, 0.f, 0.f, 0.f};
    bf16x8 At[4][2], B0[2][2], B1[2][2];
    const char* cA = S.aptr(cur); const char* cB = S.bptr(cur);
    if constexpr (SP2) {
        PG8_STAGE(PG8_SB(0, 0), cB, voffB); PG8_STAGE(PG8_SB(0, 1), cB + hstepB, voffB); PG8_STAGE(PG8_SA(0, 0), cA, voffA); PG8_STAGE(PG8_SA(0, 1), cA + hstepA, voffA);
        if (wr == 1) PG8_BAR;
        PG8_WAIT_V(2); PG8_BAR;
        PG8_STAGE(PG8_SB(1, 0), cB + kstep, voffB); PG8_STAGE(PG8_SA(1, 0), cA + kstep, voffA); PG8_STAGE(PG8_SB(1, 1), cB + hstepB + kstep, voffB);
        PG8_WAIT_V(6); PG8_BAR;
    } else {
        PG8_STAGE(PG8_SB(0, 0), cB, voffB); PG8_STAGE(PG8_SA(0, 0), cA, voffA); PG8_STAGE(PG8_SB(0, 1), cB + hstepB, voffB); PG8_STAGE(PG8_SA(0, 1), cA + hstepA, voffA);
        if (wr == 1) PG8_BAR;
        PG8_WAIT_V(4); PG8_BAR;
        PG8_STAGE(PG8_SB(1, 0), cB + kstep, voffB); PG8_STAGE(PG8_SA(1, 0), cA + kstep, voffA); PG8_STAGE(PG8_SB(1, 1), cB + hstepB + kstep, voffB);
        PG8_WAIT_V(6); PG8_BAR;
    }
    for (;;) {
        const bool has_next = S.next(ui + 1, nxt);
        const char* nA = has_next ? S.aptr(nxt) : cA; const char* nB = has_next ? S.bptr(nxt) : cB;
        for (int t = 0; t < nt; t += 2) {
            const bool last = (t == nt - 2);
            const char* a1 = cA + (size_t)(t + 1) * kstep;
            const char* a2 = last ? nA : cA + (size_t)(t + 2) * kstep; const char* b2 = last ? nB : cB + (size_t)(t + 2) * kstep;
            const char* a3 = a2 + kstep; const char* b3 = b2 + kstep;
            if constexpr (Epi::HAS_MID) { if (t == S.mid) E.mid(acc, cur, wr, wc, fr, fq); }
            if constexpr (SP2) {
            PG8_LDB(B0, 0, 0); PG8_LDB(B1, 0, 1); PG8_SCHED; PG8_LDA(At, 0, 0); PG8_STAGE(PG8_SA(1, 1), a1 + hstepA, voffA);
            PG8_WAIT_V(8); PG8_WAIT_L(0); PG8_BAR; PG8_MMA(0, 0, At, B0); PG8_MMA(0, 1, At, B1); PG8_BAR; PG8_SCHED;
            PG8_LDA(At, 0, 1); PG8_STAGE(PG8_SB(0, 0), b2, voffB); PG8_STAGE(PG8_SB(0, 1), b2 + hstepB, voffB); PG8_STAGE(PG8_SA(0, 0), a2, voffA);
            PG8_WAIT_V(8); PG8_WAIT_L(0); PG8_BAR; PG8_MMA(1, 0, At, B0); PG8_MMA(1, 1, At, B1); PG8_BAR; PG8_SCHED;
            PG8_LDB(B0, 1, 0); PG8_LDB(B1, 1, 1); PG8_SCHED; PG8_LDA(At, 1, 0); PG8_STAGE(PG8_SA(0, 1), a2 + hstepA, voffA);
            PG8_WAIT_V(8); PG8_WAIT_L(0); PG8_BAR; PG8_MMA(0, 0, At, B0); PG8_MMA(0, 1, At, B1); PG8_BAR; PG8_SCHED;
            PG8_LDA(At, 1, 1); PG8_STAGE(PG8_SB(1, 0), b3, voffB); PG8_STAGE(PG8_SB(1, 1), b3 + hstepB, voffB); PG8_STAGE(PG8_SA(1, 0), a3, voffA);
            PG8_WAIT_V(8); PG8_WAIT_L(0); PG8_BAR; PG8_MMA(1, 0, At, B0); PG8_MMA(1, 1, At, B1); PG8_BAR; PG8_SCHED;
            } else {
            PG8_LDB(B0, 0, 0); PG8_SCHED; PG8_LDA(At, 0, 0); PG8_STAGE(PG8_SA(1, 1), a1 + hstepA, voffA);
            PG8_WAIT_L(8); PG8_BAR; PG8_WAIT_L(0); PG8_MMA(0, 0, At, B0); PG8_BAR; PG8_SCHED;
            PG8_LDB(B1, 0, 1); PG8_STAGE(PG8_SB(0, 0), b2, voffB);
            PG8_BAR; PG8_WAIT_L(0); PG8_MMA(0, 1, At, B1); PG8_BAR;
            PG8_LDA(At, 0, 1); PG8_STAGE(PG8_SA(0, 0), a2, voffA);
            PG8_BAR; PG8_WAIT_L(0); PG8_MMA(1, 0, At, B0); PG8_BAR; PG8_SCHED;
            PG8_STAGE(PG8_SB(0, 1), b2 + hstepB, voffB);
            PG8_WAIT_V(6); PG8_BAR; PG8_MMA(1, 1, At, B1); PG8_BAR;
            PG8_LDB(B0, 1, 0); PG8_SCHED; PG8_LDA(At, 1, 0); PG8_STAGE(PG8_SA(0, 1), a2 + hstepA, voffA);
            PG8_WAIT_L(8); PG8_BAR; PG8_WAIT_L(0); PG8_MMA(0, 0, At, B0); PG8_BAR; PG8_SCHED;
            PG8_LDB(B1, 1, 1); PG8_STAGE(PG8_SB(1, 0), b3, voffB);
            PG8_BAR; PG8_WAIT_L(0); PG8_MMA(0, 1, At, B1); PG8_BAR;
            PG8_LDA(At, 1, 1); PG8_STAGE(PG8_SA(1, 0), a3, voffA);
            PG8_BAR; PG8_WAIT_L(0); PG8_MMA(1, 0, At, B0); PG8_BAR; PG8_SCHED;
            PG8_STAGE(PG8_SB(1, 1), b3 + hstepB, voffB);
            PG8_WAIT_V(6); PG8_BAR; PG8_MMA(1, 1, At, B1); PG8_BAR;
            }
        }
        if constexpr (ALIGN_EPI) { if (wr == 0) PG8_BAR; }
        E(acc, cur, wr, wc, fr, fq, xch, wid);
        if (!has_next) break;
#pragma unroll
        for (int a = 0; a < 2; ++a)
#pragma unroll
            for (int b = 0; b < 2; ++b)
#pragma unroll
                for (int m = 0; m < 4; ++m)
#pragma unroll
                    for (int n = 0; n < 2; ++n) acc[a][b][m][n] = (f32x4){0.f, 0.f, 0.f, 0.f};
        cur = nxt; cA = nA; cB = nB; ++ui;
        if constexpr (ALIGN_EPI) { if (wr == 1) PG8_BAR; }
    }
    PG8_WAIT_V(0);
    if constexpr (!ALIGN_EPI) { if (wr == 0) PG8_BAR; }
    PG8_BAR;
#undef PG8_SA
#undef PG8_SB
#undef PG8_STAGE
#undef PG8_LDA
#undef PG8_LDB
#undef PG8_MMA
#undef PG8_WAIT_V
#undef PG8_WAIT_L
#undef PG8_BAR
#undef PG8_SCHED
}
}

#include <hip/hip_bf16.h>
#include <cmath>
namespace attn_body {
using bf16=__hip_bfloat16;
using bf16x8=__attribute__((ext_vector_type(8)))short;
using s16x4=__attribute__((ext_vector_type(4)))short;
using f32x16=__attribute__((ext_vector_type(16)))float;
using u32x4=__attribute__((ext_vector_type(4)))unsigned;
constexpr int BATCH=16,NHEAD=8,SEQ=2048,D=64,QP=512,KP=128,OP=1024;
constexpr int NW=8,QBLK=32,QB=QBLK*NW,KVBLK=64,NQB=SEQ/QB;
__device__ __forceinline__ int crow(int r,int hi){return (r&3)+8*(r>>2)+4*hi;}
#define SBAR() __builtin_amdgcn_sched_barrier(0)
__device__ __forceinline__ void cmask(f32x16&p0,f32x16&p1,int jb,int qrel,int hi){
  const float NEG=-INFINITY; int kb=64*jb+4*hi;
  #pragma unroll
  for(int r=0;r<16;++r){int kv=kb+(r&3)+8*(r>>2); if(kv>qrel)p0[r]=NEG; if(kv+32>qrel)p1[r]=NEG;}
}

constexpr int NSLOT=3, SLOTB=8192;
constexpr int LDS_K=0, LDS_V=NSLOT*SLOTB, LDS_WS=2*NSLOT*SLOTB, LDS_OST=LDS_WS+NW*64*4, LDS_BYTES=LDS_OST+NW*4096;
constexpr float C2=0.125f*1.4426950408889634f;
__device__ __forceinline__ void glds16(const void*gsrc,unsigned lds_dst){unsigned keep;
  asm volatile("s_mov_b32 %0, m0\n\ts_mov_b32 m0, %2\n\ts_nop 0\n\tglobal_load_lds_dwordx4 %1, off\n\ts_mov_b32 m0, %0":"=&s"(keep):"v"(gsrc),"s"(lds_dst):"memory");}
__device__ __forceinline__ float max3f(float a,float b,float c){float r;asm("v_max3_f32 %0, %1, %2, %3":"=v"(r):"v"(a),"v"(b),"v"(c));return r;}
__device__ __forceinline__ float max2f(float a,float b){float r;asm("v_max_f32_e32 %0, %1, %2":"=v"(r):"v"(a),"v"(b));return r;}
__device__ __forceinline__ float fadd_s(float a,float b){float r;asm("v_add_f32_e32 %0, %1, %2":"=v"(r):"v"(a),"v"(b));return r;}
__device__ __forceinline__ float fsub_s(float a,float b){float r;asm("v_sub_f32_e32 %0, %1, %2":"=v"(r):"v"(a),"v"(b));return r;}
typedef float f32x2_t __attribute__((ext_vector_type(2))); typedef __bf16 bf16x2_t __attribute__((ext_vector_type(2)));
__device__ __forceinline__ unsigned cvtpk_s(float lo,float hi){f32x2_t v={lo,hi};bf16x2_t b=__builtin_convertvector(v,bf16x2_t);return __builtin_bit_cast(unsigned,b);}
#define WAIT_BAR(N) asm volatile("s_waitcnt vmcnt(" #N ") lgkmcnt(0)\n\ts_barrier":::"memory")

__device__ __forceinline__ void qkt(f32x16&p0,f32x16&p1,const char*Kslot,const bf16x8*qr,const f32x16&negm,int r32,int hi){
  const char*kb=Kslot+hi*1024+r32*16;
  #pragma unroll
  for(int d0=0;d0<4;++d0){
    const bf16x8 b0=*reinterpret_cast<const bf16x8*>(kb+d0*2048);
    const bf16x8 b1=*reinterpret_cast<const bf16x8*>(kb+d0*2048+512);
    if(d0==0){p0=__builtin_amdgcn_mfma_f32_32x32x16_bf16(b0,qr[0],negm,0,0,0);p1=__builtin_amdgcn_mfma_f32_32x32x16_bf16(b1,qr[0],negm,0,0,0);}
    else{p0=__builtin_amdgcn_mfma_f32_32x32x16_bf16(b0,qr[d0],p0,0,0,0);p1=__builtin_amdgcn_mfma_f32_32x32x16_bf16(b1,qr[d0],p1,0,0,0);}}
}
typedef __attribute__((address_space(3))) const char* lds_cptr;
typedef short v4i16_t __attribute__((ext_vector_type(4)));
__device__ __forceinline__ void kload8(bf16x8*kf,lds_cptr kp){
  kf[0]=*(const __attribute__((address_space(3))) bf16x8*)(kp);      kf[1]=*(const __attribute__((address_space(3))) bf16x8*)(kp+512);
  kf[2]=*(const __attribute__((address_space(3))) bf16x8*)(kp+2048); kf[3]=*(const __attribute__((address_space(3))) bf16x8*)(kp+2560);
  kf[4]=*(const __attribute__((address_space(3))) bf16x8*)(kp+4096); kf[5]=*(const __attribute__((address_space(3))) bf16x8*)(kp+4608);
  kf[6]=*(const __attribute__((address_space(3))) bf16x8*)(kp+6144); kf[7]=*(const __attribute__((address_space(3))) bf16x8*)(kp+6656);
}
__device__ __forceinline__ void kload2(bf16x8*kf,lds_cptr kp,int j){ kf[2*j]=*(const __attribute__((address_space(3))) bf16x8*)(kp+j*2048); kf[2*j+1]=*(const __attribute__((address_space(3))) bf16x8*)(kp+j*2048+512); }
__device__ __forceinline__ s16x4 vtr(lds_cptr p){ return __builtin_bit_cast(s16x4,__builtin_amdgcn_ds_read_tr16_b64_v4i16((__attribute__((address_space(3))) v4i16_t*)p)); }
__device__ __forceinline__ float rowmax(const f32x16&p0,const f32x16&p1){
  float a=max3f(p0[0],p0[1],p1[0]),b=max3f(p0[2],p0[3],p1[1]);a=max3f(a,p1[2],p1[3]);
  #pragma unroll
  for(int r=4;r<16;r+=4){a=max3f(a,p0[r],p0[r+1]);b=max3f(b,p0[r+2],p0[r+3]);a=max3f(a,p1[r],p1[r+1]);b=max3f(b,p1[r+2],p1[r+3]);}
  const float m=max2f(a,b);
  auto rr=__builtin_amdgcn_permlane32_swap(__float_as_uint(m),__float_as_uint(m),false,false);
  return max2f(__uint_as_float(rr[0]),__uint_as_float(rr[1]));
}
__device__ __forceinline__ void pv(f32x16*o,int vb,bf16x8 pa0,bf16x8 pa1,bf16x8 pa2,bf16x8 pa3){
  #pragma unroll
  for(int d0=0;d0<2;++d0){s16x4 lo[4],hi[4];
    #pragma unroll
    for(int ks=0;ks<4;++ks){
      asm volatile("ds_read_b64_tr_b16 %0,%1 offset:%c2":"=&v"(lo[ks]):"v"(vb),"i"(d0*4096+ks*1024):"memory");
      asm volatile("ds_read_b64_tr_b16 %0,%1 offset:%c2":"=&v"(hi[ks]):"v"(vb),"i"(d0*4096+ks*1024+512):"memory");}
    asm volatile("s_waitcnt lgkmcnt(0)":::"memory");SBAR();
    #define PK(k) (bf16x8){lo[k][0],lo[k][1],lo[k][2],lo[k][3],hi[k][0],hi[k][1],hi[k][2],hi[k][3]}
    o[d0]=__builtin_amdgcn_mfma_f32_32x32x16_bf16(pa0,PK(0),o[d0],0,0,0);
    o[d0]=__builtin_amdgcn_mfma_f32_32x32x16_bf16(pa1,PK(1),o[d0],0,0,0);
    o[d0]=__builtin_amdgcn_mfma_f32_32x32x16_bf16(pa2,PK(2),o[d0],0,0,0);
    o[d0]=__builtin_amdgcn_mfma_f32_32x32x16_bf16(pa3,PK(3),o[d0],0,0,0);
    #undef PK
  }
}

#ifndef ATTN_STORE16
#define ATTN_STORE16(p,v) (*(u32x4*)(p)=(v))
#endif
template<int THRL> __device__ __forceinline__ void attn_unit(int b,int h,int qb,const bf16*Q,const bf16*__restrict__ K,const bf16*__restrict__ V,bf16*O,char*shm){
  const int tid=threadIdx.x,lane=tid&63,r32=lane&31,hi=lane>>5; const int wid=__builtin_amdgcn_readfirstlane(tid>>6);
  const long rowbase=(long)b*SEQ; const int q0=qb*QB;
  const bf16*Qw=Q+(rowbase+q0+wid*QBLK)*QP+h*D;
  const bf16*Kh=K+rowbase*KP+(h>>2)*D,*Vh=V+rowbase*KP+(h>>2)*D;
  const unsigned lds0=(unsigned)(uintptr_t)shm;
  float*wsf=(float*)(shm+LDS_WS)+wid*64;
  const bf16*ksrc=Kh+(long)lane*KP+wid*8;
  const bf16*vsrc=Vh+(long)(16*(wid&3)+(lane>>2))*KP+(wid>>2)*32+(lane&3)*8;
  const unsigned kdst=lds0+LDS_K+wid*1024, vdst=lds0+LDS_V+wid*1024;
  #define DMA_K(t,slot) glds16(ksrc+(long)(t)*KVBLK*KP,(unsigned)__builtin_amdgcn_readfirstlane(kdst+(slot)))
  #define DMA_V(t,slot) glds16(vsrc+(long)(t)*KVBLK*KP,(unsigned)__builtin_amdgcn_readfirstlane(vdst+(slot)))
  const int vb0=(int)(lds0+LDS_V)+((lane>>4)&1)*32+(lane&3)*8+(4*hi+((lane&15)>>2))*64;
  const char*Kbase=shm+LDS_K; bf16x8 kf[8];
  const lds_cptr shm3=(lds_cptr)shm; const lds_cptr kp0=shm3+LDS_K+hi*1024+r32*16; const lds_cptr vp0=shm3+LDS_V+((lane>>4)&1)*32+(lane&3)*8+(4*hi+((lane&15)>>2))*64;
  constexpr int NT=SEQ/KVBLK;
  DMA_K(0,0);DMA_V(0,0);DMA_K(1,SLOTB);
  bf16x8 qr[4];
  #pragma unroll
  for(int d0=0;d0<4;++d0)qr[d0]=*reinterpret_cast<const bf16x8*>(&Qw[(long)r32*QP+d0*16+hi*8]);
  float mhat=0.f,l_reg=0.f;f32x16 o[2];o[0]=f32x16{};o[1]=f32x16{};f32x16 negm=f32x16{};asm volatile("":"+v"(negm));
  #define CMASK(P0,P1,t) do{}while(0)
  bool resc=false;
  #define START(P0,P1) do{ const float rm=rowmax(P0,P1); resc=false; \
    { const float dl=rm; mhat=fadd_s(mhat,dl); \
      _Pragma("unroll") for(int r=0;r<16;++r){P0[r]=fsub_s(P0[r],dl);P1[r]=fsub_s(P1[r],dl);} \
      _Pragma("unroll") for(int r=0;r<16;++r)negm[r]=-mhat; asm volatile("":"+v"(negm)); } \
    _Pragma("unroll") for(int r=0;r<16;++r)P0[r]=__builtin_amdgcn_exp2f(P0[r]); }while(0)
  #define RESC() do{ if(resc){ asm volatile("s_waitcnt lgkmcnt(0)":::"memory"); \
      _Pragma("unroll") for(int d_=0;d_<2;++d_) _Pragma("unroll") for(int r=0;r<16;++r)o[d_][r]*=wsf[crow(r,hi)]; } }while(0)
  f32x16 pA0,pA1,pB0,pB1;
  int sl_prev=0,sl_cur=0,sl_next=SLOTB;
  #define ROT() do{sl_prev=sl_cur;sl_cur=sl_next;sl_next=(sl_next==(NSLOT-1)*SLOTB)?0:sl_next+SLOTB;}while(0)
  DMA_K(2,2*SLOTB);
  WAIT_BAR(3);
  qkt(pA0,pA1,Kbase,qr,negm,r32,hi);asm volatile("s_nop 15\n\ts_nop 7":"+v"(pA0),"+v"(pA1));CMASK(pA0,pA1,0);
  START(pA0,pA1);
  _Pragma("unroll") for(int r=0;r<16;++r)pA1[r]=__builtin_amdgcn_exp2f(pA1[r]);
  WAIT_BAR(0);
  DMA_K(3,0);DMA_V(1,SLOTB);
  ROT();
  kload8(kf,kp0+sl_cur);
  WAIT_BAR(2);
  s16x4 vlo[8],vhi[8]; u32x4 pw0,pw1,pw2,pw3;
  #define PKW(P,B) cvtpk_s(P[B],P[B+1])
  #define PAF(k) __builtin_bit_cast(bf16x8,pw##k)
  #define VFR(i) (bf16x8){vlo[i][0],vlo[i][1],vlo[i][2],vlo[i][3],vhi[i][0],vhi[i][1],vhi[i][2],vhi[i][3]}
  #define PIN(x) asm volatile("":"+v"(x))
  #define MX3(a,b,c) __builtin_fmaxf(__builtin_fmaxf((a),(b)),(c))
  #define GAPA(MF,A0,A1,A2,A3,W0,W1,PW) do{ MF; sacc+=A0; sacc+=A1; sacc+=A2; sacc+=A3; PIN(sacc); W0; W1; PIN(PW); SBAR(); }while(0)
  #define EX(v) __builtin_amdgcn_exp2f(v)
  #define GAPB(MF,X,B) do{ MF; X[B]=EX(X[B]); X[B+1]=EX(X[B+1]); X[B+2]=EX(X[B+2]); X[B+3]=EX(X[B+3]); PIN(X); SBAR(); }while(0)
  #define VRD(i) do{ vlo[i]=vtr(vp_+(((i)>>2)*4096+((i)&3)*1024)); vhi[i]=vtr(vp_+(((i)>>2)*4096+((i)&3)*1024+512)); }while(0)
  #define KRD(G,j) do{ if(G){ kload2(kf,kp0+sl_next,j); SBAR(); } }while(0)
  #define STEP(C0,C1,P0,P1,t,GK,GV,GL) do{ SBAR(); \
    const lds_cptr vp_=vp0+sl_prev; \
    VRD(0); SBAR(); float sacc=(P0[0]+P0[1]); \
    GAPA(C0=__builtin_amdgcn_mfma_f32_32x32x16_bf16(kf[0],qr[0],negm,0,0,0), P0[2],P0[3],P0[4],P0[5],     pw0[0]=PKW(P0,0), pw0[1]=PKW(P0,2), pw0); \
    VRD(4); SBAR(); GAPA(C1=__builtin_amdgcn_mfma_f32_32x32x16_bf16(kf[1],qr[0],negm,0,0,0), P0[6],P0[7],P0[8],P0[9],     pw0[2]=PKW(P0,4), pw0[3]=PKW(P0,6), pw0); \
    VRD(1); SBAR(); GAPA(C0=__builtin_amdgcn_mfma_f32_32x32x16_bf16(kf[2],qr[1],C0,0,0,0),   P0[10],P0[11],P0[12],P0[13], pw1[0]=PKW(P0,8), pw1[1]=PKW(P0,10), pw1); \
    VRD(5); SBAR(); GAPA(C1=__builtin_amdgcn_mfma_f32_32x32x16_bf16(kf[3],qr[1],C1,0,0,0),   P0[14],P0[15],P1[0],P1[1],   pw1[2]=PKW(P0,12),pw1[3]=PKW(P0,14), pw1); \
    VRD(2); SBAR(); GAPA(C0=__builtin_amdgcn_mfma_f32_32x32x16_bf16(kf[4],qr[2],C0,0,0,0),   P1[2],P1[3],P1[4],P1[5],     pw2[0]=PKW(P1,0), pw2[1]=PKW(P1,2), pw2); \
    VRD(6); SBAR(); GAPA(C1=__builtin_amdgcn_mfma_f32_32x32x16_bf16(kf[5],qr[2],C1,0,0,0),   P1[6],P1[7],P1[8],P1[9],     pw2[2]=PKW(P1,4), pw2[3]=PKW(P1,6), pw2); \
    VRD(3); SBAR(); GAPA(C0=__builtin_amdgcn_mfma_f32_32x32x16_bf16(kf[6],qr[3],C0,0,0,0),   P1[10],P1[11],P1[12],P1[13], pw3[0]=PKW(P1,8), pw3[1]=PKW(P1,10), pw3); \
    VRD(7); SBAR(); GAPA(C1=__builtin_amdgcn_mfma_f32_32x32x16_bf16(kf[7],qr[3],C1,0,0,0),   P1[14],P1[15],0.f,0.f,       pw3[2]=PKW(P1,12),pw3[3]=PKW(P1,14), pw3); \
    l_reg+=sacc; \
    if(GK){DMA_K((t)+3,sl_cur);} if(GV){DMA_V((t)+1,sl_next);} \
    CMASK(C0,C1,t); \
    { float a=MX3(C0[0],C0[1],C1[0]),b=MX3(C0[2],C0[3],C1[1]); a=MX3(a,C1[2],C1[3]); \
      _Pragma("unroll") for(int r=4;r<16;r+=4){a=MX3(a,C0[r],C0[r+1]);b=MX3(b,C0[r+2],C0[r+3]);a=MX3(a,C1[r],C1[r+1]);b=MX3(b,C1[r+2],C1[r+3]);} \
      float rm=__builtin_fmaxf(a,b); { auto rr=__builtin_amdgcn_permlane32_swap(__float_as_uint(rm),__float_as_uint(rm),false,false); rm=__builtin_fmaxf(__uint_as_float(rr[0]),__uint_as_float(rr[1])); } \
      resc=false; \
      if(__builtin_expect(__any(rm>(float)THRL),0)){ const float dl=__builtin_fmaxf(rm,0.f); mhat+=dl; \
        _Pragma("unroll") for(int r=0;r<16;++r){C0[r]-=dl;C1[r]-=dl;} \
        _Pragma("unroll") for(int r=0;r<16;++r)negm[r]=-mhat; asm volatile("":"+v"(negm)); \
        const float f=__builtin_amdgcn_exp2f(-dl); l_reg*=f; if(hi==0)wsf[r32]=f; resc=true; } } \
    SBAR(); \
    GAPB(o[0]=__builtin_amdgcn_mfma_f32_32x32x16_bf16(PAF(0),VFR(0),o[0],0,0,0), C0,0); \
    GAPB(o[1]=__builtin_amdgcn_mfma_f32_32x32x16_bf16(PAF(0),VFR(4),o[1],0,0,0), C0,4); \
    KRD(GL,0); GAPB(o[0]=__builtin_amdgcn_mfma_f32_32x32x16_bf16(PAF(1),VFR(1),o[0],0,0,0), C0,8); \
    KRD(GL,1); GAPB(o[1]=__builtin_amdgcn_mfma_f32_32x32x16_bf16(PAF(1),VFR(5),o[1],0,0,0), C0,12); \
    KRD(GL,2); GAPB(o[0]=__builtin_amdgcn_mfma_f32_32x32x16_bf16(PAF(2),VFR(2),o[0],0,0,0), C1,0); \
    KRD(GL,3); GAPB(o[1]=__builtin_amdgcn_mfma_f32_32x32x16_bf16(PAF(2),VFR(6),o[1],0,0,0), C1,4); \
    GAPB(o[0]=__builtin_amdgcn_mfma_f32_32x32x16_bf16(PAF(3),VFR(3),o[0],0,0,0), C1,8); \
    GAPB(o[1]=__builtin_amdgcn_mfma_f32_32x32x16_bf16(PAF(3),VFR(7),o[1],0,0,0), C1,12); \
    }while(0)
  int t=1;
  #undef CMASK
  #define CMASK(P0,P1,t) do{}while(0)
  for(;t+5<NT;t+=2){
    STEP(pB0,pB1,pA0,pA1,t,true,true,true);     WAIT_BAR(2); RESC(); ROT();
    STEP(pA0,pA1,pB0,pB1,t+1,true,true,true);   WAIT_BAR(2); RESC(); ROT();
  }
  #undef CMASK
  #define CMASK(P0,P1,t) do{}while(0)
  #define ENDW(tt) do{ if((tt)+3<NT){WAIT_BAR(2);} else if((tt)+2<NT){WAIT_BAR(1);} else {WAIT_BAR(0);} }while(0)
  for(;t+1<NT;t+=2){
    STEP(pB0,pB1,pA0,pA1,t,(t+3<NT),(t+1<NT),(t+1<NT));       ENDW(t);   RESC(); ROT();
    STEP(pA0,pA1,pB0,pB1,t+1,(t+4<NT),(t+2<NT),(t+2<NT));     ENDW(t+1); RESC(); ROT();
  }
  STEP(pB0,pB1,pA0,pA1,NT-1,false,false,false); RESC();
  { float sacc=pB0[0]+pB0[1]; _Pragma("unroll") for(int r=2;r<16;++r)sacc+=pB0[r]; _Pragma("unroll") for(int r=0;r<16;++r)sacc+=pB1[r]; l_reg+=sacc;
    pw0=(u32x4){PKW(pB0,0),PKW(pB0,2),PKW(pB0,4),PKW(pB0,6)};pw1=(u32x4){PKW(pB0,8),PKW(pB0,10),PKW(pB0,12),PKW(pB0,14)};pw2=(u32x4){PKW(pB1,0),PKW(pB1,2),PKW(pB1,4),PKW(pB1,6)};pw3=(u32x4){PKW(pB1,8),PKW(pB1,10),PKW(pB1,12),PKW(pB1,14)};
    SBAR(); pv(o,vb0+sl_cur,PAF(0),PAF(1),PAF(2),PAF(3)); }
  #undef PKW
  #undef PAF
  #undef VFR
  #undef PIN
  #undef MX3
  #undef GAPA
  #undef GAPB
  #undef EX
  #undef VRD
  #undef KRD
  #undef STEP
  #undef ENDW
  {auto rr=__builtin_amdgcn_permlane32_swap(__float_as_uint(l_reg),__float_as_uint(l_reg),false,false);l_reg=__uint_as_float(rr[0])+__uint_as_float(rr[1]);}
  if(hi==0)wsf[32+r32]=l_reg;asm volatile("s_waitcnt lgkmcnt(0)":::"memory");
  float rli[16];
  #pragma unroll
  for(int r=0;r<16;++r)rli[r]=__builtin_amdgcn_rcpf(wsf[32+crow(r,hi)]);
  bf16*Ow=O+(rowbase+q0+wid*QBLK)*OP+h*D;
  { bf16*stg=(bf16*)(shm+LDS_OST)+wid*2048;
    #pragma unroll
    for(int r=0;r<16;++r){const int orow=crow(r,hi);
      #pragma unroll
      for(int d0=0;d0<2;++d0)stg[orow*64+d0*32+r32]=__float2bfloat16(o[d0][r]*rli[r]);}
    asm volatile("s_waitcnt lgkmcnt(0)":::"memory");
    #pragma unroll
    for(int i=0;i<4;++i){const int row=i*8+(lane>>3),ch=lane&7; const u32x4 v=*(const u32x4*)(stg+row*64+ch*8); ATTN_STORE16(Ow+(long)row*OP+ch*8,v);} }
  asm volatile("s_waitcnt lgkmcnt(0)\n\ts_barrier":::"memory");
  #undef DMA_K
  #undef DMA_V
  #undef CMASK
  #undef START
  #undef RESC
  #undef ROT
}
constexpr int ATTN_LDS_BYTES=LDS_BYTES;
template<int THRL=8> __device__ __forceinline__ void attn_phase(char*lds,const bf16*Q,const bf16*K,const bf16*V,bf16*O,int vcu,int G){
  for(int u=vcu;u<BATCH*NHEAD*(SEQ/QB);u+=G){ const int grp=u>>5, r=u&31; const int b=grp>>1, kvh=grp&1, hq=r>>3, qb=r&7; attn_unit<THRL>(b,kvh*4+hq,qb,Q,K,V,O,lds); }
}
#undef SBAR
#undef WAIT_BAR
}

constexpr size_t MiB = 1u << 20;
constexpr size_t WS_CTL = 0, CTL_ZERO_BYTES = 16384;
constexpr size_t WS_ROPE = 1 * MiB, WS_SS = 2 * MiB;
constexpr size_t WS_WIN = 4 * MiB, WS_WXKV = 11 * MiB, WS_WCAT = 15 * MiB, WS_WOUT = 17 * MiB, WS_WXQ = 19 * MiB, WS_WXO = 21 * MiB, WS_WFF1 = 23 * MiB, WS_WFF2 = 31 * MiB;
constexpr size_t WS_MN = 40 * MiB, WS_XK = 48 * MiB, WS_XVT = 56 * MiB, WS_HB = 64 * MiB;
constexpr size_t WS_R1 = 128 * MiB;
constexpr size_t WS_R2 = 192 * MiB;
constexpr size_t WS_R3 = 256 * MiB;
constexpr size_t WS_G = 320 * MiB;
constexpr size_t WS_F = 128 * MiB;
constexpr size_t WS_END = 448 * MiB;

constexpr int NWAVES = 8;
constexpr int RING_BYTES = 131072, XCH_OFF = RING_BYTES, MISC_OFF = XCH_OFF + 8192, LDS_BYTES = 147456;
#define GAS __attribute__((address_space(1)))
#define LAS __attribute__((address_space(3)))
typedef unsigned short bf16;
typedef unsigned v4u __attribute__((ext_vector_type(4)));
typedef float f32x4 __attribute__((ext_vector_type(4)));

__device__ __forceinline__ unsigned f2bf(float f) { unsigned u = __builtin_bit_cast(unsigned, f); return (u + 0x7fffu + ((u >> 16) & 1u)) >> 16; }
__device__ __forceinline__ unsigned pk2(float lo, float hi) { return f2bf(lo) | (f2bf(hi) << 16); }
__device__ __forceinline__ float wave_sum(float v) {
#pragma unroll
    for (int o = 1; o < 64; o <<= 1) v += __shfl_xor(v, o);
    return v;
}
#define LDS_WAIT() asm volatile("s_waitcnt lgkmcnt(0)" ::: "memory")

__device__ __forceinline__ void p0_transpose_item(const float* W, int ldw, bf16* WT, int ldt, LAS float* scr, int item, int nblk, int lane, const float* gk) {
    const int kb = item / nblk, nb = item % nblk, k0 = 64 * kb, n0 = 32 * nb;
#pragma unroll 16
    for (int i = 0; i < 32; ++i) { const int kk = 2 * i + (lane >> 5); float v = W[(size_t)(k0 + kk) * ldw + n0 + (lane & 31)]; if (gk) v *= gk[k0 + kk]; scr[kk * 33 + (lane & 31)] = v; }
    LDS_WAIT(); asm volatile("" ::: "memory");
    const int c = lane & 7;
#pragma unroll
    for (int j = 0; j < 4; ++j) { const int n = (lane >> 3) + 8 * j; const LAS float* s = scr + (8 * c) * 33 + n;
        v4u o; o.x = pk2(s[0 * 33], s[1 * 33]); o.y = pk2(s[2 * 33], s[3 * 33]); o.z = pk2(s[4 * 33], s[5 * 33]); o.w = pk2(s[6 * 33], s[7 * 33]);
        *(v4u*)(WT + (size_t)(n0 + n) * ldt + k0 + 8 * c) = o; }
    LDS_WAIT(); asm volatile("" ::: "memory");
}
template <int R> __device__ __forceinline__ void rms_rows_to_bf16(const float* xrow, const float* g, bf16* orow, int lane) {
    const f32x4* gr = (const f32x4*)g + lane;
    f32x4 v[R][4]; float s[R];
#pragma unroll
    for (int r = 0; r < R; ++r) { const f32x4* xr = (const f32x4*)(xrow + (size_t)r * 1024) + lane;
#pragma unroll
        for (int j = 0; j < 4; ++j) v[r][j] = xr[64 * j]; }
#pragma unroll
    for (int r = 0; r < R; ++r) { s[r] = 0.f;
#pragma unroll
        for (int j = 0; j < 4; ++j) s[r] += (v[r][j].x * v[r][j].x + v[r][j].y * v[r][j].y) + (v[r][j].z * v[r][j].z + v[r][j].w * v[r][j].w); }
#pragma unroll
    for (int r = 0; r < R; ++r) { const float rs = 1.0f / sqrtf(wave_sum(s[r]) * (1.f / 1024.f) + EPS);
        unsigned long long* o8 = (unsigned long long*)(orow + (size_t)r * 1024) + lane;
#pragma unroll
        for (int j = 0; j < 4; ++j) { const f32x4 gg = gr[64 * j]; o8[64 * j] = (unsigned long long)pk2(v[r][j].x * rs * gg.x, v[r][j].y * rs * gg.y) | ((unsigned long long)pk2(v[r][j].z * rs * gg.z, v[r][j].w * rs * gg.w) << 32); } }
}

typedef GAS unsigned gu32;
#define RLX_AGENT __ATOMIC_RELAXED, __HIP_MEMORY_SCOPE_AGENT
#define XB_TMO      128
#define XB_XCNT(j)  (256  + 64 * (j))
#define XB_XSUB(j)  (1280 + 64 * (j))
#define XB_XGEN(j)  (2304 + 64 * (j))
#define XB_TOP      3328
#define XB_TOPGEN   3392
#define XCD_BAR_WORDS 3456
#define XB_SPIN_CAP (1u << 18)

__device__ __forceinline__ unsigned xb_ld(unsigned* p)              { return __hip_atomic_load(p, __ATOMIC_RELAXED, __HIP_MEMORY_SCOPE_AGENT); }
__device__ __forceinline__ unsigned xb_add(unsigned* p, unsigned v) { return __hip_atomic_fetch_add(p, v, __ATOMIC_RELAXED, __HIP_MEMORY_SCOPE_AGENT); }
__device__ __forceinline__ unsigned xb_xcc_id() { return (unsigned)__builtin_amdgcn_s_getreg((3 << 11) | 20) & 0xFu; }
#define XB_SPIN(cond, bar) do { unsigned _sp = 0; while (cond) { __builtin_amdgcn_s_sleep(1); \
    if ((++_sp & 255u) == 0u) { if (xb_ld(&(bar)[XB_TMO])) break; if (_sp > XB_SPIN_CAP) { atomicAdd(&(bar)[XB_TMO], 1u); break; } } } } while (0)

struct XcdBarrier {
    unsigned* bar; unsigned x;
    volatile LAS unsigned* st;
};

__device__ __forceinline__ XcdBarrier xcd_barrier_post(unsigned* bar, volatile LAS unsigned* st) {
    XcdBarrier b; b.bar = bar; b.x = xb_xcc_id(); b.st = st;
    if (threadIdx.x == 0) (void)xb_add(&bar[XB_XCNT(b.x)], 1u);
    return b;
}
__device__ __forceinline__ void xcd_barrier_complete(unsigned* bar, unsigned x, unsigned& nloc, unsigned& nx) {
    const unsigned G = gridDim.x * gridDim.y * gridDim.z;
    unsigned sum, cnt, mine, sp = 0u;
    for (;;) {
        sum = 0u; cnt = 0u; mine = 0u;
#pragma unroll
        for (unsigned j = 0; j < 16; ++j) { const unsigned c = xb_ld(&bar[XB_XCNT(j)]); sum += c; cnt += (c > 0u) ? 1u : 0u; mine = (j == x) ? c : mine; }
        if (sum == G) break;
        __builtin_amdgcn_s_sleep(1);
        if ((++sp & 255u) == 0u) { if (xb_ld(&bar[XB_TMO])) break; if (sp > XB_SPIN_CAP) { atomicAdd(&bar[XB_TMO], 1u); break; } }
    }
    nloc = mine > 0u ? mine : 1u; nx = cnt > 0u ? cnt : 1u;
}

__device__ __forceinline__ void xcd_barrier(const XcdBarrier& b) {
    asm volatile("s_waitcnt vmcnt(0)" ::: "memory");
    __syncthreads();
    if (threadIdx.x == 0) {
        unsigned* bar = b.bar;
        __builtin_amdgcn_s_waitcnt(0);
        unsigned nloc = b.st[0], nx = b.st[1];
        if (nloc == 0u) { xcd_barrier_complete(bar, b.x, nloc, nx); b.st[0] = nloc; b.st[1] = nx; }
        const unsigned old = xb_add(&bar[XB_XSUB(b.x)], 1u);
        const unsigned gen = old / nloc;
        if (old + 1u == (gen + 1u) * nloc) {
            __builtin_amdgcn_fence(__ATOMIC_RELEASE, "agent");
            asm volatile("s_waitcnt vmcnt(0)" ::: "memory");
            const unsigned og = xb_add(&bar[XB_TOP], 1u);
            const unsigned tg = og / nx;
            if (og + 1u == (tg + 1u) * nx) xb_add(&bar[XB_TOPGEN], 1u);
            else XB_SPIN(xb_ld(&bar[XB_TOPGEN]) == tg, bar);
            __builtin_amdgcn_fence(__ATOMIC_ACQUIRE, "agent");
            xb_add(&bar[XB_XGEN(b.x)], 1u);
            asm volatile("s_waitcnt vmcnt(0)" ::: "memory");
        } else {
            XB_SPIN(xb_ld(&bar[XB_XGEN(b.x)]) == gen, bar);
            __builtin_amdgcn_fence(__ATOMIC_ACQUIRE, "agent");
            asm volatile("s_waitcnt vmcnt(0)" ::: "memory");
        }
    }
    __syncthreads();
}

struct Args {
    const float* in[21]; float* out; unsigned char* ws; int ph_lo, ph_hi;
};
enum { I_X = 0, I_MEM, I_GMIX, I_WIN, I_BGATE, I_GQ, I_GK, I_WATTN, I_POOLW, I_PSCALE, I_WPOOL, I_WOUT, I_GCROSS, I_GMEM, I_WXQ, I_WXKV, I_WXO, I_GFFN, I_WFF1, I_WFF2, I_GFINAL };
constexpr int N_PHASES = 12;

__global__ void __launch_bounds__(NWAVES * 64, 2) mega_fwd(Args args) {
    extern __shared__ __attribute__((aligned(16))) unsigned char lds[];
    LAS unsigned char* ldsp = (LAS unsigned char*)lds;
    LAS float* xch = (LAS float*)(ldsp + XCH_OFF);
    const int tid = threadIdx.x, lane = tid & 63, wave = __builtin_amdgcn_readfirstlane(tid >> 6);
    const int G = gridDim.x; const int bx = blockIdx.x;
    const int vcu = (G % 8 == 0) ? (bx % 8) * (G / 8) + bx / 8 : bx;
    unsigned char* ws = args.ws;
    const int lo = args.ph_lo, hi = args.ph_hi;
    bf16* Win_t = (bf16*)(ws + WS_WIN); bf16* Wxkv_t = (bf16*)(ws + WS_WXKV); bf16* Wcat_t = (bf16*)(ws + WS_WCAT); bf16* Wout_t = (bf16*)(ws + WS_WOUT);
    bf16* Wxq_t = (bf16*)(ws + WS_WXQ); bf16* Wxo_t = (bf16*)(ws + WS_WXO); bf16* Wff1_t = (bf16*)(ws + WS_WFF1); bf16* Wff2_t = (bf16*)(ws + WS_WFF2);
    float* ROPE = (float*)(ws + WS_ROPE); float* SS = (float*)(ws + WS_SS);
    bf16* MNb = (bf16*)(ws + WS_MN); bf16* XK = (bf16*)(ws + WS_XK); bf16* XVT = (bf16*)(ws + WS_XVT); bf16* HB = (bf16*)(ws + WS_HB);
    bf16* N1 = (bf16*)(ws + WS_R1); bf16* AP = (bf16*)(ws + WS_R1); bf16* Pm = (bf16*)(ws + WS_R1);
    bf16* Qb = (bf16*)(ws + WS_R2); bf16* Kb = (bf16*)(ws + WS_R2 + 32 * MiB); bf16* Vb = (bf16*)(ws + WS_R2 + 40 * MiB); bf16* MIX = (bf16*)(ws + WS_R2); bf16* XO = (bf16*)(ws + WS_R2);
    bf16* Ub = (bf16*)(ws + WS_R3); bf16* XQ = (bf16*)(ws + WS_R3);
    bf16* Gt = (bf16*)(ws + WS_G); bf16* Fb = (bf16*)(ws + WS_F);
    float* OUT = args.out;

    volatile LAS unsigned* MISC = (volatile LAS unsigned*)(ldsp + MISC_OFF);
    if (tid < 32) MISC[tid] = 0u;
    __syncthreads();
    XcdBarrier bar; bar.bar = (unsigned*)(ws + WS_CTL); bar.x = 0; bar.st = nullptr;
    if (!MK_PER_PHASE) bar = xcd_barrier_post((unsigned*)(ws + WS_CTL), MISC + 8);
    if (hi > 1000) cg::this_grid().sync();
#ifndef PHASE_MASK
#define PHASE_MASK 0xFFF
#endif
#define IN(k) (((PHASE_MASK >> (k)) & 1) && lo <= (k) && (k) < hi)
#ifndef REPEAT_MASK
#define REPEAT_MASK 0
#endif
#ifndef EXTRA_SYNCS
#define EXTRA_SYNCS 0
#endif
#define PHASE(k) if (IN(k)) for (int rep_ = 0; rep_ <= ((REPEAT_MASK >> (k)) & 1); ++rep_)
#define REP_SYNC() do { if (rep_) xcd_barrier(bar); } while (0)
#define SEAM(k) do { if (IN(k) && IN((k) + 1)) { xcd_barrier(bar); } } while (0)
    const int gw = vcu * NWAVES + wave, NGW = G * NWAVES;

    PHASE(0) { REP_SYNC();
        LAS float* scr = (LAS float*)(ldsp + wave * 16384);
        constexpr int I0 = 16 * 104, I1 = 16 * 64, I2 = 8 * 32, I3 = 16 * 32, I4 = 16 * 32, I5 = 16 * 32, I6 = 16 * 128, I7 = 64 * 32, IFOLD = 1024;
        constexpr int NITEMS = I0 + I1 + I2 + I3 + I4 + I5 + I6 + I7 + IFOLD;
        for (int it = gw; it < NITEMS; it += NGW) {
            int r = it;
            if (r < IFOLD) {
                const int g = r >> 8, cb = (r >> 4) & 15, nb = r & 15, n = nb * 64 + lane, c0 = cb * 8;
                const float* pw = args.in[I_POOLW] + (size_t)g * 128 * 128 + (size_t)c0 * 128; const float* ps = args.in[I_PSCALE] + g * 128; const float* wp = args.in[I_WPOOL] + (size_t)g * 128 * 1024 + n;
                float a[8];
#pragma unroll
                for (int cc = 0; cc < 8; ++cc) a[cc] = 0.f;
                for (int d0 = 0; d0 < 128; d0 += 16) { float w[16];
#pragma unroll
                    for (int dd = 0; dd < 16; ++dd) w[dd] = wp[(size_t)(d0 + dd) * 1024];
#pragma unroll
                    for (int dd = 0; dd < 16; ++dd) { const float ws_ = w[dd] * ps[d0 + dd];
#pragma unroll
                        for (int cc = 0; cc < 8; ++cc) a[cc] += pw[cc * 128 + d0 + dd] * ws_; } }
                v4u o; o.x = pk2(a[0], a[1]); o.y = pk2(a[2], a[3]); o.z = pk2(a[4], a[5]); o.w = pk2(a[6], a[7]);
                *(v4u*)(Wcat_t + (size_t)n * 1024 + 512 + g * 128 + c0) = o;
                continue; } r -= IFOLD;
            if (r < I0) { p0_transpose_item(args.in[I_WIN], INW, Win_t, 1024, scr, r, 104, lane, nullptr); continue; } r -= I0;
            if (r < I1) { p0_transpose_item(args.in[I_WXKV], 2048, Wxkv_t, 1024, scr, r, 64, lane, nullptr); continue; } r -= I1;
            if (r < I2) { p0_transpose_item(args.in[I_WATTN], 1024, Wcat_t, 1024, scr, r, 32, lane, nullptr); continue; } r -= I2;
            if (r < I3) { p0_transpose_item(args.in[I_WOUT], 1024, Wout_t, 1024, scr, r, 32, lane, nullptr); continue; } r -= I3;
            if (r < I4) { p0_transpose_item(args.in[I_WXQ], 1024, Wxq_t, 1024, scr, r, 32, lane, args.in[I_GCROSS]); continue; } r -= I4;
            if (r < I5) { p0_transpose_item(args.in[I_WXO], 1024, Wxo_t, 1024, scr, r, 32, lane, nullptr); continue; } r -= I5;
            if (r < I6) { p0_transpose_item(args.in[I_WFF1], 4096, Wff1_t, 1024, scr, r, 128, lane, args.in[I_GFFN]); continue; } r -= I6;
            p0_transpose_item(args.in[I_WFF2], 1024, Wff2_t, 4096, scr, r, 32, lane, nullptr);
        }
        {
            const int gt = vcu * NWAVES * 64 + tid;
            if (gt < 1024) { const int pos = gt >> 4, f = gt & 15; const float inv = exp2f(-(float)f * (13.287712379549449f / 16.0f));
                const float ang = (float)pos * inv; float rev = ang * 0.15915494309189535f; rev -= floorf(rev);
                ROPE[gt] = __builtin_amdgcn_cosf(rev); ROPE[1024 + gt] = __builtin_amdgcn_sinf(rev); }
        }
        for (int m4 = gw; m4 < (TOK + MTOK) / 4; m4 += NGW) { const int m = m4 * 4;
            if (m < TOK) rms_rows_to_bf16<4>(args.in[I_X] + (size_t)m * DM, args.in[I_GMIX], N1 + (size_t)m * DM, lane);
            else rms_rows_to_bf16<4>(args.in[I_MEM] + (size_t)(m - TOK) * DM, args.in[I_GMEM], MNb + (size_t)(m - TOK) * DM, lane);
        }
    }
    SEAM(0);

    PHASE(1) { REP_SYNC();
        typedef pg8::ProbP1<(long)WS_R1, (long)WS_WIN, (long)WS_MN, (long)WS_WXKV> P1; P1 S; S.ws = (const char*)ws; S.G = G; S.c = bx; S.K = 1024; S.lda = 1024; S.ldb = 1024; S.mid = -1;
        pg8::EpiP1 E{Qb, Kb, Vb, Ub, Gt, XK, XVT, args.in[I_BGATE], args.in[I_GQ], args.in[I_GK], ROPE};
        pg8::gemm_phase<pg8::EpiP1, P1, true, true>(ldsp, xch, S, E);
    }
    SEAM(1);

    PHASE(2) { REP_SYNC();
        attn_body::attn_phase((char*)lds, (const attn_body::bf16*)Qb, (const attn_body::bf16*)Kb, (const attn_body::bf16*)Vb, (attn_body::bf16*)AP, vcu, G);
        const int grp = lane >> 4, hw = 1 << grp;
        for (int ch = gw; ch < TOK / 16; ch += NGW) {
            const int t0 = ch * 16, s0 = t0 & (SEQ - 1);
            const bf16* ub = Ub + (size_t)(t0 - s0) * 512 + lane * 8;
            float a[8];
#pragma unroll
            for (int j = 0; j < 8; ++j) a[j] = 0.f;
#pragma unroll
            for (int k = 0; k < 16; ++k) { const int r = s0 - hw + k;
                if (k < 2 * hw && r >= 0 && r < SEQ) { const v4u w = *(const v4u*)(ub + (size_t)r * 512);
                    a[0] += pg8::bf_lo(w.x); a[1] += pg8::bf_hi(w.x); a[2] += pg8::bf_lo(w.y); a[3] += pg8::bf_hi(w.y); a[4] += pg8::bf_lo(w.z); a[5] += pg8::bf_hi(w.z); a[6] += pg8::bf_lo(w.w); a[7] += pg8::bf_hi(w.w); } }
#pragma unroll 4
            for (int i = 0; i < 16; ++i) { const int s = s0 + i; const int lo_s = max(s - hw, 0), hi_s = min(s + hw, SEQ);
                const v4u w = *(const v4u*)(ub + (size_t)s * 512); const float ic = 1.0f / (float)(hi_s - lo_s);
                v4u o; o.x = pk2(a[0] * ic - pg8::bf_lo(w.x), a[1] * ic - pg8::bf_hi(w.x)); o.y = pk2(a[2] * ic - pg8::bf_lo(w.y), a[3] * ic - pg8::bf_hi(w.y));
                o.z = pk2(a[4] * ic - pg8::bf_lo(w.z), a[5] * ic - pg8::bf_hi(w.z)); o.w = pk2(a[6] * ic - pg8::bf_lo(w.w), a[7] * ic - pg8::bf_hi(w.w));
                *(v4u*)(AP + (size_t)(t0 + i) * 1024 + 512 + lane * 8) = o;
                if (s + hw < SEQ) { const v4u p = *(const v4u*)(ub + (size_t)(s + hw) * 512);
                    a[0] += pg8::bf_lo(p.x); a[1] += pg8::bf_hi(p.x); a[2] += pg8::bf_lo(p.y); a[3] += pg8::bf_hi(p.y); a[4] += pg8::bf_lo(p.z); a[5] += pg8::bf_hi(p.z); a[6] += pg8::bf_lo(p.w); a[7] += pg8::bf_hi(p.w); }
                if (s - hw >= 0) { const v4u q = *(const v4u*)(ub + (size_t)(s - hw) * 512);
                    a[0] -= pg8::bf_lo(q.x); a[1] -= pg8::bf_hi(q.x); a[2] -= pg8::bf_lo(q.y); a[3] -= pg8::bf_hi(q.y); a[4] -= pg8::bf_lo(q.z); a[5] -= pg8::bf_hi(q.z); a[6] -= pg8::bf_lo(q.w); a[7] -= pg8::bf_hi(q.w); }
            }
        }
    }
    SEAM(2);

    PHASE(3) { REP_SYNC();
        pg8::ProbMN S = pg8::make_plain(AP, Wcat_t, TOK, 1024, 1024, G, bx); S.mid = 8;
        pg8::EpiMix E{Gt, MIX};
        pg8::gemm_phase<pg8::EpiMix, pg8::ProbMN, true, true>(ldsp, xch, S, E);
    }
    SEAM(3);

    PHASE(4) { REP_SYNC();
        pg8::ProbMN S = pg8::make_plain(MIX, Wout_t, TOK, 1024, 1024, G, bx);
        pg8::EpiRes<0> E{args.in[I_X], HB, SS};
        pg8::gemm_phase<pg8::EpiRes<0>, pg8::ProbMN, true, true>(ldsp, xch, S, E);
    }
    SEAM(4);

    PHASE(5) { REP_SYNC();
        pg8::ProbMN S = pg8::make_plain(HB, Wxq_t, TOK, 1024, 1024, G, bx);
        pg8::EpiRowScale<0> E{SS, XQ, 1024, XSCALE};
        pg8::gemm_phase<pg8::EpiRowScale<0>, pg8::ProbMN, true, true>(ldsp, xch, S, E);
    }
    SEAM(5);

    PHASE(6) { REP_SYNC();
        pg8::ProbMN S; S.A = XQ; S.B = XK; S.nM = TOK / 256; S.nN = 4; S.G = G; S.c = bx; S.K = 256; S.lda = 1024; S.ldb = 1024; S.mid = -1;
        S.a_pm = 256L * 1024; S.a_pn = 256; S.b_pb = 256L * 1024; S.b_pn = 256;
        pg8::EpiSoftmax E{Pm};
        pg8::gemm_phase<pg8::EpiSoftmax, pg8::ProbMN, true, true>(ldsp, xch, S, E);
    }
    SEAM(6);

    PHASE(7) { REP_SYNC();
        pg8::ProbMN S; S.A = Pm; S.B = XVT; S.nM = TOK / 256; S.nN = 4; S.G = G; S.c = bx; S.K = 256; S.lda = 1024; S.ldb = 4096; S.mid = -1;
        S.a_pm = 256L * 1024; S.a_pn = 256; S.b_pb = 256; S.b_pn = 256L * 4096;
        pg8::EpiPlain E{XO, 1024};
        pg8::gemm_phase<pg8::EpiPlain, pg8::ProbMN, true, true>(ldsp, xch, S, E);
    }
    SEAM(7);

    PHASE(8) { REP_SYNC();
        pg8::ProbMN S = pg8::make_plain(XO, Wxo_t, TOK, 1024, 1024, G, bx);
        pg8::EpiRes<1> E{nullptr, HB, SS};
        pg8::gemm_phase<pg8::EpiRes<1>, pg8::ProbMN, true, true>(ldsp, xch, S, E);
    }
    SEAM(8);

    PHASE(9) { REP_SYNC();
        pg8::ProbMN S = pg8::make_plain(HB, Wff1_t, TOK, 4096, 1024, G, bx);
        pg8::EpiRowScale<1> E{SS, Fb, 4096, 1.0f};
        pg8::gemm_phase<pg8::EpiRowScale<1>, pg8::ProbMN, true, true>(ldsp, xch, S, E);
    }
    SEAM(9);

    PHASE(10) { REP_SYNC();
        pg8::ProbMN S = pg8::make_plain(Fb, Wff2_t, TOK, 1024, 4096, G, bx);
        pg8::EpiRes<1> E{nullptr, HB, SS};
        pg8::gemm_phase<pg8::EpiRes<1>, pg8::ProbMN, true, true>(ldsp, xch, S, E);
    }
    SEAM(10);

    PHASE(11) { REP_SYNC();
        const f32x4* gf = (const f32x4*)args.in[I_GFINAL];
        const f32x4 g0 = gf[2 * lane], g1 = gf[2 * lane + 1], g2 = gf[128 + 2 * lane], g3 = gf[128 + 2 * lane + 1];
        for (int m4 = gw; m4 < TOK / 4; m4 += NGW) { const int m = m4 * 4;
            v4u w0[4], w1[4]; float sp[4];
#pragma unroll
            for (int r = 0; r < 4; ++r) { const bf16* hr = HB + (size_t)(m + r) * DM + lane * 8; w0[r] = *(const v4u*)hr; w1[r] = *(const v4u*)(hr + 512); sp[r] = (lane < 16) ? SS[(size_t)(m + r) * 16 + lane] : 0.f; }
#pragma unroll
            for (int r = 0; r < 4; ++r) { const float rs = 1.0f / sqrtf(wave_sum(sp[r]) * (1.f / 1024.f) + EPS);
                f32x4* orow = (f32x4*)(OUT + (size_t)(m + r) * DM) + 2 * lane;
                orow[0] = (f32x4){pg8::bf_lo(w0[r].x), pg8::bf_hi(w0[r].x), pg8::bf_lo(w0[r].y), pg8::bf_hi(w0[r].y)} * rs * g0;
                orow[1] = (f32x4){pg8::bf_lo(w0[r].z), pg8::bf_hi(w0[r].z), pg8::bf_lo(w0[r].w), pg8::bf_hi(w0[r].w)} * rs * g1;
                orow[128] = (f32x4){pg8::bf_lo(w1[r].x), pg8::bf_hi(w1[r].x), pg8::bf_lo(w1[r].y), pg8::bf_hi(w1[r].y)} * rs * g2;
                orow[129] = (f32x4){pg8::bf_lo(w1[r].z), pg8::bf_hi(w1[r].z), pg8::bf_lo(w1[r].w), pg8::bf_hi(w1[r].w)} * rs * g3; }
        }
    }
    for (int e_ = 0; e_ < EXTRA_SYNCS; ++e_) xcd_barrier(bar);
#undef IN
#undef SEAM
}

extern "C" void kernel_launch(void* const* d_in, const int* in_sizes, int n_in, void* d_out, int out_size, void* d_ws, size_t ws_size, hipStream_t stream) {
    static int grid = 0;
    if (grid == 0) {
        if (n_in != 21 || in_sizes[0] != TOK * DM || out_size != TOK * DM || ws_size < WS_END) {
            fprintf(stderr, "kernel_launch: unexpected shapes: n_in %d in0 %d out %d ws %zu (need >= %zu)\n", n_in, n_in > 0 ? in_sizes[0] : -1, out_size, ws_size, (size_t)WS_END); grid = -1; return; }
        int dev = 0, cus = 0, per_cu = 0;
        if (hipGetDevice(&dev) != hipSuccess || hipDeviceGetAttribute(&cus, hipDeviceAttributeMultiprocessorCount, dev) != hipSuccess) { grid = -1; return; }
        if (hipFuncSetAttribute((const void*)mega_fwd, hipFuncAttributeMaxDynamicSharedMemorySize, LDS_BYTES) != hipSuccess) { fprintf(stderr, "kernel_launch: hipFuncSetAttribute failed\n"); grid = -1; return; }
        if (hipOccupancyMaxActiveBlocksPerMultiprocessor(&per_cu, (const void*)mega_fwd, NWAVES * 64, LDS_BYTES) != hipSuccess || per_cu < 1) { fprintf(stderr, "kernel_launch: occupancy query says %d\n", per_cu); per_cu = 1; }
        (void)hipGetLastError();
        grid = cus * per_cu;
    }
    if (grid < 0) return;
    if (hipMemsetAsync((char*)d_ws + WS_CTL, 0, CTL_ZERO_BYTES, stream) != hipSuccess) { fprintf(stderr, "kernel_launch: memset failed\n"); return; }
    Args a{};
    for (int i = 0; i < 21; ++i) a.in[i] = (const float*)d_in[i];
    a.out = (float*)d_out; a.ws = (unsigned char*)d_ws;
#if MK_PER_PHASE
    for (int p = 0; p < N_PHASES; ++p) { a.ph_lo = p; a.ph_hi = p + 1; hipLaunchKernelGGL(mega_fwd, dim3(grid), dim3(NWAVES * 64), LDS_BYTES, stream, a); }
#else
    a.ph_lo = 0; a.ph_hi = N_PHASES;
    void* kargs[] = {&a};
    hipError_t e = hipLaunchCooperativeKernel((const void*)mega_fwd, dim3(grid), dim3(NWAVES * 64), kargs, LDS_BYTES, stream);
    if (e != hipSuccess) fprintf(stderr, "kernel_launch: cooperative launch failed: %s (grid %d)\n", hipGetErrorString(e), grid);
#endif
}
```

```cpp
#include <hip/hip_runtime.h>
#include <hip/hip_cooperative_groups.h>
#include <hip/hip_bf16.h>
#include <cstdio>
#include <cstdint>
#include <cmath>
namespace cg = cooperative_groups;

#ifndef MK_PER_PHASE
#define MK_PER_PHASE 0
#endif

constexpr int DM = 1024, NB = 16, SEQ = 2048, TOK = NB * SEQ, NMEM = 256, MTOK = NB * NMEM;
constexpr int INW = 3328, DFF = 4096;
constexpr float EPS = 1e-6f;
constexpr float LOG2E = 1.4426950408889634f;
constexpr float QSCALE = 0.125f * LOG2E;
constexpr float XSCALE = 0.0625f * LOG2E;

namespace pg8 {
#define PG8_LAS __attribute__((address_space(3)))
typedef unsigned short bf16_t;
typedef short bf16x8 __attribute__((ext_vector_type(8)));
typedef float f32x4 __attribute__((ext_vector_type(4)));
typedef float f32x2 __attribute__((ext_vector_type(2)));
typedef unsigned u32x4 __attribute__((ext_vector_type(4)));
typedef unsigned u32x2 __attribute__((ext_vector_type(2)));
typedef __bf16 bf16x2_t __attribute__((ext_vector_type(2)));
constexpr int BM = 256, BK = 64, HALF = 128, HTB = HALF * BK * 2, STAGE_BYTES = 8 * HTB, NXCD = 8, WGM = 8;

__host__ __device__ __forceinline__ int lds_byte(int r, int c) { const int st = (r >> 4) * 2 + (c >> 5), rr = r & 15, cc = c & 31, ob = rr * 64 + cc * 2; return st * 1024 + (ob ^ (((ob >> 9) & 1) << 5)); }
__host__ __device__ __forceinline__ void stage_rc(int b, int& R, int& C) { const int st = b / 1024, sb = b % 1024, swz = sb ^ (((sb >> 9) & 1) << 5); R = (st >> 1) * 16 + swz / 64; C = (st & 1) * 32 + (swz % 64) / 2; }
__host__ __device__ __forceinline__ int perm32(int rho) { const int n = rho >> 4, i = rho & 15; return 8 * (i >> 2) + 4 * n + (i & 3); }

struct Unit { int pm, pn, id; };
#define PG8_OPAQUE(x) asm volatile("" : "+v"(x))

__device__ __forceinline__ unsigned pk_bf16(float lo, float hi) { f32x2 v = {lo, hi}; bf16x2_t b = __builtin_convertvector(v, bf16x2_t); return __builtin_bit_cast(unsigned, b); }
__device__ __forceinline__ float bf_lo(unsigned w) { return __uint_as_float(w << 16); }
__device__ __forceinline__ float bf_hi(unsigned w) { return __uint_as_float(w & 0xffff0000u); }
#define PG8_FENCE() asm volatile("" ::: "memory")

__device__ __forceinline__ void remap_tile(int wgid, int nM, int nN, int& pm, int& pn) {
    const int nwg = nM * nN;
    { const int q = nwg / NXCD, r = nwg % NXCD, xcd = wgid % NXCD, off = wgid / NXCD; wgid = (xcd < r ? xcd * (q + 1) : r * (q + 1) + (xcd - r) * q) + off; }
    const int nig = WGM * nN, gid = wgid / nig, fm = gid * WGM, gsz = (nM - fm) < WGM ? (nM - fm) : WGM;
    pm = fm + ((wgid % nig) % gsz); pn = (wgid % nig) / gsz;
}

struct ProbMN {
    const bf16_t* A; const bf16_t* B; int nM, nN, G, c; int K, lda, ldb, mid; long a_pm, a_pn, b_pb, b_pn;
    __device__ __forceinline__ bool next(int i, Unit& u) const {
        const long L = (long)i * G + c; if (L >= (long)nM * nN) return false;
        remap_tile((int)L, nM, nN, u.pm, u.pn); u.id = 0; return true; }
    __device__ __forceinline__ const char* aptr(const Unit& u) const { return (const char*)(A + (size_t)u.pm * a_pm + (size_t)u.pn * a_pn); }
    __device__ __forceinline__ const char* bptr(const Unit& u) const { return (const char*)(B + (size_t)(u.pm >> 3) * b_pb + (size_t)u.pn * b_pn); }
};
__device__ __forceinline__ ProbMN make_plain(const bf16_t* A, const bf16_t* Bt, int M, int N, int K, int G, int c) {
    ProbMN p; p.A = A; p.B = Bt; p.nM = M / BM; p.nN = N / BM; p.G = G; p.c = c; p.K = K; p.lda = K; p.ldb = K; p.mid = -1;
    p.a_pm = (long)BM * K; p.a_pn = 0; p.b_pb = 0; p.b_pn = (long)BM * K; return p; }

template <long OFF_N1, long OFF_WIN, long OFF_MN, long OFF_WXKV> struct ProbP1 {
    const char* ws; int G, c; int K, lda, ldb, mid;
    static constexpr int NPROJ = 128 * 13, NXK = 64, NXV = 64;
    __device__ __forceinline__ bool next(int i, Unit& u) const {
        const int L = i * G + c; if (L >= NPROJ + NXK + NXV) return false;
        if (L < NPROJ) { remap_tile(L, 128, 13, u.pm, u.pn); u.id = 0; }
        else if (L < NPROJ + NXK) { const int e = L - NPROJ; u.pm = e >> 2; u.pn = e & 3; u.id = 1; }
        else { const int e = L - NPROJ - NXK; u.pm = e >> 4; u.pn = e & 15; u.id = 2; }
        return true; }
    __device__ __forceinline__ const char* aptr(const Unit& u) const {
        const long off = u.id == 0 ? OFF_N1 : (u.id == 1 ? OFF_MN : OFF_WXKV + 1024L * 1024 * 2); return ws + off + (long)u.pm * (256 * 1024 * 2); }
    __device__ __forceinline__ const char* bptr(const Unit& u) const {
        const long off = u.id == 0 ? OFF_WIN : (u.id == 1 ? OFF_WXKV : OFF_MN); return ws + off + (long)u.pn * (256 * 1024 * 2); }
};

typedef f32x4 Acc[2][2][4][2];

__device__ __forceinline__ void store_tile_bf16_np(const Acc& acc, bf16_t* base, int ldc, int wr, int wc, int fr, int fq) {
#pragma unroll
    for (int ai = 0; ai < 2; ++ai)
#pragma unroll
        for (int m = 0; m < 4; ++m) { bf16_t* rowp = base + (size_t)(ai * HALF + wr * 64 + m * 16 + fr) * ldc + wc * 32 + 4 * fq;
#pragma unroll
            for (int bj = 0; bj < 2; ++bj)
#pragma unroll
                for (int n = 0; n < 2; ++n) { const f32x4 v = acc[ai][bj][m][n]; u32x2 w; w.x = pk_bf16(v[0], v[1]); w.y = pk_bf16(v[2], v[3]); *(u32x2*)(rowp + bj * HALF + n * 16) = w; } }
}

struct EpiP1 {
    static constexpr bool PERM = false, AFTER_DRAIN = false, HAS_MID = false;
    bf16_t *Q, *Kb, *Vb, *U, *Gt, *XK, *XVT; const float *bgate, *gq, *gk, *rope;
    __device__ __forceinline__ void mid(Acc&, const Unit&, int, int, int, int) const {}
    __device__ __forceinline__ void qk_rope(Acc& acc, const Unit& u, int wr, int wc, int fr, int fq, PG8_LAS float* xch, int wid, int bj, const float* gain, float oscale, bf16_t* out, int ldo, int ocol0) const {
#pragma unroll
        for (int ai = 0; ai < 2; ++ai)
#pragma unroll
            for (int m = 0; m < 4; ++m) {
                const f32x4 a = acc[ai][bj][m][0], b = acc[ai][bj][m][1];
                float s = (a[0] * a[0] + a[1] * a[1]) + (a[2] * a[2] + a[3] * a[3]) + (b[0] * b[0] + b[1] * b[1]) + (b[2] * b[2] + b[3] * b[3]);
                s += __shfl_xor(s, 16); s += __shfl_xor(s, 32);
                if (fq == 0) xch[wid * 128 + (ai * 4 + m) * 16 + fr] = s;
            }
        asm volatile("s_waitcnt lgkmcnt(0)" ::: "memory"); __builtin_amdgcn_s_barrier(); PG8_FENCE();
        const int axis = wc & 1;
        const int d0 = axis * 32 + 4 * fq;
        const f32x4 g0 = *(const f32x4*)(gain + d0), g1 = *(const f32x4*)(gain + d0 + 16);
        const int gridrow0 = (u.pm & 7) * 4 + wr;
#pragma unroll
        for (int ai = 0; ai < 2; ++ai)
#pragma unroll
            for (int m = 0; m < 4; ++m) {
                const int xi = (ai * 4 + m) * 16 + fr;
                const float tot = xch[wid * 128 + xi] + xch[(wid ^ 1) * 128 + xi];
                const float rs = __builtin_amdgcn_rsqf(tot * (1.0f / 64.0f) + EPS) ;
                const int pos = axis ? (m * 16 + fr) : (gridrow0 + 2 * ai);
                const f32x4 cs = *(const f32x4*)(rope + pos * 16 + 4 * fq), sn = *(const f32x4*)(rope + 1024 + pos * 16 + 4 * fq);
                const f32x4 x0 = acc[ai][bj][m][0] * rs * g0, x1 = acc[ai][bj][m][1] * rs * g1;
                const f32x4 y0 = (x0 * cs - x1 * sn) * oscale, y1 = (x1 * cs + x0 * sn) * oscale;
                bf16_t* rowp = out + (size_t)(u.pm * BM + ai * HALF + wr * 64 + m * 16 + fr) * ldo + ocol0 + wc * 32 + 4 * fq;
                u32x2 w0, w1; w0.x = pk_bf16(y0[0], y0[1]); w0.y = pk_bf16(y0[2], y0[3]); w1.x = pk_bf16(y1[0], y1[1]); w1.y = pk_bf16(y1[2], y1[3]);
                *(u32x2*)(rowp) = w0; *(u32x2*)(rowp + 16) = w1;
            }
        asm volatile("s_waitcnt lgkmcnt(0)" ::: "memory"); __builtin_amdgcn_s_barrier(); PG8_FENCE();
    }
    __device__ __forceinline__ void operator()(Acc& acc, const Unit& u, int wr, int wc, int fr, int fq, PG8_LAS float* xch, int wid) const { PG8_OPAQUE(fr);
        if (u.id == 0) {
            if (u.pn < 2) {
                qk_rope(acc, u, wr, wc, fr, fq, xch, wid, 0, gq, QSCALE, Q, 512, u.pn * 256);
                qk_rope(acc, u, wr, wc, fr, fq, xch, wid, 1, gq, QSCALE, Q, 512, u.pn * 256 + 128);
            } else if (u.pn == 2) {
                qk_rope(acc, u, wr, wc, fr, fq, xch, wid, 0, gk, 1.0f, Kb, 128, 0);
#pragma unroll
                for (int ai = 0; ai < 2; ++ai)
#pragma unroll
                    for (int m = 0; m < 4; ++m) { bf16_t* rowp = Vb + (size_t)(u.pm * BM + ai * HALF + wr * 64 + m * 16 + fr) * 128 + wc * 32 + 4 * fq;
#pragma unroll
                        for (int n = 0; n < 2; ++n) { const f32x4 v = acc[ai][1][m][n]; u32x2 w; w.x = pk_bf16(v[0], v[1]); w.y = pk_bf16(v[2], v[3]); *(u32x2*)(rowp + n * 16) = w; } }
            } else if (u.pn < 5) {
                store_tile_bf16_np(acc, U + (size_t)u.pm * BM * 512 + (u.pn - 3) * 256, 512, wr, wc, fr, fq);
            } else {
                const int gc0 = (u.pn - 5) * 256 + wc * 32 + 4 * fq;
                f32x4 bv[2][2];
#pragma unroll
                for (int bj = 0; bj < 2; ++bj)
#pragma unroll
                    for (int n = 0; n < 2; ++n) bv[bj][n] = *(const f32x4*)(bgate + gc0 + bj * HALF + n * 16);
#pragma unroll
                for (int ai = 0; ai < 2; ++ai)
#pragma unroll
                    for (int m = 0; m < 4; ++m) { bf16_t* rowp = Gt + (size_t)(u.pm * BM + ai * HALF + wr * 64 + m * 16 + fr) * 2048 + gc0;
#pragma unroll
                        for (int bj = 0; bj < 2; ++bj)
#pragma unroll
                            for (int n = 0; n < 2; ++n) { f32x4 z = acc[ai][bj][m][n] + bv[bj][n]; f32x4 s;
#pragma unroll
                                for (int j = 0; j < 4; ++j) { const float zz = fminf(fmaxf(z[j], -30.f), 30.f); s[j] = __builtin_amdgcn_rcpf(1.0f + __builtin_amdgcn_exp2f(-zz * LOG2E)); }
                                u32x2 w; w.x = pk_bf16(s[0], s[1]); w.y = pk_bf16(s[2], s[3]); *(u32x2*)(rowp + bj * HALF + n * 16) = w; }
                        PG8_FENCE(); }
            }
        } else if (u.id == 1) {
            store_tile_bf16_np(acc, XK + (size_t)u.pm * BM * 1024 + u.pn * 256, 1024, wr, wc, fr, fq);
        } else {
            store_tile_bf16_np(acc, XVT + (size_t)u.pm * BM * 4096 + u.pn * 256, 4096, wr, wc, fr, fq);
        }
    }
};

struct EpiMix {
    static constexpr bool PERM = true, AFTER_DRAIN = false, HAS_MID = true;
    const bf16_t* Gt; bf16_t* MIX;
    __device__ __forceinline__ void mid(Acc& acc, const Unit& u, int wr, int wc, int fr, int fq) const { PG8_OPAQUE(fr);
#pragma unroll
        for (int ai = 0; ai < 2; ++ai) {
            u32x4 ga[4][2], gp[4][2];
#pragma unroll
            for (int m = 0; m < 4; ++m) { const bf16_t* grow = Gt + (size_t)(u.pm * BM + ai * HALF + wr * 64 + m * 16 + fr) * 2048 + u.pn * 256 + wc * 32 + 8 * fq;
#pragma unroll
                for (int bj = 0; bj < 2; ++bj) { ga[m][bj] = *(const u32x4*)(grow + bj * HALF); gp[m][bj] = *(const u32x4*)(grow + 1024 + bj * HALF); } }
#pragma unroll
            for (int m = 0; m < 4; ++m)
#pragma unroll
                for (int bj = 0; bj < 2; ++bj) { const u32x4 a = ga[m][bj], p = gp[m][bj];
                    f32x4 r0, r1;
                    r0[0] = bf_lo(a.x) * __builtin_amdgcn_rcpf(bf_lo(p.x)); r0[1] = bf_hi(a.x) * __builtin_amdgcn_rcpf(bf_hi(p.x));
                    r0[2] = bf_lo(a.y) * __builtin_amdgcn_rcpf(bf_lo(p.y)); r0[3] = bf_hi(a.y) * __builtin_amdgcn_rcpf(bf_hi(p.y));
                    r1[0] = bf_lo(a.z) * __builtin_amdgcn_rcpf(bf_lo(p.z)); r1[1] = bf_hi(a.z) * __builtin_amdgcn_rcpf(bf_hi(p.z));
                    r1[2] = bf_lo(a.w) * __builtin_amdgcn_rcpf(bf_lo(p.w)); r1[3] = bf_hi(a.w) * __builtin_amdgcn_rcpf(bf_hi(p.w));
                    acc[ai][bj][m][0] *= r0; acc[ai][bj][m][1] *= r1; }
            PG8_FENCE(); }
    }
    __device__ __forceinline__ void operator()(Acc& acc, const Unit& u, int wr, int wc, int fr, int fq, PG8_LAS float*, int) const { PG8_OPAQUE(fr);
        u32x4 gp[2][4][2];
#pragma unroll
        for (int ai = 0; ai < 2; ++ai)
#pragma unroll
            for (int m = 0; m < 4; ++m) { const bf16_t* grow = Gt + (size_t)(u.pm * BM + ai * HALF + wr * 64 + m * 16 + fr) * 2048 + 1024 + u.pn * 256 + wc * 32 + 8 * fq;
#pragma unroll
                for (int bj = 0; bj < 2; ++bj) gp[ai][m][bj] = *(const u32x4*)(grow + bj * HALF); }
#pragma unroll
        for (int ai = 0; ai < 2; ++ai)
#pragma unroll
            for (int m = 0; m < 4; ++m) { bf16_t* mrow = MIX + (size_t)(u.pm * BM + ai * HALF + wr * 64 + m * 16 + fr) * 1024 + u.pn * 256 + wc * 32 + 8 * fq;
#pragma unroll
                for (int bj = 0; bj < 2; ++bj) { const u32x4 g = gp[ai][m][bj];
                    const f32x4 a = acc[ai][bj][m][0], b = acc[ai][bj][m][1]; u32x4 w;
                    w.x = pk_bf16(a[0] * bf_lo(g.x), a[1] * bf_hi(g.x)); w.y = pk_bf16(a[2] * bf_lo(g.y), a[3] * bf_hi(g.y));
                    w.z = pk_bf16(b[0] * bf_lo(g.z), b[1] * bf_hi(g.z)); w.w = pk_bf16(b[2] * bf_lo(g.w), b[3] * bf_hi(g.w));
                    *(u32x4*)(mrow + bj * HALF) = w; } }
    }
};

template <int MODE> struct EpiRes {
    static constexpr bool PERM = true, AFTER_DRAIN = false, HAS_MID = false;
    const float* basef; bf16_t* HB; float* SS;
    __device__ __forceinline__ void mid(Acc&, const Unit&, int, int, int, int) const {}
    __device__ __forceinline__ void operator()(Acc& acc, const Unit& u, int wr, int wc, int fr, int fq, PG8_LAS float*, int) const { PG8_OPAQUE(fr);
        const int col0 = u.pn * BM + wc * 32 + 8 * fq;
#pragma unroll
        for (int ai = 0; ai < 2; ++ai) {
            f32x4 bf[MODE == 0 ? 4 : 1][2][2]; u32x4 bh[MODE == 1 ? 4 : 1][2];
#pragma unroll
            for (int m = 0; m < 4; ++m) { const size_t off = (size_t)(u.pm * BM + ai * HALF + wr * 64 + m * 16 + fr) * 1024 + col0;
#pragma unroll
                for (int bj = 0; bj < 2; ++bj) {
                    if (MODE == 0) { bf[m][bj][0] = *(const f32x4*)(basef + off + bj * HALF); bf[m][bj][1] = *(const f32x4*)(basef + off + bj * HALF + 4); }
                    else bh[m][bj] = *(const u32x4*)(HB + off + bj * HALF); } }
#pragma unroll
            for (int m = 0; m < 4; ++m) { const size_t row = (size_t)(u.pm * BM + ai * HALF + wr * 64 + m * 16 + fr); const size_t off = row * 1024 + col0; float ss = 0.f;
#pragma unroll
                for (int bj = 0; bj < 2; ++bj) { f32x4 b0, b1;
                    if (MODE == 0) { b0 = bf[m][bj][0]; b1 = bf[m][bj][1]; }
                    else { const u32x4 w = bh[m][bj]; b0 = (f32x4){bf_lo(w.x), bf_hi(w.x), bf_lo(w.y), bf_hi(w.y)}; b1 = (f32x4){bf_lo(w.z), bf_hi(w.z), bf_lo(w.w), bf_hi(w.w)}; }
                    const f32x4 h0 = b0 + acc[ai][bj][m][0], h1 = b1 + acc[ai][bj][m][1];
                    ss += (h0[0] * h0[0] + h0[1] * h0[1]) + (h0[2] * h0[2] + h0[3] * h0[3]) + (h1[0] * h1[0] + h1[1] * h1[1]) + (h1[2] * h1[2] + h1[3] * h1[3]);
                    u32x4 o; o.x = pk_bf16(h0[0], h0[1]); o.y = pk_bf16(h0[2], h0[3]); o.z = pk_bf16(h1[0], h1[1]); o.w = pk_bf16(h1[2], h1[3]);
                    *(u32x4*)(HB + off + bj * HALF) = o; }
                ss += __shfl_xor(ss, 16); ss += __shfl_xor(ss, 32);
                if (fq == 0) SS[row * 16 + u.pn * 4 + wc] = ss; }
            PG8_FENCE(); }
    }
};

template <int ACT> struct EpiRowScale {
    static constexpr bool PERM = true, AFTER_DRAIN = false, HAS_MID = false;
    const float* SS; bf16_t* O; int ldc; float scale;
    __device__ __forceinline__ void mid(Acc&, const Unit&, int, int, int, int) const {}
    __device__ __forceinline__ void operator()(Acc& acc, const Unit& u, int wr, int wc, int fr, int fq, PG8_LAS float*, int) const { PG8_OPAQUE(fr);
        f32x4 p4[2][4]; float rsv[2][4];
#pragma unroll
        for (int ai = 0; ai < 2; ++ai)
#pragma unroll
            for (int m = 0; m < 4; ++m) p4[ai][m] = *(const f32x4*)(SS + (size_t)(u.pm * BM + ai * HALF + wr * 64 + m * 16 + fr) * 16 + 4 * fq);
#pragma unroll
        for (int ai = 0; ai < 2; ++ai)
#pragma unroll
            for (int m = 0; m < 4; ++m) { const f32x4 q = p4[ai][m]; float s = (q[0] + q[1]) + (q[2] + q[3]); s += __shfl_xor(s, 16); s += __shfl_xor(s, 32);
                rsv[ai][m] = __builtin_amdgcn_rsqf(s * (1.0f / 1024.0f) + EPS) * scale; }
#pragma unroll
        for (int ai = 0; ai < 2; ++ai)
#pragma unroll
            for (int m = 0; m < 4; ++m) { const float rs = rsv[ai][m];
                bf16_t* rowp = O + (size_t)(u.pm * BM + ai * HALF + wr * 64 + m * 16 + fr) * ldc + u.pn * 256 + wc * 32 + 8 * fq;
#pragma unroll
                for (int bj = 0; bj < 2; ++bj) { f32x4 a = acc[ai][bj][m][0] * rs, b = acc[ai][bj][m][1] * rs;
                    if (ACT == 1) {
#pragma unroll
                        for (int j = 0; j < 4; ++j) { const float x = fmaxf(a[j], 0.f), y = fmaxf(b[j], 0.f); a[j] = x * x; b[j] = y * y; } }
                    u32x4 w; w.x = pk_bf16(a[0], a[1]); w.y = pk_bf16(a[2], a[3]); w.z = pk_bf16(b[0], b[1]); w.w = pk_bf16(b[2], b[3]);
                    *(u32x4*)(rowp + bj * HALF) = w; } }
    }
};

struct EpiPlain {
    static constexpr bool PERM = true, AFTER_DRAIN = false, HAS_MID = false;
    bf16_t* O; int ldc;
    __device__ __forceinline__ void mid(Acc&, const Unit&, int, int, int, int) const {}
    __device__ __forceinline__ void operator()(Acc& acc, const Unit& u, int wr, int wc, int fr, int fq, PG8_LAS float*, int) const { PG8_OPAQUE(fr);
#pragma unroll
        for (int ai = 0; ai < 2; ++ai)
#pragma unroll
            for (int m = 0; m < 4; ++m) { bf16_t* rowp = O + (size_t)(u.pm * BM + ai * HALF + wr * 64 + m * 16 + fr) * ldc + u.pn * 256 + wc * 32 + 8 * fq;
#pragma unroll
                for (int bj = 0; bj < 2; ++bj) { const f32x4 a = acc[ai][bj][m][0], b = acc[ai][bj][m][1];
                    u32x4 w; w.x = pk_bf16(a[0], a[1]); w.y = pk_bf16(a[2], a[3]); w.z = pk_bf16(b[0], b[1]); w.w = pk_bf16(b[2], b[3]);
                    *(u32x4*)(rowp + bj * HALF) = w; } }
    }
};

struct EpiSoftmax {
    static constexpr bool PERM = true, AFTER_DRAIN = false, HAS_MID = false;
    bf16_t* P;
    __device__ __forceinline__ void mid(Acc&, const Unit&, int, int, int, int) const {}
    __device__ __forceinline__ void operator()(Acc& acc, const Unit& u, int wr, int wc, int fr, int fq, PG8_LAS float* xch, int) const { PG8_OPAQUE(fr);
        PG8_LAS float* xmax = xch; PG8_LAS float* xsum = xch + 1024;
#pragma unroll
        for (int ai = 0; ai < 2; ++ai)
#pragma unroll
            for (int m = 0; m < 4; ++m) { float mx = -INFINITY;
#pragma unroll
                for (int bj = 0; bj < 2; ++bj)
#pragma unroll
                    for (int n = 0; n < 2; ++n) { const f32x4 v = acc[ai][bj][m][n]; mx = fmaxf(mx, fmaxf(fmaxf(v[0], v[1]), fmaxf(v[2], v[3]))); }
                mx = fmaxf(mx, __shfl_xor(mx, 16)); mx = fmaxf(mx, __shfl_xor(mx, 32));
                if (fq == 0) xmax[(ai * HALF + wr * 64 + m * 16 + fr) * 4 + wc] = mx; }
        asm volatile("s_waitcnt lgkmcnt(0)" ::: "memory"); __builtin_amdgcn_s_barrier(); PG8_FENCE();
#pragma unroll
        for (int ai = 0; ai < 2; ++ai)
#pragma unroll
            for (int m = 0; m < 4; ++m) { const int rl = ai * HALF + wr * 64 + m * 16 + fr; const f32x4 m4 = *(const PG8_LAS f32x4*)(xmax + rl * 4);
                const float mx = fmaxf(fmaxf(m4[0], m4[1]), fmaxf(m4[2], m4[3])); float s = 0.f;
#pragma unroll
                for (int bj = 0; bj < 2; ++bj)
#pragma unroll
                    for (int n = 0; n < 2; ++n) { f32x4 v = acc[ai][bj][m][n];
#pragma unroll
                        for (int j = 0; j < 4; ++j) { v[j] = __builtin_amdgcn_exp2f(v[j] - mx); s += v[j]; }
                        acc[ai][bj][m][n] = v; }
                s += __shfl_xor(s, 16); s += __shfl_xor(s, 32);
                if (fq == 0) xsum[rl * 4 + wc] = s; }
        asm volatile("s_waitcnt lgkmcnt(0)" ::: "memory"); __builtin_amdgcn_s_barrier(); PG8_FENCE();
#pragma unroll
        for (int ai = 0; ai < 2; ++ai)
#pragma unroll
            for (int m = 0; m < 4; ++m) { const int rl = ai * HALF + wr * 64 + m * 16 + fr; const f32x4 s4 = *(const PG8_LAS f32x4*)(xsum + rl * 4);
                const float inv = __builtin_amdgcn_rcpf((s4[0] + s4[1]) + (s4[2] + s4[3]));
                bf16_t* rowp = P + (size_t)(u.pm * BM + rl) * 1024 + u.pn * 256 + wc * 32 + 8 * fq;
#pragma unroll
                for (int bj = 0; bj < 2; ++bj) { const f32x4 a = acc[ai][bj][m][0] * inv, b = acc[ai][bj][m][1] * inv;
                    u32x4 w; w.x = pk_bf16(a[0], a[1]); w.y = pk_bf16(a[2], a[3]); w.z = pk_bf16(b[0], b[1]); w.w = pk_bf16(b[2], b[3]);
                    *(u32x4*)(rowp + bj * HALF) = w; } }
        asm volatile("s_waitcnt lgkmcnt(0)" ::: "memory"); __builtin_amdgcn_s_barrier(); PG8_FENCE();
    }
};

template <class Epi, class Sched, bool ALIGN_EPI, bool SP2>
__device__ __forceinline__ void gemm_phase(PG8_LAS unsigned char* lds, PG8_LAS float* xch, const Sched& S, const Epi& E) {
    const int tid = threadIdx.x, wid = __builtin_amdgcn_readfirstlane(tid >> 6), lane = tid & 63, wr = wid >> 2, wc = wid & 3, fr = lane & 15, fq = lane >> 4;
    const int K = S.K, nt = K / BK, lda = S.lda, ldb = S.ldb; (void)K;
    unsigned voffA[2], voffB[2];
#pragma unroll
    for (int i = 0; i < 2; ++i) { int R, C; stage_rc(tid * 16 + i * 8192, R, C); const int Rb = Epi::PERM ? ((R & ~31) + perm32(R & 31)) : R;
        voffA[i] = (unsigned)(R * lda + C) * 2u; voffB[i] = (unsigned)(Rb * ldb + C) * 2u; }
    const size_t kstep = (size_t)(BK * 2);
    const size_t hstepA = (size_t)HALF * lda * 2, hstepB = (size_t)HALF * ldb * 2;
    const unsigned ldsw = (unsigned)wid * 1024u;
    const int aoff = lds_byte(wr * 64 + fr, fq * 8), boff = lds_byte(wc * 32 + fr, fq * 8);
#define PG8_SA(b, h) (((b) * 2 + (h)) * HTB)
#define PG8_SB(b, h) ((4 + (b) * 2 + (h)) * HTB)
#define PG8_STAGE(bufoff, gbase, voff) do { _Pragma("unroll") for (int _i = 0; _i < 2; ++_i) \
        __builtin_amdgcn_global_load_lds((const unsigned*)((const char*)(gbase) + (voff)[_i]), (PG8_LAS unsigned*)(lds + (bufoff) + ldsw + _i * 8192), 16, 0, 0); } while (0)
#define PG8_LDA(dst, b, h) do { _Pragma("unroll") for (int m = 0; m < 4; ++m) _Pragma("unroll") for (int k = 0; k < 2; ++k) dst[m][k] = *(const PG8_LAS bf16x8*)(lds + PG8_SA(b, h) + aoff + m * 2048 + k * 1024); } while (0)
#define PG8_LDB(dst, b, h) do { _Pragma("unroll") for (int n = 0; n < 2; ++n) _Pragma("unroll") for (int k = 0; k < 2; ++k) dst[n][k] = *(const PG8_LAS bf16x8*)(lds + PG8_SB(b, h) + boff + n * 2048 + k * 1024); } while (0)
#define PG8_MMA(ai, bj, At, Bt) do { __builtin_amdgcn_s_setprio(1); _Pragma("unroll") for (int m = 0; m < 4; ++m) _Pragma("unroll") for (int n = 0; n < 2; ++n) _Pragma("unroll") for (int k = 0; k < 2; ++k) \
        acc[ai][bj][m][n] = __builtin_amdgcn_mfma_f32_16x16x32_bf16(Bt[n][k], At[m][k], acc[ai][bj][m][n], 0, 0, 0); __builtin_amdgcn_s_setprio(0); } while (0)
#define PG8_WAIT_V(n) asm volatile("s_waitcnt vmcnt(" #n ")" ::: "memory")
#define PG8_WAIT_L(n) asm volatile("s_waitcnt lgkmcnt(" #n ")" ::: "memory")
#define PG8_BAR __builtin_amdgcn_s_barrier()
#define PG8_SCHED __builtin_amdgcn_sched_barrier(0)
    Unit cur, nxt; int ui = 0;
    if (!S.next(0, cur)) return;
    f32x4 acc[2][2][4][2];
#pragma unroll
    for (int a = 0; a < 2; ++a)
#pragma unroll
        for (int b = 0; b < 2; ++b)
#pragma unroll
            for (int m = 0; m < 4; ++m)
#pragma unroll
                for (int n = 0; n < 2; ++n) acc[a][b][m][n] = (f32x4){0.f, 0.f, 0.f, 0.f};
    bf16x8 At[4][2], B0[2][2], B1[2][2];
    const char* cA = S.aptr(cur); const char* cB = S.bptr(cur);
    if constexpr (SP2) {
        PG8_STAGE(PG8_SB(0, 0), cB, voffB); PG8_STAGE(PG8_SB(0, 1), cB + hstepB, voffB); PG8_STAGE(PG8_SA(0, 0), cA, voffA); PG8_STAGE(PG8_SA(0, 1), cA + hstepA, voffA);
        if (wr == 1) PG8_BAR;
        PG8_WAIT_V(2); PG8_BAR;
        PG8_STAGE(PG8_SB(1, 0), cB + kstep, voffB); PG8_STAGE(PG8_SA(1, 0), cA + kstep, voffA); PG8_STAGE(PG8_SB(1, 1), cB + hstepB + kstep, voffB);
        PG8_WAIT_V(6); PG8_BAR;
    } else {
        PG8_STAGE(PG8_SB(0, 0), cB, voffB); PG8_STAGE(PG8_SA(0, 0), cA, voffA); PG8_STAGE(PG8_SB(0, 1), cB + hstepB, voffB); PG8_STAGE(PG8_SA(0, 1), cA + hstepA, voffA);
        if (wr == 1) PG8_BAR;
        PG8_WAIT_V(4); PG8_BAR;
        PG8_STAGE(PG8_SB(1, 0), cB + kstep, voffB); PG8_STAGE(PG8_SA(1, 0), cA + kstep, voffA); PG8_STAGE(PG8_SB(1, 1), cB + hstepB + kstep, voffB);
        PG8_WAIT_V(6); PG8_BAR;
    }
    for (;;) {
        const bool has_next = S.next(ui + 1, nxt);
        const char* nA = has_next ? S.aptr(nxt) : cA; const char* nB = has_next ? S.bptr(nxt) : cB;
        for (int t = 0; t < nt; t += 2) {
            const bool last = (t == nt - 2);
            const char* a1 = cA + (size_t)(t + 1) * kstep;
            const char* a2 = last ? nA : cA + (size_t)(t + 2) * kstep; const char* b2 = last ? nB : cB + (size_t)(t + 2) * kstep;
            const char* a3 = a2 + kstep; const char* b3 = b2 + kstep;
            if constexpr (Epi::HAS_MID) { if (t == S.mid) E.mid(acc, cur, wr, wc, fr, fq); }
            if constexpr (SP2) {
            PG8_LDB(B0, 0, 0); PG8_LDB(B1, 0, 1); PG8_SCHED; PG8_LDA(At, 0, 0); PG8_STAGE(PG8_SA(1, 1), a1 + hstepA, voffA);
            PG8_WAIT_V(8); PG8_WAIT_L(0); PG8_BAR; PG8_MMA(0, 0, At, B0); PG8_MMA(0, 1, At, B1); PG8_BAR; PG8_SCHED;
            PG8_LDA(At, 0, 1); PG8_STAGE(PG8_SB(0, 0), b2, voffB); PG8_STAGE(PG8_SB(0, 1), b2 + hstepB, voffB); PG8_STAGE(PG8_SA(0, 0), a2, voffA);
            PG8_WAIT_V(8); PG8_WAIT_L(0); PG8_BAR; PG8_MMA(1, 0, At, B0); PG8_MMA(1, 1, At, B1); PG8_BAR; PG8_SCHED;
            PG8_LDB(B0, 1, 0); PG8_LDB(B1, 1, 1); PG8_SCHED; PG8_LDA(At, 1, 0); PG8_STAGE(PG8_SA(0, 1), a2 + hstepA, voffA);
            PG8_WAIT_V(8); PG8_WAIT_L(0); PG8_BAR; PG8_MMA(0, 0, At, B0); PG8_MMA(0, 1, At, B1); PG8_BAR; PG8_SCHED;
            PG8_LDA(At, 1, 1); PG8_STAGE(PG8_SB(1, 0), b3, voffB); PG8_STAGE(PG8_SB(1, 1), b3 + hstepB, voffB); PG8_STAGE(PG8_SA(1, 0), a3, voffA);
            PG8_WAIT_V(8); PG8_WAIT_L(0); PG8_BAR; PG8_MMA(1, 0, At, B0); PG8_MMA(1, 1, At, B1); PG8_BAR; PG8_SCHED;
            } else {
            PG8_LDB(B0, 0, 0); PG8_SCHED; PG8_LDA(At, 0, 0); PG8_STAGE(PG8_SA(1, 1), a1 + hstepA, voffA);
            PG8_WAIT_L(8); PG8_BAR; PG8_WAIT_L(0); PG8_MMA(0, 0, At, B0); PG8_BAR; PG8_SCHED;
            PG8_LDB(B1, 0, 1); PG8_STAGE(PG8_SB(0, 0), b2, voffB);
            PG8_BAR; PG8_WAIT_L(0); PG8_MMA(0, 1, At, B1); PG8_BAR;
            PG8_LDA(At, 0, 1); PG8_STAGE(PG8_SA(0, 0), a2, voffA);
            PG8_BAR; PG8_WAIT_L(0); PG8_MMA(1, 0, At, B0); PG8_BAR; PG8_SCHED;
            PG8_STAGE(PG8_SB(0, 1), b2 + hstepB, voffB);
            PG8_WAIT_V(6); PG8_BAR; PG8_MMA(1, 1, At, B1); PG8_BAR;
            PG8_LDB(B0, 1, 0); PG8_SCHED; PG8_LDA(At, 1, 0); PG8_STAGE(PG8_SA(0, 1), a2 + hstepA, voffA);
            PG8_WAIT_L(8); PG8_BAR; PG8_WAIT_L(0); PG8_MMA(0, 0, At, B0); PG8_BAR; PG8_SCHED;
            PG8_LDB(B1, 1, 1); PG8_STAGE(PG8_SB(1, 0), b3, voffB);
            PG8_BAR; PG8_WAIT_L(0); PG8_MMA(0, 1, At, B1); PG8_BAR;
            PG8_LDA(At, 1, 1); PG8_STAGE(PG8_SA(1, 0), a3, voffA);
            PG8_BAR; PG8_WAIT_L(0); PG8_MMA(1, 0, At, B0); PG8_BAR; PG8_SCHED;
            PG8_STAGE(PG8_SB(1, 1), b3 + hstepB, voffB);
            PG8_WAIT_V(6); PG8_BAR; PG8_MMA(1, 1, At, B1); PG8_BAR;
            }
        }
        if constexpr (ALIGN_EPI) { if (wr == 0) PG8_BAR; }
        E(acc, cur, wr, wc, fr, fq, xch, wid);
        if (!has_next) break;
#pragma unroll
        for (int a = 0; a < 2; ++a)
#pragma unroll
            for (int b = 0; b < 2; ++b)
#pragma unroll
                for (int m = 0; m < 4; ++m)
#pragma unroll
                    for (int n = 0; n < 2; ++n) acc[a][b][m][n] = (f32x4){0.f, 0.f, 0.f, 0.f};
        cur = nxt; cA = nA; cB = nB; ++ui;
        if constexpr (ALIGN_EPI) { if (wr == 1) PG8_BAR; }
    }
    PG8_WAIT_V(0);
    if constexpr (!ALIGN_EPI) { if (wr == 0) PG8_BAR; }
    PG8_BAR;
#undef PG8_SA
#undef PG8_SB
#undef PG8_STAGE
#undef PG8_LDA
#undef PG8_LDB
#undef PG8_MMA
#undef PG8_WAIT_V
#undef PG8_WAIT_L
#undef PG8_BAR
#undef PG8_SCHED
}
}

#include <hip/hip_bf16.h>
#include <cmath>
namespace attn_body {
using bf16=__hip_bfloat16;
using bf16x8=__attribute__((ext_vector_type(8)))short;
using s16x4=__attribute__((ext_vector_type(4)))short;
using f32x16=__attribute__((ext_vector_type(16)))float;
using u32x4=__attribute__((ext_vector_type(4)))unsigned;
constexpr int BATCH=16,NHEAD=8,SEQ=2048,D=64,QP=512,KP=128,OP=1024;
constexpr int NW=8,QBLK=32,QB=QBLK*NW,KVBLK=64,NQB=SEQ/QB;
__device__ __forceinline__ int crow(int r,int hi){return (r&3)+8*(r>>2)+4*hi;}
#define SBAR() __builtin_amdgcn_sched_barrier(0)
__device__ __forceinline__ void cmask(f32x16&p0,f32x16&p1,int jb,int qrel,int hi){
  const float NEG=-INFINITY; int kb=64*jb+4*hi;
  #pragma unroll
  for(int r=0;r<16;++r){int kv=kb+(r&3)+8*(r>>2); if(kv>qrel)p0[r]=NEG; if(kv+32>qrel)p1[r]=NEG;}
}

constexpr int NSLOT=3, SLOTB=8192;
constexpr int LDS_K=0, LDS_V=NSLOT*SLOTB, LDS_WS=2*NSLOT*SLOTB, LDS_OST=LDS_WS+NW*64*4, LDS_BYTES=LDS_OST+NW*4096;
constexpr float C2=0.125f*1.4426950408889634f;
__device__ __forceinline__ void glds16(const void*gsrc,unsigned lds_dst){unsigned keep;
  asm volatile("s_mov_b32 %0, m0\n\ts_mov_b32 m0, %2\n\ts_nop 0\n\tglobal_load_lds_dwordx4 %1, off\n\ts_mov_b32 m0, %0":"=&s"(keep):"v"(gsrc),"s"(lds_dst):"memory");}
__device__ __forceinline__ float max3f(float a,float b,float c){float r;asm("v_max3_f32 %0, %1, %2, %3":"=v"(r):"v"(a),"v"(b),"v"(c));return r;}
__device__ __forceinline__ float max2f(float a,float b){float r;asm("v_max_f32_e32 %0, %1, %2":"=v"(r):"v"(a),"v"(b));return r;}
__device__ __forceinline__ float fadd_s(float a,float b){float r;asm("v_add_f32_e32 %0, %1, %2":"=v"(r):"v"(a),"v"(b));return r;}
__device__ __forceinline__ float fsub_s(float a,float b){float r;asm("v_sub_f32_e32 %0, %1, %2":"=v"(r):"v"(a),"v"(b));return r;}
typedef float f32x2_t __attribute__((ext_vector_type(2))); typedef __bf16 bf16x2_t __attribute__((ext_vector_type(2)));
__device__ __forceinline__ unsigned cvtpk_s(float lo,float hi){f32x2_t v={lo,hi};bf16x2_t b=__builtin_convertvector(v,bf16x2_t);return __builtin_bit_cast(unsigned,b);}
#define WAIT_BAR(N) asm volatile("s_waitcnt vmcnt(" #N ") lgkmcnt(0)\n\ts_barrier":::"memory")

__device__ __forceinline__ void qkt(f32x16&p0,f32x16&p1,const char*Kslot,const bf16x8*qr,const f32x16&negm,int r32,int hi){
  const char*kb=Kslot+hi*1024+r32*16;
  #pragma unroll
  for(int d0=0;d0<4;++d0){
    const bf16x8 b0=*reinterpret_cast<const bf16x8*>(kb+d0*2048);
    const bf16x8 b1=*reinterpret_cast<const bf16x8*>(kb+d0*2048+512);
    if(d0==0){p0=__builtin_amdgcn_mfma_f32_32x32x16_bf16(b0,qr[0],negm,0,0,0);p1=__builtin_amdgcn_mfma_f32_32x32x16_bf16(b1,qr[0],negm,0,0,0);}
    else{p0=__builtin_amdgcn_mfma_f32_32x32x16_bf16(b0,qr[d0],p0,0,0,0);p1=__builtin_amdgcn_mfma_f32_32x32x16_bf16(b1,qr[d0],p1,0,0,0);}}
}
typedef __attribute__((address_space(3))) const char* lds_cptr;
typedef short v4i16_t __attribute__((ext_vector_type(4)));
__device__ __forceinline__ void kload8(bf16x8*kf,lds_cptr kp){
  kf[0]=*(const __attribute__((address_space(3))) bf16x8*)(kp);      kf[1]=*(const __attribute__((address_space(3))) bf16x8*)(kp+512);
  kf[2]=*(const __attribute__((address_space(3))) bf16x8*)(kp+2048); kf[3]=*(const __attribute__((address_space(3))) bf16x8*)(kp+2560);
  kf[4]=*(const __attribute__((address_space(3))) bf16x8*)(kp+4096); kf[5]=*(const __attribute__((address_space(3))) bf16x8*)(kp+4608);
  kf[6]=*(const __attribute__((address_space(3))) bf16x8*)(kp+6144); kf[7]=*(const __attribute__((address_space(3))) bf16x8*)(kp+6656);
}
__device__ __forceinline__ void kload2(bf16x8*kf,lds_cptr kp,int j){ kf[2*j]=*(const __attribute__((address_space(3))) bf16x8*)(kp+j*2048); kf[2*j+1]=*(const __attribute__((address_space(3))) bf16x8*)(kp+j*2048+512); }
__device__ __forceinline__ s16x4 vtr(lds_cptr p){ return __builtin_bit_cast(s16x4,__builtin_amdgcn_ds_read_tr16_b64_v4i16((__attribute__((address_space(3))) v4i16_t*)p)); }
__device__ __forceinline__ float rowmax(const f32x16&p0,const f32x16&p1){
  float a=max3f(p0[0],p0[1],p1[0]),b=max3f(p0[2],p0[3],p1[1]);a=max3f(a,p1[2],p1[3]);
  #pragma unroll
  for(int r=4;r<16;r+=4){a=max3f(a,p0[r],p0[r+1]);b=max3f(b,p0[r+2],p0[r+3]);a=max3f(a,p1[r],p1[r+1]);b=max3f(b,p1[r+2],p1[r+3]);}
  const float m=max2f(a,b);
  auto rr=__builtin_amdgcn_permlane32_swap(__float_as_uint(m),__float_as_uint(m),false,false);
  return max2f(__uint_as_float(rr[0]),__uint_as_float(rr[1]));
}
__device__ __forceinline__ void pv(f32x16*o,int vb,bf16x8 pa0,bf16x8 pa1,bf16x8 pa2,bf16x8 pa3){
  #pragma unroll
  for(int d0=0;d0<2;++d0){s16x4 lo[4],hi[4];
    #pragma unroll
    for(int ks=0;ks<4;++ks){
      asm volatile("ds_read_b64_tr_b16 %0,%1 offset:%c2":"=&v"(lo[ks]):"v"(vb),"i"(d0*4096+ks*1024):"memory");
      asm volatile("ds_read_b64_tr_b16 %0,%1 offset:%c2":"=&v"(hi[ks]):"v"(vb),"i"(d0*4096+ks*1024+512):"memory");}
    asm volatile("s_waitcnt lgkmcnt(0)":::"memory");SBAR();
    #define PK(k) (bf16x8){lo[k][0],lo[k][1],lo[k][2],lo[k][3],hi[k][0],hi[k][1],hi[k][2],hi[k][3]}
    o[d0]=__builtin_amdgcn_mfma_f32_32x32x16_bf16(pa0,PK(0),o[d0],0,0,0);
    o[d0]=__builtin_amdgcn_mfma_f32_32x32x16_bf16(pa1,PK(1),o[d0],0,0,0);
    o[d0]=__builtin_amdgcn_mfma_f32_32x32x16_bf16(pa2,PK(2),o[d0],0,0,0);
    o[d0]=__builtin_amdgcn_mfma_f32_32x32x16_bf16(pa3,PK(3),o[d0],0,0,0);
    #undef PK
  }
}

#ifndef ATTN_STORE16
#define ATTN_STORE16(p,v) (*(u32x4*)(p)=(v))
#endif
template<int THRL> __device__ __forceinline__ void attn_unit(int b,int h,int qb,const bf16*Q,const bf16*__restrict__ K,const bf16*__restrict__ V,bf16*O,char*shm){
  const int tid=threadIdx.x,lane=tid&63,r32=lane&31,hi=lane>>5; const int wid=__builtin_amdgcn_readfirstlane(tid>>6);
  const long rowbase=(long)b*SEQ; const int q0=qb*QB;
  const bf16*Qw=Q+(rowbase+q0+wid*QBLK)*QP+h*D;
  const bf16*Kh=K+rowbase*KP+(h>>2)*D,*Vh=V+rowbase*KP+(h>>2)*D;
  const unsigned lds0=(unsigned)(uintptr_t)shm;
  float*wsf=(float*)(shm+LDS_WS)+wid*64;
  const bf16*ksrc=Kh+(long)lane*KP+wid*8;
  const bf16*vsrc=Vh+(long)(16*(wid&3)+(lane>>2))*KP+(wid>>2)*32+(lane&3)*8;
  const unsigned kdst=lds0+LDS_K+wid*1024, vdst=lds0+LDS_V+wid*1024;
  #define DMA_K(t,slot) glds16(ksrc+(long)(t)*KVBLK*KP,(unsigned)__builtin_amdgcn_readfirstlane(kdst+(slot)))
  #define DMA_V(t,slot) glds16(vsrc+(long)(t)*KVBLK*KP,(unsigned)__builtin_amdgcn_readfirstlane(vdst+(slot)))
  const int vb0=(int)(lds0+LDS_V)+((lane>>4)&1)*32+(lane&3)*8+(4*hi+((lane&15)>>2))*64;
  const char*Kbase=shm+LDS_K; bf16x8 kf[8];
  const lds_cptr shm3=(lds_cptr)shm; const lds_cptr kp0=shm3+LDS_K+hi*1024+r32*16; const lds_cptr vp0=shm3+LDS_V+((lane>>4)&1)*32+(lane&3)*8+(4*hi+((lane&15)>>2))*64;
  constexpr int NT=SEQ/KVBLK;
  DMA_K(0,0);DMA_V(0,0);DMA_K(1,SLOTB);
  bf16x8 qr[4];
  #pragma unroll
  for(int d0=0;d0<4;++d0)qr[d0]=*reinterpret_cast<const bf16x8*>(&Qw[(long)r32*QP+d0*16+hi*8]);
  float mhat=0.f,l_reg=0.f;f32x16 o[2];o[0]=f32x16{};o[1]=f32x16{};f32x16 negm=f32x16{};asm volatile("":"+v"(negm));
  #define CMASK(P0,P1,t) do{}while(0)
  bool resc=false;
  #define START(P0,P1) do{ const float rm=rowmax(P0,P1); resc=false; \
    { const float dl=rm; mhat=fadd_s(mhat,dl); \
      _Pragma("unroll") for(int r=0;r<16;++r){P0[r]=fsub_s(P0[r],dl);P1[r]=fsub_s(P1[r],dl);} \
      _Pragma("unroll") for(int r=0;r<16;++r)negm[r]=-mhat; asm volatile("":"+v"(negm)); } \
    _Pragma("unroll") for(int r=0;r<16;++r)P0[r]=__builtin_amdgcn_exp2f(P0[r]); }while(0)
  #define RESC() do{ if(resc){ asm volatile("s_waitcnt lgkmcnt(0)":::"memory"); \
      _Pragma("unroll") for(int d_=0;d_<2;++d_) _Pragma("unroll") for(int r=0;r<16;++r)o[d_][r]*=wsf[crow(r,hi)]; } }while(0)
  f32x16 pA0,pA1,pB0,pB1;
  int sl_prev=0,sl_cur=0,sl_next=SLOTB;
  #define ROT() do{sl_prev=sl_cur;sl_cur=sl_next;sl_next=(sl_next==(NSLOT-1)*SLOTB)?0:sl_next+SLOTB;}while(0)
  DMA_K(2,2*SLOTB);
  WAIT_BAR(3);
  qkt(pA0,pA1,Kbase,qr,negm,r32,hi);asm volatile("s_nop 15\n\ts_nop 7":"+v"(pA0),"+v"(pA1));CMASK(pA0,pA1,0);
  START(pA0,pA1);
  _Pragma("unroll") for(int r=0;r<16;++r)pA1[r]=__builtin_amdgcn_exp2f(pA1[r]);
  WAIT_BAR(0);
  DMA_K(3,0);DMA_V(1,SLOTB);
  ROT();
  kload8(kf,kp0+sl_cur);
  WAIT_BAR(2);
  s16x4 vlo[8],vhi[8]; u32x4 pw0,pw1,pw2,pw3;
  #define PKW(P,B) cvtpk_s(P[B],P[B+1])
  #define PAF(k) __builtin_bit_cast(bf16x8,pw##k)
  #define VFR(i) (bf16x8){vlo[i][0],vlo[i][1],vlo[i][2],vlo[i][3],vhi[i][0],vhi[i][1],vhi[i][2],vhi[i][3]}
  #define PIN(x) asm volatile("":"+v"(x))
  #define MX3(a,b,c) __builtin_fmaxf(__builtin_fmaxf((a),(b)),(c))
  #define GAPA(MF,A0,A1,A2,A3,W0,W1,PW) do{ MF; sacc+=A0; sacc+=A1; sacc+=A2; sacc+=A3; PIN(sacc); W0; W1; PIN(PW); SBAR(); }while(0)
  #define EX(v) __builtin_amdgcn_exp2f(v)
  #define GAPB(MF,X,B) do{ MF; X[B]=EX(X[B]); X[B+1]=EX(X[B+1]); X[B+2]=EX(X[B+2]); X[B+3]=EX(X[B+3]); PIN(X); SBAR(); }while(0)
  #define VRD(i) do{ vlo[i]=vtr(vp_+(((i)>>2)*4096+((i)&3)*1024)); vhi[i]=vtr(vp_+(((i)>>2)*4096+((i)&3)*1024+512)); }while(0)
  #define KRD(G,j) do{ if(G){ kload2(kf,kp0+sl_next,j); SBAR(); } }while(0)
  #define STEP(C0,C1,P0,P1,t,GK,GV,GL) do{ SBAR(); \
    const lds_cptr vp_=vp0+sl_prev; \
    VRD(0); SBAR(); float sacc=(P0[0]+P0[1]); \
    GAPA(C0=__builtin_amdgcn_mfma_f32_32x32x16_bf16(kf[0],qr[0],negm,0,0,0), P0[2],P0[3],P0[4],P0[5],     pw0[0]=PKW(P0,0), pw0[1]=PKW(P0,2), pw0); \
    VRD(4); SBAR(); GAPA(C1=__builtin_amdgcn_mfma_f32_32x32x16_bf16(kf[1],qr[0],negm,0,0,0), P0[6],P0[7],P0[8],P0[9],     pw0[2]=PKW(P0,4), pw0[3]=PKW(P0,6), pw0); \
    VRD(1); SBAR(); GAPA(C0=__builtin_amdgcn_mfma_f32_32x32x16_bf16(kf[2],qr[1],C0,0,0,0),   P0[10],P0[11],P0[12],P0[13], pw1[0]=PKW(P0,8), pw1[1]=PKW(P0,10), pw1); \
    VRD(5); SBAR(); GAPA(C1=__builtin_amdgcn_mfma_f32_32x32x16_bf16(kf[3],qr[1],C1,0,0,0),   P0[14],P0[15],P1[0],P1[1],   pw1[2]=PKW(P0,12),pw1[3]=PKW(P0,14), pw1); \
    VRD(2); SBAR(); GAPA(C0=__builtin_amdgcn_mfma_f32_32x32x16_bf16(kf[4],qr[2],C0,0,0,0),   P1[2],P1[3],P1[4],P1[5],     pw2[0]=PKW(P1,0), pw2[1]=PKW(P1,2), pw2); \
    VRD(6); SBAR(); GAPA(C1=__builtin_amdgcn_mfma_f32_32x32x16_bf16(kf[5],qr[2],C1,0,0,0),   P1[6],P1[7],P1[8],P1[9],     pw2[2]=PKW(P1,4), pw2[3]=PKW(P1,6), pw2); \
    VRD(3); SBAR(); GAPA(C0=__builtin_amdgcn_mfma_f32_32x32x16_bf16(kf[6],qr[3],C0,0,0,0),   P1[10],P1[11],P1[12],P1[13], pw3[0]=PKW(P1,8), pw3[1]=PKW(P1,10), pw3); \
    VRD(7); SBAR(); GAPA(C1=__builtin_amdgcn_mfma_f32_32x32x16_bf16(kf[7],qr[3],C1,0,0,0),   P1[14],P1[15],0.f,0.f,       pw3[2]=PKW(P1,12),pw3[3]=PKW(P1,14), pw3); \
    l_reg+=sacc; \
    if(GK){DMA_K((t)+3,sl_cur);} if(GV){DMA_V((t)+1,sl_next);} \
    CMASK(C0,C1,t); \
    { float a=MX3(C0[0],C0[1],C1[0]),b=MX3(C0[2],C0[3],C1[1]); a=MX3(a,C1[2],C1[3]); \
      _Pragma("unroll") for(int r=4;r<16;r+=4){a=MX3(a,C0[r],C0[r+1]);b=MX3(b,C0[r+2],C0[r+3]);a=MX3(a,C1[r],C1[r+1]);b=MX3(b,C1[r+2],C1[r+3]);} \
      float rm=__builtin_fmaxf(a,b); { auto rr=__builtin_amdgcn_permlane32_swap(__float_as_uint(rm),__float_as_uint(rm),false,false); rm=__builtin_fmaxf(__uint_as_float(rr[0]),__uint_as_float(rr[1])); } \
      resc=false; \
      if(__builtin_expect(__any(rm>(float)THRL),0)){ const float dl=__builtin_fmaxf(rm,0.f); mhat+=dl; \
        _Pragma("unroll") for(int r=0;r<16;++r){C0[r]-=dl;C1[r]-=dl;} \
        _Pragma("unroll") for(int r=0;r<16;++r)negm[r]=-mhat; asm volatile("":"+v"(negm)); \
        const float f=__builtin_amdgcn_exp2f(-dl); l_reg*=f; if(hi==0)wsf[r32]=f; resc=true; } } \
    SBAR(); \
    GAPB(o[0]=__builtin_amdgcn_mfma_f32_32x32x16_bf16(PAF(0),VFR(0),o[0],0,0,0), C0,0); \
    GAPB(o[1]=__builtin_amdgcn_mfma_f32_32x32x16_bf16(PAF(0),VFR(4),o[1],0,0,0), C0,4); \
    KRD(GL,0); GAPB(o[0]=__builtin_amdgcn_mfma_f32_32x32x16_bf16(PAF(1),VFR(1),o[0],0,0,0), C0,8); \
    KRD(GL,1); GAPB(o[1]=__builtin_amdgcn_mfma_f32_32x32x16_bf16(PAF(1),VFR(5),o[1],0,0,0), C0,12); \
    KRD(GL,2); GAPB(o[0]=__builtin_amdgcn_mfma_f32_32x32x16_bf16(PAF(2),VFR(2),o[0],0,0,0), C1,0); \
    KRD(GL,3); GAPB(o[1]=__builtin_amdgcn_mfma_f32_32x32x16_bf16(PAF(2),VFR(6),o[1],0,0,0), C1,4); \
    GAPB(o[0]=__builtin_amdgcn_mfma_f32_32x32x16_bf16(PAF(3),VFR(3),o[0],0,0,0), C1,8); \
    GAPB(o[1]=__builtin_amdgcn_mfma_f32_32x32x16_bf16(PAF(3),VFR(7),o[1],0,0,0), C1,12); \
    }while(0)
  int t=1;
  #undef CMASK
  #define CMASK(P0,P1,t) do{}while(0)
  for(;t+5<NT;t+=2){
    STEP(pB0,pB1,pA0,pA1,t,true,true,true);     WAIT_BAR(2); RESC(); ROT();
    STEP(pA0,pA1,pB0,pB1,t+1,true,true,true);   WAIT_BAR(2); RESC(); ROT();
  }
  #undef CMASK
  #define CMASK(P0,P1,t) do{}while(0)
  #define ENDW(tt) do{ if((tt)+3<NT){WAIT_BAR(2);} else if((tt)+2<NT){WAIT_BAR(1);} else {WAIT_BAR(0);} }while(0)
  for(;t+1<NT;t+=2){
    STEP(pB0,pB1,pA0,pA1,t,(t+3<NT),(t+1<NT),(t+1<NT));       ENDW(t);   RESC(); ROT();
    STEP(pA0,pA1,pB0,pB1,t+1,(t+4<NT),(t+2<NT),(t+2<NT));     ENDW(t+1); RESC(); ROT();
  }
  STEP(pB0,pB1,pA0,pA1,NT-1,false,false,false); RESC();
  { float sacc=pB0[0]+pB0[1]; _Pragma("unroll") for(int r=2;r<16;++r)sacc+=pB0[r]; _Pragma("unroll") for(int r=0;r<16;++r)sacc+=pB1[r]; l_reg+=sacc;
    pw0=(u32x4){PKW(pB0,0),PKW(pB0,2),PKW(pB0,4),PKW(pB0,6)};pw1=(u32x4){PKW(pB0,8),PKW(pB0,10),PKW(pB0,12),PKW(pB0,14)};pw2=(u32x4){PKW(pB1,0),PKW(pB1,2),PKW(pB1,4),PKW(pB1,6)};pw3=(u32x4){PKW(pB1,8),PKW(pB1,10),PKW(pB1,12),PKW(pB1,14)};
    SBAR(); pv(o,vb0+sl_cur,PAF(0),PAF(1),PAF(2),PAF(3)); }
  #undef PKW
  #undef PAF
  #undef VFR
  #undef PIN
  #undef MX3
  #undef GAPA
  #undef GAPB
  #undef EX
  #undef VRD
  #undef KRD
  #undef STEP
  #undef ENDW
  {auto rr=__builtin_amdgcn_permlane32_swap(__float_as_uint(l_reg),__float_as_uint(l_reg),false,false);l_reg=__uint_as_float(rr[0])+__uint_as_float(rr[1]);}
  if(hi==0)wsf[32+r32]=l_reg;asm volatile("s_waitcnt lgkmcnt(0)":::"memory");
  float rli[16];
  #pragma unroll
  for(int r=0;r<16;++r)rli[r]=__builtin_amdgcn_rcpf(wsf[32+crow(r,hi)]);
  bf16*Ow=O+(rowbase+q0+wid*QBLK)*OP+h*D;
  { bf16*stg=(bf16*)(shm+LDS_OST)+wid*2048;
    #pragma unroll
    for(int r=0;r<16;++r){const int orow=crow(r,hi);
      #pragma unroll
      for(int d0=0;d0<2;++d0)stg[orow*64+d0*32+r32]=__float2bfloat16(o[d0][r]*rli[r]);}
    asm volatile("s_waitcnt lgkmcnt(0)":::"memory");
    #pragma unroll
    for(int i=0;i<4;++i){const int row=i*8+(lane>>3),ch=lane&7; const u32x4 v=*(const u32x4*)(stg+row*64+ch*8); ATTN_STORE16(Ow+(long)row*OP+ch*8,v);} }
  asm volatile("s_waitcnt lgkmcnt(0)\n\ts_barrier":::"memory");
  #undef DMA_K
  #undef DMA_V
  #undef CMASK
  #undef START
  #undef RESC
  #undef ROT
}
constexpr int ATTN_LDS_BYTES=LDS_BYTES;
template<int THRL=8> __device__ __forceinline__ void attn_phase(char*lds,const bf16*Q,const bf16*K,const bf16*V,bf16*O,int vcu,int G){
  for(int u=vcu;u<BATCH*NHEAD*(SEQ/QB);u+=G){ const int grp=u>>5, r=u&31; const int b=grp>>1, kvh=grp&1, hq=r>>3, qb=r&7; attn_unit<THRL>(b,kvh*4+hq,qb,Q,K,V,O,lds); }
}
#undef SBAR
#undef WAIT_BAR
}

constexpr size_t MiB = 1u << 20;
constexpr size_t WS_CTL = 0, CTL_ZERO_BYTES = 16384;
constexpr size_t WS_ROPE = 1 * MiB, WS_SS = 2 * MiB;
constexpr size_t WS_WIN = 4 * MiB, WS_WXKV = 11 * MiB, WS_WCAT = 15 * MiB, WS_WOUT = 17 * MiB, WS_WXQ = 19 * MiB, WS_WXO = 21 * MiB, WS_WFF1 = 23 * MiB, WS_WFF2 = 31 * MiB;
constexpr size_t WS_MN = 40 * MiB, WS_XK = 48 * MiB, WS_XVT = 56 * MiB, WS_HB = 64 * MiB;
constexpr size_t WS_R1 = 128 * MiB;
constexpr size_t WS_R2 = 192 * MiB;
constexpr size_t WS_R3 = 256 * MiB;
constexpr size_t WS_G = 320 * MiB;
constexpr size_t WS_F = 128 * MiB;
constexpr size_t WS_END = 448 * MiB;

constexpr int NWAVES = 8;
constexpr int RING_BYTES = 131072, XCH_OFF = RING_BYTES, MISC_OFF = XCH_OFF + 8192, LDS_BYTES = 147456;
#define GAS __attribute__((address_space(1)))
#define LAS __attribute__((address_space(3)))
typedef unsigned short bf16;
typedef unsigned v4u __attribute__((ext_vector_type(4)));
typedef float f32x4 __attribute__((ext_vector_type(4)));

__device__ __forceinline__ unsigned f2bf(float f) { unsigned u = __builtin_bit_cast(unsigned, f); return (u + 0x7fffu + ((u >> 16) & 1u)) >> 16; }
__device__ __forceinline__ unsigned pk2(float lo, float hi) { return f2bf(lo) | (f2bf(hi) << 16); }
__device__ __forceinline__ float wave_sum(float v) {
#pragma unroll
    for (int o = 1; o < 64; o <<= 1) v += __shfl_xor(v, o);
    return v;
}
#define LDS_WAIT() asm volatile("s_waitcnt lgkmcnt(0)" ::: "memory")

__device__ __forceinline__ void p0_transpose_item(const float* W, int ldw, bf16* WT, int ldt, LAS float* scr, int item, int nblk, int lane, const float* gk) {
    const int kb = item / nblk, nb = item % nblk, k0 = 64 * kb, n0 = 32 * nb;
#pragma unroll
    for (int i = 0; i < 32; ++i) { const int kk = 2 * i + (lane >> 5); float v = W[(size_t)(k0 + kk) * ldw + n0 + (lane & 31)]; if (gk) v *= gk[k0 + kk]; scr[kk * 33 + (lane & 31)] = v; }
    LDS_WAIT(); asm volatile("" ::: "memory");
    const int c = lane & 7;
#pragma unroll
    for (int j = 0; j < 4; ++j) { const int n = (lane >> 3) + 8 * j; const LAS float* s = scr + (8 * c) * 33 + n;
        v4u o; o.x = pk2(s[0 * 33], s[1 * 33]); o.y = pk2(s[2 * 33], s[3 * 33]); o.z = pk2(s[4 * 33], s[5 * 33]); o.w = pk2(s[6 * 33], s[7 * 33]);
        *(v4u*)(WT + (size_t)(n0 + n) * ldt + k0 + 8 * c) = o; }
    LDS_WAIT(); asm volatile("" ::: "memory");
}
__device__ __forceinline__ void p0_transpose_block(const float* W, int ldw, bf16* WT, int ldt, LAS float* T, int k0, int n0, int tid, const float* gk) {
    f32x4 v[8];
#pragma unroll
    for (int i = 0; i < 8; ++i) { const int row = (tid >> 6) + 8 * i; v[i] = *(const f32x4*)(W + (size_t)(k0 + row) * ldw + n0 + (tid & 63) * 4); }
    if (gk) {
#pragma unroll
        for (int i = 0; i < 8; ++i) v[i] = v[i] * gk[k0 + (tid >> 6) + 8 * i]; }
#pragma unroll
    for (int i = 0; i < 8; ++i) { LAS float* d = T + ((tid >> 6) + 8 * i) * 257 + (tid & 63) * 4; d[0] = v[i].x; d[1] = v[i].y; d[2] = v[i].z; d[3] = v[i].w; }
    LDS_WAIT(); __builtin_amdgcn_s_barrier(); asm volatile("" ::: "memory");
#pragma unroll
    for (int j = 0; j < 4; ++j) { const int p = tid + 512 * j, n = p >> 3, c = p & 7; const LAS float* s = T + (8 * c) * 257 + n;
        v4u o; o.x = pk2(s[0 * 257], s[1 * 257]); o.y = pk2(s[2 * 257], s[3 * 257]); o.z = pk2(s[4 * 257], s[5 * 257]); o.w = pk2(s[6 * 257], s[7 * 257]);
        *(v4u*)(WT + (size_t)(n0 + n) * ldt + k0 + 8 * c) = o; }
    LDS_WAIT(); __builtin_amdgcn_s_barrier(); asm volatile("" ::: "memory");
}
template <int R> __device__ __forceinline__ void rms_rows_to_bf16(const float* xrow, const float* g, bf16* orow, int lane) {
    const f32x4* gr = (const f32x4*)g + lane;
    f32x4 v[R][4]; float s[R];
#pragma unroll
    for (int r = 0; r < R; ++r) { const f32x4* xr = (const f32x4*)(xrow + (size_t)r * 1024) + lane;
#pragma unroll
        for (int j = 0; j < 4; ++j) v[r][j] = xr[64 * j]; }
#pragma unroll
    for (int r = 0; r < R; ++r) { s[r] = 0.f;
#pragma unroll
        for (int j = 0; j < 4; ++j) s[r] += (v[r][j].x * v[r][j].x + v[r][j].y * v[r][j].y) + (v[r][j].z * v[r][j].z + v[r][j].w * v[r][j].w); }
#pragma unroll
    for (int r = 0; r < R; ++r) { const float rs = 1.0f / sqrtf(wave_sum(s[r]) * (1.f / 1024.f) + EPS);
        unsigned long long* o8 = (unsigned long long*)(orow + (size_t)r * 1024) + lane;
#pragma unroll
        for (int j = 0; j < 4; ++j) { const f32x4 gg = gr[64 * j]; o8[64 * j] = (unsigned long long)pk2(v[r][j].x * rs * gg.x, v[r][j].y * rs * gg.y) | ((unsigned long long)pk2(v[r][j].z * rs * gg.z, v[r][j].w * rs * gg.w) << 32); } }
}

typedef GAS unsigned gu32;
#define RLX_AGENT __ATOMIC_RELAXED, __HIP_MEMORY_SCOPE_AGENT
#define XB_TMO      128
#define XB_XCNT(j)  (256  + 64 * (j))
#define XB_XSUB(j)  (1280 + 64 * (j))
#define XB_XGEN(j)  (2304 + 64 * (j))
#define XB_TOP      3328
#define XB_TOPGEN   3392
#define XCD_BAR_WORDS 3456
#define XB_SPIN_CAP (1u << 18)

__device__ __forceinline__ unsigned xb_ld(unsigned* p)              { return __hip_atomic_load(p, __ATOMIC_RELAXED, __HIP_MEMORY_SCOPE_AGENT); }
__device__ __forceinline__ unsigned xb_add(unsigned* p, unsigned v) { return __hip_atomic_fetch_add(p, v, __ATOMIC_RELAXED, __HIP_MEMORY_SCOPE_AGENT); }
__device__ __forceinline__ unsigned xb_xcc_id() { return (unsigned)__builtin_amdgcn_s_getreg((3 << 11) | 20) & 0xFu; }
#define XB_SPIN(cond, bar) do { unsigned _sp = 0; while (cond) { __builtin_amdgcn_s_sleep(1); \
    if ((++_sp & 255u) == 0u) { if (xb_ld(&(bar)[XB_TMO])) break; if (_sp > XB_SPIN_CAP) { atomicAdd(&(bar)[XB_TMO], 1u); break; } } } } while (0)

struct XcdBarrier {
    unsigned* bar; unsigned x;
    volatile LAS unsigned* st;
};

__device__ __forceinline__ XcdBarrier xcd_barrier_post(unsigned* bar, volatile LAS unsigned* st) {
    XcdBarrier b; b.bar = bar; b.x = xb_xcc_id(); b.st = st;
    if (threadIdx.x == 0) (void)xb_add(&bar[XB_XCNT(b.x)], 1u);
    return b;
}
__device__ __forceinline__ void xcd_barrier_complete(unsigned* bar, unsigned x, unsigned& nloc, unsigned& nx) {
    const unsigned G = gridDim.x * gridDim.y * gridDim.z;
    unsigned sum, cnt, mine, sp = 0u;
    for (;;) {
        sum = 0u; cnt = 0u; mine = 0u;
#pragma unroll
        for (unsigned j = 0; j < 16; ++j) { const unsigned c = xb_ld(&bar[XB_XCNT(j)]); sum += c; cnt += (c > 0u) ? 1u : 0u; mine = (j == x) ? c : mine; }
        if (sum == G) break;
        __builtin_amdgcn_s_sleep(1);
        if ((++sp & 255u) == 0u) { if (xb_ld(&bar[XB_TMO])) break; if (sp > XB_SPIN_CAP) { atomicAdd(&bar[XB_TMO], 1u); break; } }
    }
    nloc = mine > 0u ? mine : 1u; nx = cnt > 0u ? cnt : 1u;
}

__device__ __forceinline__ void xcd_barrier(const XcdBarrier& b) {
    asm volatile("s_waitcnt vmcnt(0)" ::: "memory");
    __syncthreads();
    if (threadIdx.x == 0) {
        unsigned* bar = b.bar;
        __builtin_amdgcn_s_waitcnt(0);
        unsigned nloc = b.st[0], nx = b.st[1];
        if (nloc == 0u) { xcd_barrier_complete(bar, b.x, nloc, nx); b.st[0] = nloc; b.st[1] = nx; }
        const unsigned old = xb_add(&bar[XB_XSUB(b.x)], 1u);
        const unsigned gen = old / nloc;
        if (old + 1u == (gen + 1u) * nloc) {
            __builtin_amdgcn_fence(__ATOMIC_RELEASE, "agent");
            asm volatile("s_waitcnt vmcnt(0)" ::: "memory");
            const unsigned og = xb_add(&bar[XB_TOP], 1u);
            const unsigned tg = og / nx;
            if (og + 1u == (tg + 1u) * nx) xb_add(&bar[XB_TOPGEN], 1u);
            else XB_SPIN(xb_ld(&bar[XB_TOPGEN]) == tg, bar);
            __builtin_amdgcn_fence(__ATOMIC_ACQUIRE, "agent");
            xb_add(&bar[XB_XGEN(b.x)], 1u);
            asm volatile("s_waitcnt vmcnt(0)" ::: "memory");
        } else {
            XB_SPIN(xb_ld(&bar[XB_XGEN(b.x)]) == gen, bar);
            __builtin_amdgcn_fence(__ATOMIC_ACQUIRE, "agent");
            asm volatile("s_waitcnt vmcnt(0)" ::: "memory");
        }
    }
    __syncthreads();
}

struct Args {
    const float* in[21]; float* out; unsigned char* ws; int ph_lo, ph_hi;
};
enum { I_X = 0, I_MEM, I_GMIX, I_WIN, I_BGATE, I_GQ, I_GK, I_WATTN, I_POOLW, I_PSCALE, I_WPOOL, I_WOUT, I_GCROSS, I_GMEM, I_WXQ, I_WXKV, I_WXO, I_GFFN, I_WFF1, I_WFF2, I_GFINAL };
constexpr int N_PHASES = 12;

__global__ void __launch_bounds__(NWAVES * 64, 2) mega_fwd(Args args) {
    extern __shared__ __attribute__((aligned(16))) unsigned char lds[];
    LAS unsigned char* ldsp = (LAS unsigned char*)lds;
    LAS float* xch = (LAS float*)(ldsp + XCH_OFF);
    const int tid = threadIdx.x, lane = tid & 63, wave = __builtin_amdgcn_readfirstlane(tid >> 6);
    const int G = gridDim.x; const int bx = blockIdx.x;
    const int vcu = (G % 8 == 0) ? (bx % 8) * (G / 8) + bx / 8 : bx;
    unsigned char* ws = args.ws;
    const int lo = args.ph_lo, hi = args.ph_hi;
    bf16* Win_t = (bf16*)(ws + WS_WIN); bf16* Wxkv_t = (bf16*)(ws + WS_WXKV); bf16* Wcat_t = (bf16*)(ws + WS_WCAT); bf16* Wout_t = (bf16*)(ws + WS_WOUT);
    bf16* Wxq_t = (bf16*)(ws + WS_WXQ); bf16* Wxo_t = (bf16*)(ws + WS_WXO); bf16* Wff1_t = (bf16*)(ws + WS_WFF1); bf16* Wff2_t = (bf16*)(ws + WS_WFF2);
    float* ROPE = (float*)(ws + WS_ROPE); float* SS = (float*)(ws + WS_SS);
    bf16* MNb = (bf16*)(ws + WS_MN); bf16* XK = (bf16*)(ws + WS_XK); bf16* XVT = (bf16*)(ws + WS_XVT); bf16* HB = (bf16*)(ws + WS_HB);
    bf16* N1 = (bf16*)(ws + WS_R1); bf16* AP = (bf16*)(ws + WS_R1); bf16* Pm = (bf16*)(ws + WS_R1);
    bf16* Qb = (bf16*)(ws + WS_R2); bf16* Kb = (bf16*)(ws + WS_R2 + 32 * MiB); bf16* Vb = (bf16*)(ws + WS_R2 + 40 * MiB); bf16* MIX = (bf16*)(ws + WS_R2); bf16* XO = (bf16*)(ws + WS_R2);
    bf16* Ub = (bf16*)(ws + WS_R3); bf16* XQ = (bf16*)(ws + WS_R3);
    bf16* Gt = (bf16*)(ws + WS_G); bf16* Fb = (bf16*)(ws + WS_F);
    float* OUT = args.out;

    volatile LAS unsigned* MISC = (volatile LAS unsigned*)(ldsp + MISC_OFF);
    if (tid < 32) MISC[tid] = 0u;
    __syncthreads();
    XcdBarrier bar; bar.bar = (unsigned*)(ws + WS_CTL); bar.x = 0; bar.st = nullptr;
    if (!MK_PER_PHASE) bar = xcd_barrier_post((unsigned*)(ws + WS_CTL), MISC + 8);
    if (hi > 1000) cg::this_grid().sync();
#ifndef PHASE_MASK
#define PHASE_MASK 0xFFF
#endif
#define IN(k) (((PHASE_MASK >> (k)) & 1) && lo <= (k) && (k) < hi)
#ifndef REPEAT_MASK
#define REPEAT_MASK 0
#endif
#ifndef EXTRA_SYNCS
#define EXTRA_SYNCS 0
#endif
#define PHASE(k) if (IN(k)) _Pragma("unroll") for (int rep_ = 0; rep_ <= ((REPEAT_MASK >> (k)) & 1); ++rep_)
#define REP_SYNC() do { if (rep_) xcd_barrier(bar); } while (0)
#define SEAM(k) do { if (IN(k) && IN((k) + 1)) { xcd_barrier(bar); } } while (0)
    const int gw = vcu * NWAVES + wave, NGW = G * NWAVES;

    PHASE(0) { REP_SYNC();
        {
            LAS float* T = (LAS float*)ldsp;
            constexpr int B0 = 16 * 13, B1 = 16 * 8, B2 = 8 * 4, B3 = 16 * 4, B4 = 16 * 4, B5 = 16 * 4, B6 = 16 * 16, B7 = 64 * 4;
            constexpr int NBLK = B0 + B1 + B2 + B3 + B4 + B5 + B6 + B7;
            for (int bi = vcu; bi < NBLK; bi += G) {
                int r = bi;
                if (r < B0) { p0_transpose_block(args.in[I_WIN], INW, Win_t, 1024, T, (r / 13) * 64, (r % 13) * 256, tid, nullptr); continue; } r -= B0;
                if (r < B1) { p0_transpose_block(args.in[I_WXKV], 2048, Wxkv_t, 1024, T, (r >> 3) * 64, (r & 7) * 256, tid, nullptr); continue; } r -= B1;
                if (r < B2) { p0_transpose_block(args.in[I_WATTN], 1024, Wcat_t, 1024, T, (r >> 2) * 64, (r & 3) * 256, tid, nullptr); continue; } r -= B2;
                if (r < B3) { p0_transpose_block(args.in[I_WOUT], 1024, Wout_t, 1024, T, (r >> 2) * 64, (r & 3) * 256, tid, nullptr); continue; } r -= B3;
                if (r < B4) { p0_transpose_block(args.in[I_WXQ], 1024, Wxq_t, 1024, T, (r >> 2) * 64, (r & 3) * 256, tid, args.in[I_GCROSS]); continue; } r -= B4;
                if (r < B5) { p0_transpose_block(args.in[I_WXO], 1024, Wxo_t, 1024, T, (r >> 2) * 64, (r & 3) * 256, tid, nullptr); continue; } r -= B5;
                if (r < B6) { p0_transpose_block(args.in[I_WFF1], 4096, Wff1_t, 1024, T, (r >> 4) * 64, (r & 15) * 256, tid, args.in[I_GFFN]); continue; } r -= B6;
                p0_transpose_block(args.in[I_WFF2], 1024, Wff2_t, 4096, T, (r >> 2) * 64, (r & 3) * 256, tid, nullptr);
            }
        }
        for (int r = gw; r < 2048; r += NGW) {
                const int g = r >> 9, cb = (r >> 4) & 31, nb = r & 15, n = nb * 64 + lane, c0 = cb * 4;
                const float* pw = args.in[I_POOLW] + (size_t)g * 128 * 128 + (size_t)c0 * 128; const float* ps = args.in[I_PSCALE] + g * 128; const float* wp = args.in[I_WPOOL] + (size_t)g * 128 * 1024 + n;
                float a[4];
#pragma unroll
                for (int cc = 0; cc < 4; ++cc) a[cc] = 0.f;
                for (int d0 = 0; d0 < 128; d0 += 32) { float w[32];
#pragma unroll
                    for (int dd = 0; dd < 32; ++dd) w[dd] = wp[(size_t)(d0 + dd) * 1024];
#pragma unroll
                    for (int dd = 0; dd < 32; ++dd) { const float ws_ = w[dd] * ps[d0 + dd];
#pragma unroll
                        for (int cc = 0; cc < 4; ++cc) a[cc] += pw[cc * 128 + d0 + dd] * ws_; } }
                *(unsigned long long*)(Wcat_t + (size_t)n * 1024 + 512 + g * 128 + c0) = (unsigned long long)pk2(a[0], a[1]) | ((unsigned long long)pk2(a[2], a[3]) << 32);
        }
        {
            const int gt = vcu * NWAVES * 64 + tid;
            if (gt < 1024) { const int pos = gt >> 4, f = gt & 15; const float inv = exp2f(-(float)f * (13.287712379549449f / 16.0f));
                const float ang = (float)pos * inv; float rev = ang * 0.15915494309189535f; rev -= floorf(rev);
                ROPE[gt] = __builtin_amdgcn_cosf(rev); ROPE[1024 + gt] = __builtin_amdgcn_sinf(rev); }
        }
        for (int m4 = gw; m4 < (TOK + MTOK) / 4; m4 += NGW) { const int m = m4 * 4;
            if (m < TOK) rms_rows_to_bf16<4>(args.in[I_X] + (size_t)m * DM, args.in[I_GMIX], N1 + (size_t)m * DM, lane);
            else rms_rows_to_bf16<4>(args.in[I_MEM] + (size_t)(m - TOK) * DM, args.in[I_GMEM], MNb + (size_t)(m - TOK) * DM, lane);
        }
    }
    SEAM(0);

    PHASE(1) { REP_SYNC();
        typedef pg8::ProbP1<(long)WS_R1, (long)WS_WIN, (long)WS_MN, (long)WS_WXKV> P1; P1 S; S.ws = (const char*)ws; S.G = G; S.c = bx; S.K = 1024; S.lda = 1024; S.ldb = 1024; S.mid = -1;
        pg8::EpiP1 E{Qb, Kb, Vb, Ub, Gt, XK, XVT, args.in[I_BGATE], args.in[I_GQ], args.in[I_GK], ROPE};
        pg8::gemm_phase<pg8::EpiP1, P1, true, true>(ldsp, xch, S, E);
    }
    SEAM(1);

    PHASE(2) { REP_SYNC();
        attn_body::attn_phase((char*)lds, (const attn_body::bf16*)Qb, (const attn_body::bf16*)Kb, (const attn_body::bf16*)Vb, (attn_body::bf16*)AP, vcu, G);
        const int grp = lane >> 4, hw = 1 << grp;
        for (int ch = gw; ch < TOK / 16; ch += NGW) {
            const int t0 = ch * 16, s0 = t0 & (SEQ - 1);
            const bf16* ub = Ub + (size_t)(t0 - s0) * 512 + lane * 8;
            float a[8];
#pragma unroll
            for (int j = 0; j < 8; ++j) a[j] = 0.f;
#pragma unroll
            for (int k = 0; k < 16; ++k) { const int r = s0 - hw + k;
                if (k < 2 * hw && r >= 0 && r < SEQ) { const v4u w = *(const v4u*)(ub + (size_t)r * 512);
                    a[0] += pg8::bf_lo(w.x); a[1] += pg8::bf_hi(w.x); a[2] += pg8::bf_lo(w.y); a[3] += pg8::bf_hi(w.y); a[4] += pg8::bf_lo(w.z); a[5] += pg8::bf_hi(w.z); a[6] += pg8::bf_lo(w.w); a[7] += pg8::bf_hi(w.w); } }
#pragma unroll 4
            for (int i = 0; i < 16; ++i) { const int s = s0 + i; const int lo_s = max(s - hw, 0), hi_s = min(s + hw, SEQ);
                const v4u w = *(const v4u*)(ub + (size_t)s * 512); const float ic = 1.0f / (float)(hi_s - lo_s);
                v4u o; o.x = pk2(a[0] * ic - pg8::bf_lo(w.x), a[1] * ic - pg8::bf_hi(w.x)); o.y = pk2(a[2] * ic - pg8::bf_lo(w.y), a[3] * ic - pg8::bf_hi(w.y));
                o.z = pk2(a[4] * ic - pg8::bf_lo(w.z), a[5] * ic - pg8::bf_hi(w.z)); o.w = pk2(a[6] * ic - pg8::bf_lo(w.w), a[7] * ic - pg8::bf_hi(w.w));
                *(v4u*)(AP + (size_t)(t0 + i) * 1024 + 512 + lane * 8) = o;
                if (s + hw < SEQ) { const v4u p = *(const v4u*)(ub + (size_t)(s + hw) * 512);
                    a[0] += pg8::bf_lo(p.x); a[1] += pg8::bf_hi(p.x); a[2] += pg8::bf_lo(p.y); a[3] += pg8::bf_hi(p.y); a[4] += pg8::bf_lo(p.z); a[5] += pg8::bf_hi(p.z); a[6] += pg8::bf_lo(p.w); a[7] += pg8::bf_hi(p.w); }
                if (s - hw >= 0) { const v4u q = *(const v4u*)(ub + (size_t)(s - hw) * 512);
                    a[0] -= pg8::bf_lo(q.x); a[1] -= pg8::bf_hi(q.x); a[2] -= pg8::bf_lo(q.y); a[3] -= pg8::bf_hi(q.y); a[4] -= pg8::bf_lo(q.z); a[5] -= pg8::bf_hi(q.z); a[6] -= pg8::bf_lo(q.w); a[7] -= pg8::bf_hi(q.w); }
            }
        }
    }
    SEAM(2);

    PHASE(3) { REP_SYNC();
        pg8::ProbMN S = pg8::make_plain(AP, Wcat_t, TOK, 1024, 1024, G, bx); S.mid = 8;
        pg8::EpiMix E{Gt, MIX};
        pg8::gemm_phase<pg8::EpiMix, pg8::ProbMN, true, true>(ldsp, xch, S, E);
    }
    SEAM(3);

    PHASE(4) { REP_SYNC();
        pg8::ProbMN S = pg8::make_plain(MIX, Wout_t, TOK, 1024, 1024, G, bx);
        pg8::EpiRes<0> E{args.in[I_X], HB, SS};
        pg8::gemm_phase<pg8::EpiRes<0>, pg8::ProbMN, true, true>(ldsp, xch, S, E);
    }
    SEAM(4);

    PHASE(5) { REP_SYNC();
        pg8::ProbMN S = pg8::make_plain(HB, Wxq_t, TOK, 1024, 1024, G, bx);
        pg8::EpiRowScale<0> E{SS, XQ, 1024, XSCALE};
        pg8::gemm_phase<pg8::EpiRowScale<0>, pg8::ProbMN, true, true>(ldsp, xch, S, E);
    }
    SEAM(5);

    PHASE(6) { REP_SYNC();
        pg8::ProbMN S; S.A = XQ; S.B = XK; S.nM = TOK / 256; S.nN = 4; S.G = G; S.c = bx; S.K = 256; S.lda = 1024; S.ldb = 1024; S.mid = -1;
        S.a_pm = 256L * 1024; S.a_pn = 256; S.b_pb = 256L * 1024; S.b_pn = 256;
        pg8::EpiSoftmax E{Pm};
        pg8::gemm_phase<pg8::EpiSoftmax, pg8::ProbMN, true, true>(ldsp, xch, S, E);
    }
    SEAM(6);

    PHASE(7) { REP_SYNC();
        pg8::ProbMN S; S.A = Pm; S.B = XVT; S.nM = TOK / 256; S.nN = 4; S.G = G; S.c = bx; S.K = 256; S.lda = 1024; S.ldb = 4096; S.mid = -1;
        S.a_pm = 256L * 1024; S.a_pn = 256; S.b_pb = 256; S.b_pn = 256L * 4096;
        pg8::EpiPlain E{XO, 1024};
        pg8::gemm_phase<pg8::EpiPlain, pg8::ProbMN, true, true>(ldsp, xch, S, E);
    }
    SEAM(7);

    PHASE(8) { REP_SYNC();
        pg8::ProbMN S = pg8::make_plain(XO, Wxo_t, TOK, 1024, 1024, G, bx);
        pg8::EpiRes<1> E{nullptr, HB, SS};
        pg8::gemm_phase<pg8::EpiRes<1>, pg8::ProbMN, true, true>(ldsp, xch, S, E);
    }
    SEAM(8);

    PHASE(9) { REP_SYNC();
        pg8::ProbMN S = pg8::make_plain(HB, Wff1_t, TOK, 4096, 1024, G, bx);
        pg8::EpiRowScale<1> E{SS, Fb, 4096, 1.0f};
        pg8::gemm_phase<pg8::EpiRowScale<1>, pg8::ProbMN, true, true>(ldsp, xch, S, E);
    }
    SEAM(9);

    PHASE(10) { REP_SYNC();
        pg8::ProbMN S = pg8::make_plain(Fb, Wff2_t, TOK, 1024, 4096, G, bx);
        pg8::EpiRes<1> E{nullptr, HB, SS};
        pg8::gemm_phase<pg8::EpiRes<1>, pg8::ProbMN, true, true>(ldsp, xch, S, E);
    }
    SEAM(10);

    PHASE(11) { REP_SYNC();
        const f32x4* gf = (const f32x4*)args.in[I_GFINAL];
        const f32x4 g0 = gf[2 * lane], g1 = gf[2 * lane + 1], g2 = gf[128 + 2 * lane], g3 = gf[128 + 2 * lane + 1];
        for (int m4 = gw; m4 < TOK / 4; m4 += NGW) { const int m = m4 * 4;
            v4u w0[4], w1[4]; float sp[4];
#pragma unroll
            for (int r = 0; r < 4; ++r) { const bf16* hr = HB + (size_t)(m + r) * DM + lane * 8; w0[r] = *(const v4u*)hr; w1[r] = *(const v4u*)(hr + 512); sp[r] = (lane < 16) ? SS[(size_t)(m + r) * 16 + lane] : 0.f; }
#pragma unroll
            for (int r = 0; r < 4; ++r) { const float rs = 1.0f / sqrtf(wave_sum(sp[r]) * (1.f / 1024.f) + EPS);
                f32x4* orow = (f32x4*)(OUT + (size_t)(m + r) * DM) + 2 * lane;
                orow[0] = (f32x4){pg8::bf_lo(w0[r].x), pg8::bf_hi(w0[r].x), pg8::bf_lo(w0[r].y), pg8::bf_hi(w0[r].y)} * rs * g0;
                orow[1] = (f32x4){pg8::bf_lo(w0[r].z), pg8::bf_hi(w0[r].z), pg8::bf_lo(w0[r].w), pg8::bf_hi(w0[r].w)} * rs * g1;
                orow[128] = (f32x4){pg8::bf_lo(w1[r].x), pg8::bf_hi(w1[r].x), pg8::bf_lo(w1[r].y), pg8::bf_hi(w1[r].y)} * rs * g2;
                orow[129] = (f32x4){pg8::bf_lo(w1[r].z), pg8::bf_hi(w1[r].z), pg8::bf_lo(w1[r].w), pg8::bf_hi(w1[r].w)} * rs * g3; }
        }
    }
    for (int e_ = 0; e_ < EXTRA_SYNCS; ++e_) xcd_barrier(bar);
#undef IN
#undef SEAM
}

extern "C" void kernel_launch(void* const* d_in, const int* in_sizes, int n_in, void* d_out, int out_size, void* d_ws, size_t ws_size, hipStream_t stream) {
    static int grid = 0;
    if (grid == 0) {
        if (n_in != 21 || in_sizes[0] != TOK * DM || out_size != TOK * DM || ws_size < WS_END) {
            fprintf(stderr, "kernel_launch: unexpected shapes: n_in %d in0 %d out %d ws %zu (need >= %zu)\n", n_in, n_in > 0 ? in_sizes[0] : -1, out_size, ws_size, (size_t)WS_END); grid = -1; return; }
        int dev = 0, cus = 0, per_cu = 0;
        if (hipGetDevice(&dev) != hipSuccess || hipDeviceGetAttribute(&cus, hipDeviceAttributeMultiprocessorCount, dev) != hipSuccess) { grid = -1; return; }
        if (hipFuncSetAttribute((const void*)mega_fwd, hipFuncAttributeMaxDynamicSharedMemorySize, LDS_BYTES) != hipSuccess) { fprintf(stderr, "kernel_launch: hipFuncSetAttribute failed\n"); grid = -1; return; }
        if (hipOccupancyMaxActiveBlocksPerMultiprocessor(&per_cu, (const void*)mega_fwd, NWAVES * 64, LDS_BYTES) != hipSuccess || per_cu < 1) { fprintf(stderr, "kernel_launch: occupancy query says %d\n", per_cu); per_cu = 1; }
        (void)hipGetLastError();
        grid = cus * per_cu;
    }
    if (grid < 0) return;
    if (hipMemsetAsync((char*)d_ws + WS_CTL, 0, CTL_ZERO_BYTES, stream) != hipSuccess) { fprintf(stderr, "kernel_launch: memset failed\n"); return; }
    Args a{};
    for (int i = 0; i < 21; ++i) a.in[i] = (const float*)d_in[i];
    a.out = (float*)d_out; a.ws = (unsigned char*)d_ws;
#if MK_PER_PHASE
    for (int p = 0; p < N_PHASES; ++p) { a.ph_lo = p; a.ph_hi = p + 1; hipLaunchKernelGGL(mega_fwd, dim3(grid), dim3(NWAVES * 64), LDS_BYTES, stream, a); }
#else
    a.ph_lo = 0; a.ph_hi = N_PHASES;
    void* kargs[] = {&a};
    hipError_t e = hipLaunchCooperativeKernel((const void*)mega_fwd, dim3(grid), dim3(NWAVES * 64), kargs, LDS_BYTES, stream);
    if (e != hipSuccess) fprintf(stderr, "kernel_launch: cooperative launch failed: %s (grid %d)\n", hipGetErrorString(e), grid);
#endif
}
```

```cpp
#include <hip/hip_runtime.h>
#include <hip/hip_cooperative_groups.h>
#include <hip/hip_bf16.h>
#include <cstdio>
#include <cstdint>
#include <cmath>
namespace cg = cooperative_groups;

#ifndef MK_PER_PHASE
#define MK_PER_PHASE 0
#endif

constexpr int DM = 1024, NB = 16, SEQ = 2048, TOK = NB * SEQ, NMEM = 256, MTOK = NB * NMEM;
constexpr int INW = 3328, DFF = 4096;
constexpr float EPS = 1e-6f;
constexpr float LOG2E = 1.4426950408889634f;
constexpr float QSCALE = 0.125f * LOG2E;
constexpr float XSCALE = 0.0625f * LOG2E;

namespace pg8 {
#define PG8_LAS __attribute__((address_space(3)))
typedef unsigned short bf16_t;
typedef short bf16x8 __attribute__((ext_vector_type(8)));
typedef float f32x4 __attribute__((ext_vector_type(4)));
typedef float f32x2 __attribute__((ext_vector_type(2)));
typedef unsigned u32x4 __attribute__((ext_vector_type(4)));
typedef unsigned u32x2 __attribute__((ext_vector_type(2)));
typedef __bf16 bf16x2_t __attribute__((ext_vector_type(2)));
constexpr int BM = 256, BK = 64, HALF = 128, HTB = HALF * BK * 2, STAGE_BYTES = 8 * HTB, NXCD = 8, WGM = 4;

__host__ __device__ __forceinline__ int lds_byte(int r, int c) { const int st = (r >> 4) * 2 + (c >> 5), rr = r & 15, cc = c & 31, ob = rr * 64 + cc * 2; return st * 1024 + (ob ^ (((ob >> 9) & 1) << 5)); }
__host__ __device__ __forceinline__ void stage_rc(int b, int& R, int& C) { const int st = b / 1024, sb = b % 1024, swz = sb ^ (((sb >> 9) & 1) << 5); R = (st >> 1) * 16 + swz / 64; C = (st & 1) * 32 + (swz % 64) / 2; }
__host__ __device__ __forceinline__ int perm32(int rho) { const int n = rho >> 4, i = rho & 15; return 8 * (i >> 2) + 4 * n + (i & 3); }

struct Unit { int pm, pn, id; };
#define PG8_OPAQUE(x) asm volatile("" : "+v"(x))

__device__ __forceinline__ unsigned pk_bf16(float lo, float hi) { f32x2 v = {lo, hi}; bf16x2_t b = __builtin_convertvector(v, bf16x2_t); return __builtin_bit_cast(unsigned, b); }
__device__ __forceinline__ float bf_lo(unsigned w) { return __uint_as_float(w << 16); }
__device__ __forceinline__ float bf_hi(unsigned w) { return __uint_as_float(w & 0xffff0000u); }
#define PG8_FENCE() asm volatile("" ::: "memory")

__device__ __forceinline__ void remap_tile(int wgid, int nM, int nN, int& pm, int& pn) {
    const int nwg = nM * nN;
    { const int q = nwg / NXCD, r = nwg % NXCD, xcd = wgid % NXCD, off = wgid / NXCD; wgid = (xcd < r ? xcd * (q + 1) : r * (q + 1) + (xcd - r) * q) + off; }
    const int nig = WGM * nN, gid = wgid / nig, fm = gid * WGM, gsz = (nM - fm) < WGM ? (nM - fm) : WGM;
    pm = fm + ((wgid % nig) % gsz); pn = (wgid % nig) / gsz;
}

struct ProbMN {
    const bf16_t* A; const bf16_t* B; int nM, nN, G, c; int K, lda, ldb, mid; long a_pm, a_pn, b_pb, b_pn;
    __device__ __forceinline__ bool next(int i, Unit& u) const {
        const long L = (long)i * G + c; if (L >= (long)nM * nN) return false;
        remap_tile((int)L, nM, nN, u.pm, u.pn); u.id = 0; return true; }
    __device__ __forceinline__ const char* aptr(const Unit& u) const { return (const char*)(A + (size_t)u.pm * a_pm + (size_t)u.pn * a_pn); }
    __device__ __forceinline__ const char* bptr(const Unit& u) const { return (const char*)(B + (size_t)(u.pm >> 3) * b_pb + (size_t)u.pn * b_pn); }
};
__device__ __forceinline__ ProbMN make_plain(const bf16_t* A, const bf16_t* Bt, int M, int N, int K, int G, int c) {
    ProbMN p; p.A = A; p.B = Bt; p.nM = M / BM; p.nN = N / BM; p.G = G; p.c = c; p.K = K; p.lda = K; p.ldb = K; p.mid = -1;
    p.a_pm = (long)BM * K; p.a_pn = 0; p.b_pb = 0; p.b_pn = (long)BM * K; return p; }

template <long OFF_N1, long OFF_WIN, long OFF_MN, long OFF_WXKV> struct ProbP1 {
    const char* ws; int G, c; int K, lda, ldb, mid;
    static constexpr int NPROJ = 128 * 13, NXK = 64, NXV = 64;
    __device__ __forceinline__ bool next(int i, Unit& u) const {
        const int L = i * G + c; if (L >= NPROJ + NXK + NXV) return false;
        if (L < NPROJ) { remap_tile(L, 128, 13, u.pm, u.pn); u.id = 0; }
        else if (L < NPROJ + NXK) { const int e = L - NPROJ; u.pm = e >> 2; u.pn = e & 3; u.id = 1; }
        else { const int e = L - NPROJ - NXK; u.pm = e >> 4; u.pn = e & 15; u.id = 2; }
        return true; }
    __device__ __forceinline__ const char* aptr(const Unit& u) const {
        const long off = u.id == 0 ? OFF_N1 : (u.id == 1 ? OFF_MN : OFF_WXKV + 1024L * 1024 * 2); return ws + off + (long)u.pm * (256 * 1024 * 2); }
    __device__ __forceinline__ const char* bptr(const Unit& u) const {
        const long off = u.id == 0 ? OFF_WIN : (u.id == 1 ? OFF_WXKV : OFF_MN); return ws + off + (long)u.pn * (256 * 1024 * 2); }
};

typedef f32x4 Acc[2][2][4][2];

__device__ __forceinline__ void store_tile_bf16_np(const Acc& acc, bf16_t* base, int ldc, int wr, int wc, int fr, int fq) {
#pragma unroll
    for (int ai = 0; ai < 2; ++ai)
#pragma unroll
        for (int m = 0; m < 4; ++m) { bf16_t* rowp = base + (size_t)(ai * HALF + wr * 64 + m * 16 + fr) * ldc + wc * 32 + 4 * fq;
#pragma unroll
            for (int bj = 0; bj < 2; ++bj)
#pragma unroll
                for (int n = 0; n < 2; ++n) { const f32x4 v = acc[ai][bj][m][n]; u32x2 w; w.x = pk_bf16(v[0], v[1]); w.y = pk_bf16(v[2], v[3]); *(u32x2*)(rowp + bj * HALF + n * 16) = w; } }
}

struct EpiP1 {
    static constexpr bool PERM = false, AFTER_DRAIN = false, HAS_MID = false;
    bf16_t *Q, *Kb, *Vb, *U, *Gt, *XK, *XVT; const float *bgate, *gq, *gk, *rope;
    __device__ __forceinline__ void mid(Acc&, const Unit&, int, int, int, int) const {}
    __device__ __forceinline__ void qk_rope(Acc& acc, const Unit& u, int wr, int wc, int fr, int fq, PG8_LAS float* xch, int wid, int bj, const float* gain, float oscale, bf16_t* out, int ldo, int ocol0) const {
#pragma unroll
        for (int ai = 0; ai < 2; ++ai)
#pragma unroll
            for (int m = 0; m < 4; ++m) {
                const f32x4 a = acc[ai][bj][m][0], b = acc[ai][bj][m][1];
                float s = (a[0] * a[0] + a[1] * a[1]) + (a[2] * a[2] + a[3] * a[3]) + (b[0] * b[0] + b[1] * b[1]) + (b[2] * b[2] + b[3] * b[3]);
                s += __shfl_xor(s, 16); s += __shfl_xor(s, 32);
                if (fq == 0) xch[wid * 128 + (ai * 4 + m) * 16 + fr] = s;
            }
        asm volatile("s_waitcnt lgkmcnt(0)" ::: "memory"); __builtin_amdgcn_s_barrier(); PG8_FENCE();
        const int axis = wc & 1;
        const int d0 = axis * 32 + 4 * fq;
        const f32x4 g0 = *(const f32x4*)(gain + d0), g1 = *(const f32x4*)(gain + d0 + 16);
        const int gridrow0 = (u.pm & 7) * 4 + wr;
#pragma unroll
        for (int ai = 0; ai < 2; ++ai)
#pragma unroll
            for (int m = 0; m < 4; ++m) {
                const int xi = (ai * 4 + m) * 16 + fr;
                const float tot = xch[wid * 128 + xi] + xch[(wid ^ 1) * 128 + xi];
                const float rs = __builtin_amdgcn_rsqf(tot * (1.0f / 64.0f) + EPS) ;
                const int pos = axis ? (m * 16 + fr) : (gridrow0 + 2 * ai);
                const f32x4 cs = *(const f32x4*)(rope + pos * 16 + 4 * fq), sn = *(const f32x4*)(rope + 1024 + pos * 16 + 4 * fq);
                const f32x4 x0 = acc[ai][bj][m][0] * rs * g0, x1 = acc[ai][bj][m][1] * rs * g1;
                const f32x4 y0 = (x0 * cs - x1 * sn) * oscale, y1 = (x1 * cs + x0 * sn) * oscale;
                bf16_t* rowp = out + (size_t)(u.pm * BM + ai * HALF + wr * 64 + m * 16 + fr) * ldo + ocol0 + wc * 32 + 4 * fq;
                u32x2 w0, w1; w0.x = pk_bf16(y0[0], y0[1]); w0.y = pk_bf16(y0[2], y0[3]); w1.x = pk_bf16(y1[0], y1[1]); w1.y = pk_bf16(y1[2], y1[3]);
                *(u32x2*)(rowp) = w0; *(u32x2*)(rowp + 16) = w1;
            }
        asm volatile("s_waitcnt lgkmcnt(0)" ::: "memory"); __builtin_amdgcn_s_barrier(); PG8_FENCE();
    }
    __device__ __forceinline__ void operator()(Acc& acc, const Unit& u, int wr, int wc, int fr, int fq, PG8_LAS float* xch, int wid) const { PG8_OPAQUE(fr);
        if (u.id == 0) {
            if (u.pn < 2) {
                qk_rope(acc, u, wr, wc, fr, fq, xch, wid, 0, gq, QSCALE, Q, 512, u.pn * 256);
                qk_rope(acc, u, wr, wc, fr, fq, xch, wid, 1, gq, QSCALE, Q, 512, u.pn * 256 + 128);
            } else if (u.pn == 2) {
                qk_rope(acc, u, wr, wc, fr, fq, xch, wid, 0, gk, 1.0f, Kb, 128, 0);
#pragma unroll
                for (int ai = 0; ai < 2; ++ai)
#pragma unroll
                    for (int m = 0; m < 4; ++m) { bf16_t* rowp = Vb + (size_t)(u.pm * BM + ai * HALF + wr * 64 + m * 16 + fr) * 128 + wc * 32 + 4 * fq;
#pragma unroll
                        for (int n = 0; n < 2; ++n) { const f32x4 v = acc[ai][1][m][n]; u32x2 w; w.x = pk_bf16(v[0], v[1]); w.y = pk_bf16(v[2], v[3]); *(u32x2*)(rowp + n * 16) = w; } }
            } else if (u.pn < 5) {
                store_tile_bf16_np(acc, U + (size_t)u.pm * BM * 512 + (u.pn - 3) * 256, 512, wr, wc, fr, fq);
            } else {
                const int gc0 = (u.pn - 5) * 256 + wc * 32 + 4 * fq;
                f32x4 bv[2][2];
#pragma unroll
                for (int bj = 0; bj < 2; ++bj)
#pragma unroll
                    for (int n = 0; n < 2; ++n) bv[bj][n] = *(const f32x4*)(bgate + gc0 + bj * HALF + n * 16);
#pragma unroll
                for (int ai = 0; ai < 2; ++ai)
#pragma unroll
                    for (int m = 0; m < 4; ++m) { bf16_t* rowp = Gt + (size_t)(u.pm * BM + ai * HALF + wr * 64 + m * 16 + fr) * 2048 + gc0;
#pragma unroll
                        for (int bj = 0; bj < 2; ++bj)
#pragma unroll
                            for (int n = 0; n < 2; ++n) { f32x4 z = acc[ai][bj][m][n] + bv[bj][n]; f32x4 s;
#pragma unroll
                                for (int j = 0; j < 4; ++j) { const float zz = fminf(fmaxf(z[j], -30.f), 30.f); s[j] = __builtin_amdgcn_rcpf(1.0f + __builtin_amdgcn_exp2f(-zz * LOG2E)); }
                                u32x2 w; w.x = pk_bf16(s[0], s[1]); w.y = pk_bf16(s[2], s[3]); *(u32x2*)(rowp + bj * HALF + n * 16) = w; }
                        PG8_FENCE(); }
            }
        } else if (u.id == 1) {
            store_tile_bf16_np(acc, XK + (size_t)u.pm * BM * 1024 + u.pn * 256, 1024, wr, wc, fr, fq);
        } else {
            store_tile_bf16_np(acc, XVT + (size_t)u.pm * BM * 4096 + u.pn * 256, 4096, wr, wc, fr, fq);
        }
    }
};

struct EpiMix {
    static constexpr bool PERM = true, AFTER_DRAIN = false, HAS_MID = true;
    const bf16_t* Gt; bf16_t* MIX;
    __device__ __forceinline__ void mid(Acc& acc, const Unit& u, int wr, int wc, int fr, int fq) const { PG8_OPAQUE(fr);
#pragma unroll
        for (int ai = 0; ai < 2; ++ai) {
            u32x4 ga[4][2], gp[4][2];
#pragma unroll
            for (int m = 0; m < 4; ++m) { const bf16_t* grow = Gt + (size_t)(u.pm * BM + ai * HALF + wr * 64 + m * 16 + fr) * 2048 + u.pn * 256 + wc * 32 + 8 * fq;
#pragma unroll
                for (int bj = 0; bj < 2; ++bj) { ga[m][bj] = *(const u32x4*)(grow + bj * HALF); gp[m][bj] = *(const u32x4*)(grow + 1024 + bj * HALF); } }
#pragma unroll
            for (int m = 0; m < 4; ++m)
#pragma unroll
                for (int bj = 0; bj < 2; ++bj) { const u32x4 a = ga[m][bj], p = gp[m][bj];
                    f32x4 r0, r1;
                    r0[0] = bf_lo(a.x) * __builtin_amdgcn_rcpf(bf_lo(p.x)); r0[1] = bf_hi(a.x) * __builtin_amdgcn_rcpf(bf_hi(p.x));
                    r0[2] = bf_lo(a.y) * __builtin_amdgcn_rcpf(bf_lo(p.y)); r0[3] = bf_hi(a.y) * __builtin_amdgcn_rcpf(bf_hi(p.y));
                    r1[0] = bf_lo(a.z) * __builtin_amdgcn_rcpf(bf_lo(p.z)); r1[1] = bf_hi(a.z) * __builtin_amdgcn_rcpf(bf_hi(p.z));
                    r1[2] = bf_lo(a.w) * __builtin_amdgcn_rcpf(bf_lo(p.w)); r1[3] = bf_hi(a.w) * __builtin_amdgcn_rcpf(bf_hi(p.w));
                    acc[ai][bj][m][0] *= r0; acc[ai][bj][m][1] *= r1; }
            PG8_FENCE(); }
    }
    __device__ __forceinline__ void operator()(Acc& acc, const Unit& u, int wr, int wc, int fr, int fq, PG8_LAS float*, int) const { PG8_OPAQUE(fr);
        u32x4 gp[2][4][2];
#pragma unroll
        for (int ai = 0; ai < 2; ++ai)
#pragma unroll
            for (int m = 0; m < 4; ++m) { const bf16_t* grow = Gt + (size_t)(u.pm * BM + ai * HALF + wr * 64 + m * 16 + fr) * 2048 + 1024 + u.pn * 256 + wc * 32 + 8 * fq;
#pragma unroll
                for (int bj = 0; bj < 2; ++bj) gp[ai][m][bj] = *(const u32x4*)(grow + bj * HALF); }
#pragma unroll
        for (int ai = 0; ai < 2; ++ai)
#pragma unroll
            for (int m = 0; m < 4; ++m) { bf16_t* mrow = MIX + (size_t)(u.pm * BM + ai * HALF + wr * 64 + m * 16 + fr) * 1024 + u.pn * 256 + wc * 32 + 8 * fq;
#pragma unroll
                for (int bj = 0; bj < 2; ++bj) { const u32x4 g = gp[ai][m][bj];
                    const f32x4 a = acc[ai][bj][m][0], b = acc[ai][bj][m][1]; u32x4 w;
                    w.x = pk_bf16(a[0] * bf_lo(g.x), a[1] * bf_hi(g.x)); w.y = pk_bf16(a[2] * bf_lo(g.y), a[3] * bf_hi(g.y));
                    w.z = pk_bf16(b[0] * bf_lo(g.z), b[1] * bf_hi(g.z)); w.w = pk_bf16(b[2] * bf_lo(g.w), b[3] * bf_hi(g.w));
                    *(u32x4*)(mrow + bj * HALF) = w; } }
    }
};

template <int MODE> struct EpiRes {
    static constexpr bool PERM = true, AFTER_DRAIN = false, HAS_MID = false;
    const float* basef; bf16_t* HB; float* SS;
    __device__ __forceinline__ void mid(Acc&, const Unit&, int, int, int, int) const {}
    __device__ __forceinline__ void operator()(Acc& acc, const Unit& u, int wr, int wc, int fr, int fq, PG8_LAS float*, int) const { PG8_OPAQUE(fr);
        const int col0 = u.pn * BM + wc * 32 + 8 * fq;
#pragma unroll
        for (int ai = 0; ai < 2; ++ai) {
            f32x4 bf[MODE == 0 ? 4 : 1][2][2]; u32x4 bh[MODE == 1 ? 4 : 1][2];
#pragma unroll
            for (int m = 0; m < 4; ++m) { const size_t off = (size_t)(u.pm * BM + ai * HALF + wr * 64 + m * 16 + fr) * 1024 + col0;
#pragma unroll
                for (int bj = 0; bj < 2; ++bj) {
                    if (MODE == 0) { bf[m][bj][0] = *(const f32x4*)(basef + off + bj * HALF); bf[m][bj][1] = *(const f32x4*)(basef + off + bj * HALF + 4); }
                    else bh[m][bj] = *(const u32x4*)(HB + off + bj * HALF); } }
#pragma unroll
            for (int m = 0; m < 4; ++m) { const size_t row = (size_t)(u.pm * BM + ai * HALF + wr * 64 + m * 16 + fr); const size_t off = row * 1024 + col0; float ss = 0.f;
#pragma unroll
                for (int bj = 0; bj < 2; ++bj) { f32x4 b0, b1;
                    if (MODE == 0) { b0 = bf[m][bj][0]; b1 = bf[m][bj][1]; }
                    else { const u32x4 w = bh[m][bj]; b0 = (f32x4){bf_lo(w.x), bf_hi(w.x), bf_lo(w.y), bf_hi(w.y)}; b1 = (f32x4){bf_lo(w.z), bf_hi(w.z), bf_lo(w.w), bf_hi(w.w)}; }
                    const f32x4 h0 = b0 + acc[ai][bj][m][0], h1 = b1 + acc[ai][bj][m][1];
                    ss += (h0[0] * h0[0] + h0[1] * h0[1]) + (h0[2] * h0[2] + h0[3] * h0[3]) + (h1[0] * h1[0] + h1[1] * h1[1]) + (h1[2] * h1[2] + h1[3] * h1[3]);
                    u32x4 o; o.x = pk_bf16(h0[0], h0[1]); o.y = pk_bf16(h0[2], h0[3]); o.z = pk_bf16(h1[0], h1[1]); o.w = pk_bf16(h1[2], h1[3]);
                    *(u32x4*)(HB + off + bj * HALF) = o; }
                ss += __shfl_xor(ss, 16); ss += __shfl_xor(ss, 32);
                if (fq == 0) SS[row * 16 + u.pn * 4 + wc] = ss; }
            PG8_FENCE(); }
    }
};

template <int ACT> struct EpiRowScale {
    static constexpr bool PERM = true, AFTER_DRAIN = false, HAS_MID = false;
    const float* SS; bf16_t* O; int ldc; float scale;
    __device__ __forceinline__ void mid(Acc&, const Unit&, int, int, int, int) const {}
    __device__ __forceinline__ void operator()(Acc& acc, const Unit& u, int wr, int wc, int fr, int fq, PG8_LAS float*, int) const { PG8_OPAQUE(fr);
        f32x4 p4[2][4]; float rsv[2][4];
#pragma unroll
        for (int ai = 0; ai < 2; ++ai)
#pragma unroll
            for (int m = 0; m < 4; ++m) p4[ai][m] = *(const f32x4*)(SS + (size_t)(u.pm * BM + ai * HALF + wr * 64 + m * 16 + fr) * 16 + 4 * fq);
#pragma unroll
        for (int ai = 0; ai < 2; ++ai)
#pragma unroll
            for (int m = 0; m < 4; ++m) { const f32x4 q = p4[ai][m]; float s = (q[0] + q[1]) + (q[2] + q[3]); s += __shfl_xor(s, 16); s += __shfl_xor(s, 32);
                rsv[ai][m] = __builtin_amdgcn_rsqf(s * (1.0f / 1024.0f) + EPS) * scale; }
#pragma unroll
        for (int ai = 0; ai < 2; ++ai)
#pragma unroll
            for (int m = 0; m < 4; ++m) { const float rs = rsv[ai][m];
                bf16_t* rowp = O + (size_t)(u.pm * BM + ai * HALF + wr * 64 + m * 16 + fr) * ldc + u.pn * 256 + wc * 32 + 8 * fq;
#pragma unroll
                for (int bj = 0; bj < 2; ++bj) { f32x4 a = acc[ai][bj][m][0] * rs, b = acc[ai][bj][m][1] * rs;
                    if (ACT == 1) {
#pragma unroll
                        for (int j = 0; j < 4; ++j) { const float x = fmaxf(a[j], 0.f), y = fmaxf(b[j], 0.f); a[j] = x * x; b[j] = y * y; } }
                    u32x4 w; w.x = pk_bf16(a[0], a[1]); w.y = pk_bf16(a[2], a[3]); w.z = pk_bf16(b[0], b[1]); w.w = pk_bf16(b[2], b[3]);
                    *(u32x4*)(rowp + bj * HALF) = w; } }
    }
};

struct EpiPlain {
    static constexpr bool PERM = true, AFTER_DRAIN = false, HAS_MID = false;
    bf16_t* O; int ldc;
    __device__ __forceinline__ void mid(Acc&, const Unit&, int, int, int, int) const {}
    __device__ __forceinline__ void operator()(Acc& acc, const Unit& u, int wr, int wc, int fr, int fq, PG8_LAS float*, int) const { PG8_OPAQUE(fr);
#pragma unroll
        for (int ai = 0; ai < 2; ++ai)
#pragma unroll
            for (int m = 0; m < 4; ++m) { bf16_t* rowp = O + (size_t)(u.pm * BM + ai * HALF + wr * 64 + m * 16 + fr) * ldc + u.pn * 256 + wc * 32 + 8 * fq;
#pragma unroll
                for (int bj = 0; bj < 2; ++bj) { const f32x4 a = acc[ai][bj][m][0], b = acc[ai][bj][m][1];
                    u32x4 w; w.x = pk_bf16(a[0], a[1]); w.y = pk_bf16(a[2], a[3]); w.z = pk_bf16(b[0], b[1]); w.w = pk_bf16(b[2], b[3]);
                    *(u32x4*)(rowp + bj * HALF) = w; } }
    }
};

struct EpiSoftmax {
    static constexpr bool PERM = true, AFTER_DRAIN = false, HAS_MID = false;
    bf16_t* P;
    __device__ __forceinline__ void mid(Acc&, const Unit&, int, int, int, int) const {}
    __device__ __forceinline__ void operator()(Acc& acc, const Unit& u, int wr, int wc, int fr, int fq, PG8_LAS float* xch, int) const { PG8_OPAQUE(fr);
        PG8_LAS float* xmax = xch; PG8_LAS float* xsum = xch + 1024;
#pragma unroll
        for (int ai = 0; ai < 2; ++ai)
#pragma unroll
            for (int m = 0; m < 4; ++m) { float mx = -INFINITY;
#pragma unroll
                for (int bj = 0; bj < 2; ++bj)
#pragma unroll
                    for (int n = 0; n < 2; ++n) { const f32x4 v = acc[ai][bj][m][n]; mx = fmaxf(mx, fmaxf(fmaxf(v[0], v[1]), fmaxf(v[2], v[3]))); }
                mx = fmaxf(mx, __shfl_xor(mx, 16)); mx = fmaxf(mx, __shfl_xor(mx, 32));
                if (fq == 0) xmax[(ai * HALF + wr * 64 + m * 16 + fr) * 4 + wc] = mx; }
        asm volatile("s_waitcnt lgkmcnt(0)" ::: "memory"); __builtin_amdgcn_s_barrier(); PG8_FENCE();
#pragma unroll
        for (int ai = 0; ai < 2; ++ai)
#pragma unroll
            for (int m = 0; m < 4; ++m) { const int rl = ai * HALF + wr * 64 + m * 16 + fr; const f32x4 m4 = *(const PG8_LAS f32x4*)(xmax + rl * 4);
                const float mx = fmaxf(fmaxf(m4[0], m4[1]), fmaxf(m4[2], m4[3])); float s = 0.f;
#pragma unroll
                for (int bj = 0; bj < 2; ++bj)
#pragma unroll
                    for (int n = 0; n < 2; ++n) { f32x4 v = acc[ai][bj][m][n];
#pragma unroll
                        for (int j = 0; j < 4; ++j) { v[j] = __builtin_amdgcn_exp2f(v[j] - mx); s += v[j]; }
                        acc[ai][bj][m][n] = v; }
                s += __shfl_xor(s, 16); s += __shfl_xor(s, 32);
                if (fq == 0) xsum[rl * 4 + wc] = s; }
        asm volatile("s_waitcnt lgkmcnt(0)" ::: "memory"); __builtin_amdgcn_s_barrier(); PG8_FENCE();
#pragma unroll
        for (int ai = 0; ai < 2; ++ai)
#pragma unroll
            for (int m = 0; m < 4; ++m) { const int rl = ai * HALF + wr * 64 + m * 16 + fr; const f32x4 s4 = *(const PG8_LAS f32x4*)(xsum + rl * 4);
                const float inv = __builtin_amdgcn_rcpf((s4[0] + s4[1]) + (s4[2] + s4[3]));
                bf16_t* rowp = P + (size_t)(u.pm * BM + rl) * 1024 + u.pn * 256 + wc * 32 + 8 * fq;
#pragma unroll
                for (int bj = 0; bj < 2; ++bj) { const f32x4 a = acc[ai][bj][m][0] * inv, b = acc[ai][bj][m][1] * inv;
                    u32x4 w; w.x = pk_bf16(a[0], a[1]); w.y = pk_bf16(a[2], a[3]); w.z = pk_bf16(b[0], b[1]); w.w = pk_bf16(b[2], b[3]);
                    *(u32x4*)(rowp + bj * HALF) = w; } }
        asm volatile("s_waitcnt lgkmcnt(0)" ::: "memory"); __builtin_amdgcn_s_barrier(); PG8_FENCE();
    }
};

template <class Epi, class Sched, bool ALIGN_EPI, bool SP2>
__device__ __forceinline__ void gemm_phase(PG8_LAS unsigned char* lds, PG8_LAS float* xch, const Sched& S, const Epi& E) {
    const int tid = threadIdx.x, wid = __builtin_amdgcn_readfirstlane(tid >> 6), lane = tid & 63, wr = wid >> 2, wc = wid & 3, fr = lane & 15, fq = lane >> 4;
    const int K = S.K, nt = K / BK, lda = S.lda, ldb = S.ldb; (void)K;
    unsigned voffA[2], voffB[2];
#pragma unroll
    for (int i = 0; i < 2; ++i) { int R, C; stage_rc(tid * 16 + i * 8192, R, C); const int Rb = Epi::PERM ? ((R & ~31) + perm32(R & 31)) : R;
        voffA[i] = (unsigned)(R * lda + C) * 2u; voffB[i] = (unsigned)(Rb * ldb + C) * 2u; }
    const size_t kstep = (size_t)(BK * 2);
    const size_t hstepA = (size_t)HALF * lda * 2, hstepB = (size_t)HALF * ldb * 2;
    const unsigned ldsw = (unsigned)wid * 1024u;
    const int aoff = lds_byte(wr * 64 + fr, fq * 8), boff = lds_byte(wc * 32 + fr, fq * 8);
#define PG8_SA(b, h) (((b) * 2 + (h)) * HTB)
#define PG8_SB(b, h) ((4 + (b) * 2 + (h)) * HTB)
#define PG8_STAGE(bufoff, gbase, voff) do { _Pragma("unroll") for (int _i = 0; _i < 2; ++_i) \
        __builtin_amdgcn_global_load_lds((const unsigned*)((const char*)(gbase) + (voff)[_i]), (PG8_LAS unsigned*)(lds + (bufoff) + ldsw + _i * 8192), 16, 0, 0); } while (0)
#define PG8_LDA(dst, b, h) do { _Pragma("unroll") for (int m = 0; m < 4; ++m) _Pragma("unroll") for (int k = 0; k < 2; ++k) dst[m][k] = *(const PG8_LAS bf16x8*)(lds + PG8_SA(b, h) + aoff + m * 2048 + k * 1024); } while (0)
#define PG8_LDB(dst, b, h) do { _Pragma("unroll") for (int n = 0; n < 2; ++n) _Pragma("unroll") for (int k = 0; k < 2; ++k) dst[n][k] = *(const PG8_LAS bf16x8*)(lds + PG8_SB(b, h) + boff + n * 2048 + k * 1024); } while (0)
#define PG8_MMA(ai, bj, At, Bt) do { __builtin_amdgcn_s_setprio(1); _Pragma("unroll") for (int m = 0; m < 4; ++m) _Pragma("unroll") for (int n = 0; n < 2; ++n) _Pragma("unroll") for (int k = 0; k < 2; ++k) \
        acc[ai][bj][m][n] = __builtin_amdgcn_mfma_f32_16x16x32_bf16(Bt[n][k], At[m][k], acc[ai][bj][m][n], 0, 0, 0); __builtin_amdgcn_s_setprio(0); } while (0)
#define PG8_WAIT_V(n) asm volatile("s_waitcnt vmcnt(" #n ")" ::: "memory")
#define PG8_WAIT_L(n) asm volatile("s_waitcnt lgkmcnt(" #n ")" ::: "memory")
#define PG8_BAR __builtin_amdgcn_s_barrier()
#define PG8_SCHED __builtin_amdgcn_sched_barrier(0)
    Unit cur, nxt; int ui = 0;
    if (!S.next(0, cur)) return;
    f32x4 acc[2][2][4][2];
#pragma unroll
    for (int a = 0; a < 2; ++a)
#pragma unroll
        for (int b = 0; b < 2; ++b)
#pragma unroll
            for (int m = 0; m < 4; ++m)
#pragma unroll
                for (int n = 0; n < 2; ++n) acc[a][b][m][n] = (f32x4){0.f, 0.f, 0.f, 0.f};
    bf16x8 At[4][2], B0[2][2], B1[2][2];
    const char* cA = S.aptr(cur); const char* cB = S.bptr(cur);
    if constexpr (SP2) {
        PG8_STAGE(PG8_SB(0, 0), cB, voffB); PG8_STAGE(PG8_SB(0, 1), cB + hstepB, voffB); PG8_STAGE(PG8_SA(0, 0), cA, voffA); PG8_STAGE(PG8_SA(0, 1), cA + hstepA, voffA);
        if (wr == 1) PG8_BAR;
        PG8_WAIT_V(2); PG8_BAR;
        PG8_STAGE(PG8_SB(1, 0), cB + kstep, voffB); PG8_STAGE(PG8_SA(1, 0), cA + kstep, voffA); PG8_STAGE(PG8_SB(1, 1), cB + hstepB + kstep, voffB);
        PG8_WAIT_V(6); PG8_BAR;
    } else {
        PG8_STAGE(PG8_SB(0, 0), cB, voffB); PG8_STAGE(PG8_SA(0, 0), cA, voffA); PG8_STAGE(PG8_SB(0, 1), cB + hstepB, voffB); PG8_STAGE(PG8_SA(0, 1), cA + hstepA, voffA);
        if (wr == 1) PG8_BAR;
        PG8_WAIT_V(4); PG8_BAR;
        PG8_STAGE(PG8_SB(1, 0), cB + kstep, voffB); PG8_STAGE(PG8_SA(1, 0), cA + kstep, voffA); PG8_STAGE(PG8_SB(1, 1), cB + hstepB + kstep, voffB);
        PG8_WAIT_V(6); PG8_BAR;
    }
    for (;;) {
        const bool has_next = S.next(ui + 1, nxt);
        const char* nA = has_next ? S.aptr(nxt) : cA; const char* nB = has_next ? S.bptr(nxt) : cB;
        for (int t = 0; t < nt; t += 2) {
            const bool last = (t == nt - 2);
            const char* a1 = cA + (size_t)(t + 1) * kstep;
            const char* a2 = last ? nA : cA + (size_t)(t + 2) * kstep; const char* b2 = last ? nB : cB + (size_t)(t + 2) * kstep;
            const char* a3 = a2 + kstep; const char* b3 = b2 + kstep;
            if constexpr (Epi::HAS_MID) { if (t == S.mid) E.mid(acc, cur, wr, wc, fr, fq); }
            if constexpr (SP2) {
            PG8_LDB(B0, 0, 0); PG8_LDB(B1, 0, 1); PG8_SCHED; PG8_LDA(At, 0, 0); PG8_STAGE(PG8_SA(1, 1), a1 + hstepA, voffA);
            PG8_WAIT_V(8); PG8_WAIT_L(0); PG8_BAR; PG8_MMA(0, 0, At, B0); PG8_MMA(0, 1, At, B1); PG8_BAR; PG8_SCHED;
            PG8_LDA(At, 0, 1); PG8_STAGE(PG8_SB(0, 0), b2, voffB); PG8_STAGE(PG8_SB(0, 1), b2 + hstepB, voffB); PG8_STAGE(PG8_SA(0, 0), a2, voffA);
            PG8_WAIT_V(8); PG8_WAIT_L(0); PG8_BAR; PG8_MMA(1, 0, At, B0); PG8_MMA(1, 1, At, B1); PG8_BAR; PG8_SCHED;
            PG8_LDB(B0, 1, 0); PG8_LDB(B1, 1, 1); PG8_SCHED; PG8_LDA(At, 1, 0); PG8_STAGE(PG8_SA(0, 1), a2 + hstepA, voffA);
            PG8_WAIT_V(8); PG8_WAIT_L(0); PG8_BAR; PG8_MMA(0, 0, At, B0); PG8_MMA(0, 1, At, B1); PG8_BAR; PG8_SCHED;
            PG8_LDA(At, 1, 1); PG8_STAGE(PG8_SB(1, 0), b3, voffB); PG8_STAGE(PG8_SB(1, 1), b3 + hstepB, voffB); PG8_STAGE(PG8_SA(1, 0), a3, voffA);
            PG8_WAIT_V(8); PG8_WAIT_L(0); PG8_BAR; PG8_MMA(1, 0, At, B0); PG8_MMA(1, 1, At, B1); PG8_BAR; PG8_SCHED;
            } else {
            PG8_LDB(B0, 0, 0); PG8_SCHED; PG8_LDA(At, 0, 0); PG8_STAGE(PG8_SA(1, 1), a1 + hstepA, voffA);
            PG8_WAIT_L(8); PG8_BAR; PG8_WAIT_L(0); PG8_MMA(0, 0, At, B0); PG8_BAR; PG8_SCHED;
            PG8_LDB(B1, 0, 1); PG8_STAGE(PG8_SB(0, 0), b2, voffB);
            PG8_BAR; PG8_WAIT_L(0); PG8_MMA(0, 1, At, B1); PG8_BAR;
            PG8_LDA(At, 0, 1); PG8_STAGE(PG8_SA(0, 0), a2, voffA);
            PG8_BAR; PG8_WAIT_L(0); PG8_MMA(1, 0, At, B0); PG8_BAR; PG8_SCHED;
            PG8_STAGE(PG8_SB(0, 1), b2 + hstepB, voffB);
            PG8_WAIT_V(6); PG8_BAR; PG8_MMA(1, 1, At, B1); PG8_BAR;
            PG8_LDB(B0, 1, 0); PG8_SCHED; PG8_LDA(At, 1, 0); PG8_STAGE(PG8_SA(0, 1), a2 + hstepA, voffA);
            PG8_WAIT_L(8); PG8_BAR; PG8_WAIT_L(0); PG8_MMA(0, 0, At, B0); PG8_BAR; PG8_SCHED;
            PG8_LDB(B1, 1, 1); PG8_STAGE(PG8_SB(1, 0), b3, voffB);
            PG8_BAR; PG8_WAIT_L(0); PG8_MMA(0, 1, At, B1); PG8_BAR;
            PG8_LDA(At, 1, 1); PG8_STAGE(PG8_SA(1, 0), a3, voffA);
            PG8_BAR; PG8_WAIT_L(0); PG8_MMA(1, 0, At, B0); PG8_BAR; PG8_SCHED;
            PG8_STAGE(PG8_SB(1, 1), b3 + hstepB, voffB);
            PG8_WAIT_V(6); PG8_BAR; PG8_MMA(1, 1, At, B1); PG8_BAR;
            }
        }
        if constexpr (ALIGN_EPI) { if (wr == 0) PG8_BAR; }
        E(acc, cur, wr, wc, fr, fq, xch, wid);
        if (!has_next) break;
#pragma unroll
        for (int a = 0; a < 2; ++a)
#pragma unroll
            for (int b = 0; b < 2; ++b)
#pragma unroll
                for (int m = 0; m < 4; ++m)
#pragma unroll
                    for (int n = 0; n < 2; ++n) acc[a][b][m][n] = (f32x4){0.f, 0.f, 0.f, 0.f};
        cur = nxt; cA = nA; cB = nB; ++ui;
        if constexpr (ALIGN_EPI) { if (wr == 1) PG8_BAR; }
    }
    PG8_WAIT_V(0);
    if constexpr (!ALIGN_EPI) { if (wr == 0) PG8_BAR; }
    PG8_BAR;
#undef PG8_SA
#undef PG8_SB
#undef PG8_STAGE
#undef PG8_LDA
#undef PG8_LDB
#undef PG8_MMA
#undef PG8_WAIT_V
#undef PG8_WAIT_L
#undef PG8_BAR
#undef PG8_SCHED
}
}

#include <hip/hip_bf16.h>
#include <cmath>
namespace attn_body {
using bf16=__hip_bfloat16;
using bf16x8=__attribute__((ext_vector_type(8)))short;
using s16x4=__attribute__((ext_vector_type(4)))short;
using f32x16=__attribute__((ext_vector_type(16)))float;
using u32x4=__attribute__((ext_vector_type(4)))unsigned;
constexpr int BATCH=16,NHEAD=8,SEQ=2048,D=64,QP=512,KP=128,OP=1024;
constexpr int NW=8,QBLK=32,QB=QBLK*NW,KVBLK=64,NQB=SEQ/QB;
__device__ __forceinline__ int crow(int r,int hi){return (r&3)+8*(r>>2)+4*hi;}
#define SBAR() __builtin_amdgcn_sched_barrier(0)
__device__ __forceinline__ void cmask(f32x16&p0,f32x16&p1,int jb,int qrel,int hi){
  const float NEG=-INFINITY; int kb=64*jb+4*hi;
  #pragma unroll
  for(int r=0;r<16;++r){int kv=kb+(r&3)+8*(r>>2); if(kv>qrel)p0[r]=NEG; if(kv+32>qrel)p1[r]=NEG;}
}

constexpr int NSLOT=3, SLOTB=8192;
constexpr int LDS_K=0, LDS_V=NSLOT*SLOTB, LDS_WS=2*NSLOT*SLOTB, LDS_OST=LDS_WS+NW*64*4, LDS_BYTES=LDS_OST+NW*4096;
constexpr float C2=0.125f*1.4426950408889634f;
__device__ __forceinline__ void glds16(const void*gsrc,unsigned lds_dst){unsigned keep;
  asm volatile("s_mov_b32 %0, m0\n\ts_mov_b32 m0, %2\n\ts_nop 0\n\tglobal_load_lds_dwordx4 %1, off\n\ts_mov_b32 m0, %0":"=&s"(keep):"v"(gsrc),"s"(lds_dst):"memory");}
__device__ __forceinline__ float max3f(float a,float b,float c){float r;asm("v_max3_f32 %0, %1, %2, %3":"=v"(r):"v"(a),"v"(b),"v"(c));return r;}
__device__ __forceinline__ float max2f(float a,float b){float r;asm("v_max_f32_e32 %0, %1, %2":"=v"(r):"v"(a),"v"(b));return r;}
__device__ __forceinline__ float fadd_s(float a,float b){float r;asm("v_add_f32_e32 %0, %1, %2":"=v"(r):"v"(a),"v"(b));return r;}
__device__ __forceinline__ float fsub_s(float a,float b){float r;asm("v_sub_f32_e32 %0, %1, %2":"=v"(r):"v"(a),"v"(b));return r;}
typedef float f32x2_t __attribute__((ext_vector_type(2))); typedef __bf16 bf16x2_t __attribute__((ext_vector_type(2)));
__device__ __forceinline__ unsigned cvtpk_s(float lo,float hi){f32x2_t v={lo,hi};bf16x2_t b=__builtin_convertvector(v,bf16x2_t);return __builtin_bit_cast(unsigned,b);}
#define WAIT_BAR(N) asm volatile("s_waitcnt vmcnt(" #N ") lgkmcnt(0)\n\ts_barrier":::"memory")

__device__ __forceinline__ void qkt(f32x16&p0,f32x16&p1,const char*Kslot,const bf16x8*qr,const f32x16&negm,int r32,int hi){
  const char*kb=Kslot+hi*1024+r32*16;
  #pragma unroll
  for(int d0=0;d0<4;++d0){
    const bf16x8 b0=*reinterpret_cast<const bf16x8*>(kb+d0*2048);
    const bf16x8 b1=*reinterpret_cast<const bf16x8*>(kb+d0*2048+512);
    if(d0==0){p0=__builtin_amdgcn_mfma_f32_32x32x16_bf16(b0,qr[0],negm,0,0,0);p1=__builtin_amdgcn_mfma_f32_32x32x16_bf16(b1,qr[0],negm,0,0,0);}
    else{p0=__builtin_amdgcn_mfma_f32_32x32x16_bf16(b0,qr[d0],p0,0,0,0);p1=__builtin_amdgcn_mfma_f32_32x32x16_bf16(b1,qr[d0],p1,0,0,0);}}
}
typedef __attribute__((address_space(3))) const char* lds_cptr;
typedef short v4i16_t __attribute__((ext_vector_type(4)));
__device__ __forceinline__ void kload8(bf16x8*kf,lds_cptr kp){
  kf[0]=*(const __attribute__((address_space(3))) bf16x8*)(kp);      kf[1]=*(const __attribute__((address_space(3))) bf16x8*)(kp+512);
  kf[2]=*(const __attribute__((address_space(3))) bf16x8*)(kp+2048); kf[3]=*(const __attribute__((address_space(3))) bf16x8*)(kp+2560);
  kf[4]=*(const __attribute__((address_space(3))) bf16x8*)(kp+4096); kf[5]=*(const __attribute__((address_space(3))) bf16x8*)(kp+4608);
  kf[6]=*(const __attribute__((address_space(3))) bf16x8*)(kp+6144); kf[7]=*(const __attribute__((address_space(3))) bf16x8*)(kp+6656);
}
__device__ __forceinline__ void kload2(bf16x8*kf,lds_cptr kp,int j){ kf[2*j]=*(const __attribute__((address_space(3))) bf16x8*)(kp+j*2048); kf[2*j+1]=*(const __attribute__((address_space(3))) bf16x8*)(kp+j*2048+512); }
__device__ __forceinline__ s16x4 vtr(lds_cptr p){ return __builtin_bit_cast(s16x4,__builtin_amdgcn_ds_read_tr16_b64_v4i16((__attribute__((address_space(3))) v4i16_t*)p)); }
__device__ __forceinline__ float rowmax(const f32x16&p0,const f32x16&p1){
  float a=max3f(p0[0],p0[1],p1[0]),b=max3f(p0[2],p0[3],p1[1]);a=max3f(a,p1[2],p1[3]);
  #pragma unroll
  for(int r=4;r<16;r+=4){a=max3f(a,p0[r],p0[r+1]);b=max3f(b,p0[r+2],p0[r+3]);a=max3f(a,p1[r],p1[r+1]);b=max3f(b,p1[r+2],p1[r+3]);}
  const float m=max2f(a,b);
  auto rr=__builtin_amdgcn_permlane32_swap(__float_as_uint(m),__float_as_uint(m),false,false);
  return max2f(__uint_as_float(rr[0]),__uint_as_float(rr[1]));
}
__device__ __forceinline__ void pv(f32x16*o,int vb,bf16x8 pa0,bf16x8 pa1,bf16x8 pa2,bf16x8 pa3){
  #pragma unroll
  for(int d0=0;d0<2;++d0){s16x4 lo[4],hi[4];
    #pragma unroll
    for(int ks=0;ks<4;++ks){
      asm volatile("ds_read_b64_tr_b16 %0,%1 offset:%c2":"=&v"(lo[ks]):"v"(vb),"i"(d0*4096+ks*1024):"memory");
      asm volatile("ds_read_b64_tr_b16 %0,%1 offset:%c2":"=&v"(hi[ks]):"v"(vb),"i"(d0*4096+ks*1024+512):"memory");}
    asm volatile("s_waitcnt lgkmcnt(0)":::"memory");SBAR();
    #define PK(k) (bf16x8){lo[k][0],lo[k][1],lo[k][2],lo[k][3],hi[k][0],hi[k][1],hi[k][2],hi[k][3]}
    o[d0]=__builtin_amdgcn_mfma_f32_32x32x16_bf16(pa0,PK(0),o[d0],0,0,0);
    o[d0]=__builtin_amdgcn_mfma_f32_32x32x16_bf16(pa1,PK(1),o[d0],0,0,0);
    o[d0]=__builtin_amdgcn_mfma_f32_32x32x16_bf16(pa2,PK(2),o[d0],0,0,0);
    o[d0]=__builtin_amdgcn_mfma_f32_32x32x16_bf16(pa3,PK(3),o[d0],0,0,0);
    #undef PK
  }
}

#ifndef ATTN_STORE16
#define ATTN_STORE16(p,v) (*(u32x4*)(p)=(v))
#endif
template<int THRL> __device__ __forceinline__ void attn_unit(int b,int h,int qb,const bf16*Q,const bf16*__restrict__ K,const bf16*__restrict__ V,bf16*O,char*shm){
  const int tid=threadIdx.x,lane=tid&63,r32=lane&31,hi=lane>>5; const int wid=__builtin_amdgcn_readfirstlane(tid>>6);
  const long rowbase=(long)b*SEQ; const int q0=qb*QB;
  const bf16*Qw=Q+(rowbase+q0+wid*QBLK)*QP+h*D;
  const bf16*Kh=K+rowbase*KP+(h>>2)*D,*Vh=V+rowbase*KP+(h>>2)*D;
  const unsigned lds0=(unsigned)(uintptr_t)shm;
  float*wsf=(float*)(shm+LDS_WS)+wid*64;
  const bf16*ksrc=Kh+(long)lane*KP+wid*8;
  const bf16*vsrc=Vh+(long)(16*(wid&3)+(lane>>2))*KP+(wid>>2)*32+(lane&3)*8;
  const unsigned kdst=lds0+LDS_K+wid*1024, vdst=lds0+LDS_V+wid*1024;
  #define DMA_K(t,slot) glds16(ksrc+(long)(t)*KVBLK*KP,(unsigned)__builtin_amdgcn_readfirstlane(kdst+(slot)))
  #define DMA_V(t,slot) glds16(vsrc+(long)(t)*KVBLK*KP,(unsigned)__builtin_amdgcn_readfirstlane(vdst+(slot)))
  const int vb0=(int)(lds0+LDS_V)+((lane>>4)&1)*32+(lane&3)*8+(4*hi+((lane&15)>>2))*64;
  const char*Kbase=shm+LDS_K; bf16x8 kf[8];
  const lds_cptr shm3=(lds_cptr)shm; const lds_cptr kp0=shm3+LDS_K+hi*1024+r32*16; const lds_cptr vp0=shm3+LDS_V+((lane>>4)&1)*32+(lane&3)*8+(4*hi+((lane&15)>>2))*64;
  constexpr int NT=SEQ/KVBLK;
  DMA_K(0,0);DMA_V(0,0);DMA_K(1,SLOTB);
  bf16x8 qr[4];
  #pragma unroll
  for(int d0=0;d0<4;++d0)qr[d0]=*reinterpret_cast<const bf16x8*>(&Qw[(long)r32*QP+d0*16+hi*8]);
  float mhat=0.f,l_reg=0.f;f32x16 o[2];o[0]=f32x16{};o[1]=f32x16{};f32x16 negm=f32x16{};asm volatile("":"+v"(negm));
  #define CMASK(P0,P1,t) do{}while(0)
  bool resc=false;
  #define START(P0,P1) do{ const float rm=rowmax(P0,P1); resc=false; \
    { const float dl=rm; mhat=fadd_s(mhat,dl); \
      _Pragma("unroll") for(int r=0;r<16;++r){P0[r]=fsub_s(P0[r],dl);P1[r]=fsub_s(P1[r],dl);} \
      _Pragma("unroll") for(int r=0;r<16;++r)negm[r]=-mhat; asm volatile("":"+v"(negm)); } \
    _Pragma("unroll") for(int r=0;r<16;++r)P0[r]=__builtin_amdgcn_exp2f(P0[r]); }while(0)
  #define RESC() do{ if(resc){ asm volatile("s_waitcnt lgkmcnt(0)":::"memory"); \
      _Pragma("unroll") for(int d_=0;d_<2;++d_) _Pragma("unroll") for(int r=0;r<16;++r)o[d_][r]*=wsf[crow(r,hi)]; } }while(0)
  f32x16 pA0,pA1,pB0,pB1;
  int sl_prev=0,sl_cur=0,sl_next=SLOTB;
  #define ROT() do{sl_prev=sl_cur;sl_cur=sl_next;sl_next=(sl_next==(NSLOT-1)*SLOTB)?0:sl_next+SLOTB;}while(0)
  DMA_K(2,2*SLOTB);
  WAIT_BAR(3);
  qkt(pA0,pA1,Kbase,qr,negm,r32,hi);asm volatile("s_nop 15\n\ts_nop 7":"+v"(pA0),"+v"(pA1));CMASK(pA0,pA1,0);
  START(pA0,pA1);
  _Pragma("unroll") for(int r=0;r<16;++r)pA1[r]=__builtin_amdgcn_exp2f(pA1[r]);
  WAIT_BAR(0);
  DMA_K(3,0);DMA_V(1,SLOTB);
  ROT();
  kload8(kf,kp0+sl_cur);
  WAIT_BAR(2);
  s16x4 vlo[8],vhi[8]; u32x4 pw0,pw1,pw2,pw3;
  #define PKW(P,B) cvtpk_s(P[B],P[B+1])
  #define PAF(k) __builtin_bit_cast(bf16x8,pw##k)
  #define VFR(i) (bf16x8){vlo[i][0],vlo[i][1],vlo[i][2],vlo[i][3],vhi[i][0],vhi[i][1],vhi[i][2],vhi[i][3]}
  #define PIN(x) asm volatile("":"+v"(x))
  #define MX3(a,b,c) __builtin_fmaxf(__builtin_fmaxf((a),(b)),(c))
  #define GAPA(MF,A0,A1,A2,A3,W0,W1,PW) do{ MF; sacc+=A0; sacc+=A1; sacc+=A2; sacc+=A3; PIN(sacc); W0; W1; PIN(PW); SBAR(); }while(0)
  #define EX(v) __builtin_amdgcn_exp2f(v)
  #define GAPB(MF,X,B) do{ MF; X[B]=EX(X[B]); X[B+1]=EX(X[B+1]); X[B+2]=EX(X[B+2]); X[B+3]=EX(X[B+3]); PIN(X); SBAR(); }while(0)
  #define VRD(i) do{ vlo[i]=vtr(vp_+(((i)>>2)*4096+((i)&3)*1024)); vhi[i]=vtr(vp_+(((i)>>2)*4096+((i)&3)*1024+512)); }while(0)
  #define KRD(G,j) do{ if(G){ kload2(kf,kp0+sl_next,j); SBAR(); } }while(0)
  #define STEP(C0,C1,P0,P1,t,GK,GV,GL) do{ SBAR(); \
    const lds_cptr vp_=vp0+sl_prev; \
    VRD(0); SBAR(); float sacc=(P0[0]+P0[1]); \
    GAPA(C0=__builtin_amdgcn_mfma_f32_32x32x16_bf16(kf[0],qr[0],negm,0,0,0), P0[2],P0[3],P0[4],P0[5],     pw0[0]=PKW(P0,0), pw0[1]=PKW(P0,2), pw0); \
    VRD(4); SBAR(); GAPA(C1=__builtin_amdgcn_mfma_f32_32x32x16_bf16(kf[1],qr[0],negm,0,0,0), P0[6],P0[7],P0[8],P0[9],     pw0[2]=PKW(P0,4), pw0[3]=PKW(P0,6), pw0); \
    VRD(1); SBAR(); GAPA(C0=__builtin_amdgcn_mfma_f32_32x32x16_bf16(kf[2],qr[1],C0,0,0,0),   P0[10],P0[11],P0[12],P0[13], pw1[0]=PKW(P0,8), pw1[1]=PKW(P0,10), pw1); \
    VRD(5); SBAR(); GAPA(C1=__builtin_amdgcn_mfma_f32_32x32x16_bf16(kf[3],qr[1],C1,0,0,0),   P0[14],P0[15],P1[0],P1[1],   pw1[2]=PKW(P0,12),pw1[3]=PKW(P0,14), pw1); \
    VRD(2); SBAR(); GAPA(C0=__builtin_amdgcn_mfma_f32_32x32x16_bf16(kf[4],qr[2],C0,0,0,0),   P1[2],P1[3],P1[4],P1[5],     pw2[0]=PKW(P1,0), pw2[1]=PKW(P1,2), pw2); \
    VRD(6); SBAR(); GAPA(C1=__builtin_amdgcn_mfma_f32_32x32x16_bf16(kf[5],qr[2],C1,0,0,0),   P1[6],P1[7],P1[8],P1[9],     pw2[2]=PKW(P1,4), pw2[3]=PKW(P1,6), pw2); \
    VRD(3); SBAR(); GAPA(C0=__builtin_amdgcn_mfma_f32_32x32x16_bf16(kf[6],qr[3],C0,0,0,0),   P1[10],P1[11],P1[12],P1[13], pw3[0]=PKW(P1,8), pw3[1]=PKW(P1,10), pw3); \
    VRD(7); SBAR(); GAPA(C1=__builtin_amdgcn_mfma_f32_32x32x16_bf16(kf[7],qr[3],C1,0,0,0),   P1[14],P1[15],0.f,0.f,       pw3[2]=PKW(P1,12),pw3[3]=PKW(P1,14), pw3); \
    l_reg+=sacc; \
    if(GK){DMA_K((t)+3,sl_cur);} if(GV){DMA_V((t)+1,sl_next);} \
    CMASK(C0,C1,t); \
    { float a=MX3(C0[0],C0[1],C1[0]),b=MX3(C0[2],C0[3],C1[1]); a=MX3(a,C1[2],C1[3]); \
      _Pragma("unroll") for(int r=4;r<16;r+=4){a=MX3(a,C0[r],C0[r+1]);b=MX3(b,C0[r+2],C0[r+3]);a=MX3(a,C1[r],C1[r+1]);b=MX3(b,C1[r+2],C1[r+3]);} \
      float rm=__builtin_fmaxf(a,b); { auto rr=__builtin_amdgcn_permlane32_swap(__float_as_uint(rm),__float_as_uint(rm),false,false); rm=__builtin_fmaxf(__uint_as_float(rr[0]),__uint_as_float(rr[1])); } \
      resc=false; \
      if(__builtin_expect(__any(rm>(float)THRL),0)){ const float dl=__builtin_fmaxf(rm,0.f); mhat+=dl; \
        _Pragma("unroll") for(int r=0;r<16;++r){C0[r]-=dl;C1[r]-=dl;} \
        _Pragma("unroll") for(int r=0;r<16;++r)negm[r]=-mhat; asm volatile("":"+v"(negm)); \
        const float f=__builtin_amdgcn_exp2f(-dl); l_reg*=f; if(hi==0)wsf[r32]=f; resc=true; } } \
    SBAR(); \
    GAPB(o[0]=__builtin_amdgcn_mfma_f32_32x32x16_bf16(PAF(0),VFR(0),o[0],0,0,0), C0,0); \
    GAPB(o[1]=__builtin_amdgcn_mfma_f32_32x32x16_bf16(PAF(0),VFR(4),o[1],0,0,0), C0,4); \
    KRD(GL,0); GAPB(o[0]=__builtin_amdgcn_mfma_f32_32x32x16_bf16(PAF(1),VFR(1),o[0],0,0,0), C0,8); \
    KRD(GL,1); GAPB(o[1]=__builtin_amdgcn_mfma_f32_32x32x16_bf16(PAF(1),VFR(5),o[1],0,0,0), C0,12); \
    KRD(GL,2); GAPB(o[0]=__builtin_amdgcn_mfma_f32_32x32x16_bf16(PAF(2),VFR(2),o[0],0,0,0), C1,0); \
    KRD(GL,3); GAPB(o[1]=__builtin_amdgcn_mfma_f32_32x32x16_bf16(PAF(2),VFR(6),o[1],0,0,0), C1,4); \
    GAPB(o[0]=__builtin_amdgcn_mfma_f32_32x32x16_bf16(PAF(3),VFR(3),o[0],0,0,0), C1,8); \
    GAPB(o[1]=__builtin_amdgcn_mfma_f32_32x32x16_bf16(PAF(3),VFR(7),o[1],0,0,0), C1,12); \
    }while(0)
  int t=1;
  #undef CMASK
  #define CMASK(P0,P1,t) do{}while(0)
  for(;t+5<NT;t+=2){
    STEP(pB0,pB1,pA0,pA1,t,true,true,true);     WAIT_BAR(2); RESC(); ROT();
    STEP(pA0,pA1,pB0,pB1,t+1,true,true,true);   WAIT_BAR(2); RESC(); ROT();
  }
  #undef CMASK
  #define CMASK(P0,P1,t) do{}while(0)
  #define ENDW(tt) do{ if((tt)+3<NT){WAIT_BAR(2);} else if((tt)+2<NT){WAIT_BAR(1);} else {WAIT_BAR(0);} }while(0)
  for(;t+1<NT;t+=2){
    STEP(pB0,pB1,pA0,pA1,t,(t+3<NT),(t+1<NT),(t+1<NT));       ENDW(t);   RESC(); ROT();
    STEP(pA0,pA1,pB0,pB1,t+1,(t+4<NT),(t+2<NT),(t+2<NT));     ENDW(t+1); RESC(); ROT();
  }
  STEP(pB0,pB1,pA0,pA1,NT-1,false,false,false); RESC();
  { float sacc=pB0[0]+pB0[1]; _Pragma("unroll") for(int r=2;r<16;++r)sacc+=pB0[r]; _Pragma("unroll") for(int r=0;r<16;++r)sacc+=pB1[r]; l_reg+=sacc;
    pw0=(u32x4){PKW(pB0,0),PKW(pB0,2),PKW(pB0,4),PKW(pB0,6)};pw1=(u32x4){PKW(pB0,8),PKW(pB0,10),PKW(pB0,12),PKW(pB0,14)};pw2=(u32x4){PKW(pB1,0),PKW(pB1,2),PKW(pB1,4),PKW(pB1,6)};pw3=(u32x4){PKW(pB1,8),PKW(pB1,10),PKW(pB1,12),PKW(pB1,14)};
    SBAR(); pv(o,vb0+sl_cur,PAF(0),PAF(1),PAF(2),PAF(3)); }
  #undef PKW
  #undef PAF
  #undef VFR
  #undef PIN
  #undef MX3
  #undef GAPA
  #undef GAPB
  #undef EX
  #undef VRD
  #undef KRD
  #undef STEP
  #undef ENDW
  {auto rr=__builtin_amdgcn_permlane32_swap(__float_as_uint(l_reg),__float_as_uint(l_reg),false,false);l_reg=__uint_as_float(rr[0])+__uint_as_float(rr[1]);}
  if(hi==0)wsf[32+r32]=l_reg;asm volatile("s_waitcnt lgkmcnt(0)":::"memory");
  float rli[16];
  #pragma unroll
  for(int r=0;r<16;++r)rli[r]=__builtin_amdgcn_rcpf(wsf[32+crow(r,hi)]);
  bf16*Ow=O+(rowbase+q0+wid*QBLK)*OP+h*D;
  { bf16*stg=(bf16*)(shm+LDS_OST)+wid*2048;
    #pragma unroll
    for(int r=0;r<16;++r){const int orow=crow(r,hi);
      #pragma unroll
      for(int d0=0;d0<2;++d0)stg[orow*64+d0*32+r32]=__float2bfloat16(o[d0][r]*rli[r]);}
    asm volatile("s_waitcnt lgkmcnt(0)":::"memory");
    #pragma unroll
    for(int i=0;i<4;++i){const int row=i*8+(lane>>3),ch=lane&7; const u32x4 v=*(const u32x4*)(stg+row*64+ch*8); ATTN_STORE16(Ow+(long)row*OP+ch*8,v);} }
  asm volatile("s_waitcnt lgkmcnt(0)\n\ts_barrier":::"memory");
  #undef DMA_K
  #undef DMA_V
  #undef CMASK
  #undef START
  #undef RESC
  #undef ROT
}
constexpr int ATTN_LDS_BYTES=LDS_BYTES;
template<int THRL=8> __device__ __forceinline__ void attn_phase(char*lds,const bf16*Q,const bf16*K,const bf16*V,bf16*O,int vcu,int G){
  for(int u=vcu;u<BATCH*NHEAD*(SEQ/QB);u+=G){ const int grp=u>>5, r=u&31; const int b=grp>>1, kvh=grp&1, hq=r>>3, qb=r&7; attn_unit<THRL>(b,kvh*4+hq,qb,Q,K,V,O,lds); }
}
#undef SBAR
#undef WAIT_BAR
}

constexpr size_t MiB = 1u << 20;
constexpr size_t WS_CTL = 0, CTL_ZERO_BYTES = 16384;
constexpr size_t WS_ROPE = 1 * MiB, WS_SS = 2 * MiB;
constexpr size_t WS_WIN = 4 * MiB, WS_WXKV = 11 * MiB, WS_WCAT = 15 * MiB, WS_WOUT = 17 * MiB, WS_WXQ = 19 * MiB, WS_WXO = 21 * MiB, WS_WFF1 = 23 * MiB, WS_WFF2 = 31 * MiB;
constexpr size_t WS_MN = 40 * MiB, WS_XK = 48 * MiB, WS_XVT = 56 * MiB, WS_HB = 64 * MiB;
constexpr size_t WS_R1 = 128 * MiB;
constexpr size_t WS_R2 = 192 * MiB;
constexpr size_t WS_R3 = 256 * MiB;
constexpr size_t WS_G = 320 * MiB;
constexpr size_t WS_F = 128 * MiB;
constexpr size_t WS_END = 448 * MiB;

constexpr int NWAVES = 8;
constexpr int RING_BYTES = 131072, XCH_OFF = RING_BYTES, MISC_OFF = XCH_OFF + 8192, LDS_BYTES = 147456;
#define GAS __attribute__((address_space(1)))
#define LAS __attribute__((address_space(3)))
typedef unsigned short bf16;
typedef unsigned v4u __attribute__((ext_vector_type(4)));
typedef float f32x4 __attribute__((ext_vector_type(4)));

__device__ __forceinline__ unsigned f2bf(float f) { unsigned u = __builtin_bit_cast(unsigned, f); return (u + 0x7fffu + ((u >> 16) & 1u)) >> 16; }
__device__ __forceinline__ unsigned pk2(float lo, float hi) { return f2bf(lo) | (f2bf(hi) << 16); }
__device__ __forceinline__ float wave_sum(float v) {
#pragma unroll
    for (int o = 1; o < 64; o <<= 1) v += __shfl_xor(v, o);
    return v;
}
#define LDS_WAIT() asm volatile("s_waitcnt lgkmcnt(0)" ::: "memory")

__device__ __forceinline__ void p0_transpose_item(const float* W, int ldw, bf16* WT, int ldt, LAS float* scr, int item, int nblk, int lane, const float* gk) {
    const int kb = item / nblk, nb = item % nblk, k0 = 64 * kb, n0 = 32 * nb;
#pragma unroll
    for (int i = 0; i < 32; ++i) { const int kk = 2 * i + (lane >> 5); float v = W[(size_t)(k0 + kk) * ldw + n0 + (lane & 31)]; if (gk) v *= gk[k0 + kk]; scr[kk * 33 + (lane & 31)] = v; }
    LDS_WAIT(); asm volatile("" ::: "memory");
    const int c = lane & 7;
#pragma unroll
    for (int j = 0; j < 4; ++j) { const int n = (lane >> 3) + 8 * j; const LAS float* s = scr + (8 * c) * 33 + n;
        v4u o; o.x = pk2(s[0 * 33], s[1 * 33]); o.y = pk2(s[2 * 33], s[3 * 33]); o.z = pk2(s[4 * 33], s[5 * 33]); o.w = pk2(s[6 * 33], s[7 * 33]);
        *(v4u*)(WT + (size_t)(n0 + n) * ldt + k0 + 8 * c) = o; }
    LDS_WAIT(); asm volatile("" ::: "memory");
}
__device__ __forceinline__ void p0_transpose_block(const float* W, int ldw, bf16* WT, int ldt, LAS float* T, int k0, int n0, int tid, const float* gk) {
    f32x4 v[8];
#pragma unroll
    for (int i = 0; i < 8; ++i) { const int row = (tid >> 6) + 8 * i; v[i] = *(const f32x4*)(W + (size_t)(k0 + row) * ldw + n0 + (tid & 63) * 4); }
    if (gk) {
#pragma unroll
        for (int i = 0; i < 8; ++i) v[i] = v[i] * gk[k0 + (tid >> 6) + 8 * i]; }
#pragma unroll
    for (int i = 0; i < 8; ++i) { LAS float* d = T + ((tid >> 6) + 8 * i) * 257 + (tid & 63) * 4; d[0] = v[i].x; d[1] = v[i].y; d[2] = v[i].z; d[3] = v[i].w; }
    LDS_WAIT(); __builtin_amdgcn_s_barrier(); asm volatile("" ::: "memory");
#pragma unroll
    for (int j = 0; j < 4; ++j) { const int p = tid + 512 * j, n = p >> 3, c = p & 7; const LAS float* s = T + (8 * c) * 257 + n;
        v4u o; o.x = pk2(s[0 * 257], s[1 * 257]); o.y = pk2(s[2 * 257], s[3 * 257]); o.z = pk2(s[4 * 257], s[5 * 257]); o.w = pk2(s[6 * 257], s[7 * 257]);
        *(v4u*)(WT + (size_t)(n0 + n) * ldt + k0 + 8 * c) = o; }
    LDS_WAIT(); __builtin_amdgcn_s_barrier(); asm volatile("" ::: "memory");
}
template <int R> __device__ __forceinline__ void rms_rows_to_bf16(const float* xrow, const float* g, bf16* orow, int lane) {
    const f32x4* gr = (const f32x4*)g + lane;
    f32x4 v[R][4]; float s[R];
#pragma unroll
    for (int r = 0; r < R; ++r) { const f32x4* xr = (const f32x4*)(xrow + (size_t)r * 1024) + lane;
#pragma unroll
        for (int j = 0; j < 4; ++j) v[r][j] = xr[64 * j]; }
#pragma unroll
    for (int r = 0; r < R; ++r) { s[r] = 0.f;
#pragma unroll
        for (int j = 0; j < 4; ++j) s[r] += (v[r][j].x * v[r][j].x + v[r][j].y * v[r][j].y) + (v[r][j].z * v[r][j].z + v[r][j].w * v[r][j].w); }
#pragma unroll
    for (int r = 0; r < R; ++r) { const float rs = 1.0f / sqrtf(wave_sum(s[r]) * (1.f / 1024.f) + EPS);
        unsigned long long* o8 = (unsigned long long*)(orow + (size_t)r * 1024) + lane;
#pragma unroll
        for (int j = 0; j < 4; ++j) { const f32x4 gg = gr[64 * j]; o8[64 * j] = (unsigned long long)pk2(v[r][j].x * rs * gg.x, v[r][j].y * rs * gg.y) | ((unsigned long long)pk2(v[r][j].z * rs * gg.z, v[r][j].w * rs * gg.w) << 32); } }
}

typedef GAS unsigned gu32;
#define RLX_AGENT __ATOMIC_RELAXED, __HIP_MEMORY_SCOPE_AGENT
#define XB_TMO      128
#define XB_XCNT(j)  (256  + 64 * (j))
#define XB_XSUB(j)  (1280 + 64 * (j))
#define XB_XGEN(j)  (2304 + 64 * (j))
#define XB_TOP      3328
#define XB_TOPGEN   3392
#define XCD_BAR_WORDS 3456
#define XB_SPIN_CAP (1u << 18)

__device__ __forceinline__ unsigned xb_ld(unsigned* p)              { return __hip_atomic_load(p, __ATOMIC_RELAXED, __HIP_MEMORY_SCOPE_AGENT); }
__device__ __forceinline__ unsigned xb_add(unsigned* p, unsigned v) { return __hip_atomic_fetch_add(p, v, __ATOMIC_RELAXED, __HIP_MEMORY_SCOPE_AGENT); }
__device__ __forceinline__ unsigned xb_xcc_id() { return (unsigned)__builtin_amdgcn_s_getreg((3 << 11) | 20) & 0xFu; }
#define XB_SPIN(cond, bar) do { unsigned _sp = 0; while (cond) { __builtin_amdgcn_s_sleep(1); \
    if ((++_sp & 255u) == 0u) { if (xb_ld(&(bar)[XB_TMO])) break; if (_sp > XB_SPIN_CAP) { atomicAdd(&(bar)[XB_TMO], 1u); break; } } } } while (0)

struct XcdBarrier {
    unsigned* bar; unsigned x;
    volatile LAS unsigned* st;
};

__device__ __forceinline__ XcdBarrier xcd_barrier_post(unsigned* bar, volatile LAS unsigned* st) {
    XcdBarrier b; b.bar = bar; b.x = xb_xcc_id(); b.st = st;
    if (threadIdx.x == 0) (void)xb_add(&bar[XB_XCNT(b.x)], 1u);
    return b;
}
__device__ __forceinline__ void xcd_barrier_complete(unsigned* bar, unsigned x, unsigned& nloc, unsigned& nx) {
    const unsigned G = gridDim.x * gridDim.y * gridDim.z;
    unsigned sum, cnt, mine, sp = 0u;
    for (;;) {
        sum = 0u; cnt = 0u; mine = 0u;
#pragma unroll
        for (unsigned j = 0; j < 16; ++j) { const unsigned c = xb_ld(&bar[XB_XCNT(j)]); sum += c; cnt += (c > 0u) ? 1u : 0u; mine = (j == x) ? c : mine; }
        if (sum == G) break;
        __builtin_amdgcn_s_sleep(1);
        if ((++sp & 255u) == 0u) { if (xb_ld(&bar[XB_TMO])) break; if (sp > XB_SPIN_CAP) { atomicAdd(&bar[XB_TMO], 1u); break; } }
    }
    nloc = mine > 0u ? mine : 1u; nx = cnt > 0u ? cnt : 1u;
}

__device__ __forceinline__ void xcd_barrier(const XcdBarrier& b) {
    asm volatile("s_waitcnt vmcnt(0)" ::: "memory");
    __syncthreads();
    if (threadIdx.x == 0) {
        unsigned* bar = b.bar;
        __builtin_amdgcn_s_waitcnt(0);
        unsigned nloc = b.st[0], nx = b.st[1];
        if (nloc == 0u) { xcd_barrier_complete(bar, b.x, nloc, nx); b.st[0] = nloc; b.st[1] = nx; }
        const unsigned old = xb_add(&bar[XB_XSUB(b.x)], 1u);
        const unsigned gen = old / nloc;
        if (old + 1u == (gen + 1u) * nloc) {
            __builtin_amdgcn_fence(__ATOMIC_RELEASE, "agent");
            asm volatile("s_waitcnt vmcnt(0)" ::: "memory");
            const unsigned og = xb_add(&bar[XB_TOP], 1u);
            const unsigned tg = og / nx;
            if (og + 1u == (tg + 1u) * nx) xb_add(&bar[XB_TOPGEN], 1u);
            else XB_SPIN(xb_ld(&bar[XB_TOPGEN]) == tg, bar);
            __builtin_amdgcn_fence(__ATOMIC_ACQUIRE, "agent");
            xb_add(&bar[XB_XGEN(b.x)], 1u);
            asm volatile("s_waitcnt vmcnt(0)" ::: "memory");
        } else {
            XB_SPIN(xb_ld(&bar[XB_XGEN(b.x)]) == gen, bar);
            __builtin_amdgcn_fence(__ATOMIC_ACQUIRE, "agent");
            asm volatile("s_waitcnt vmcnt(0)" ::: "memory");
        }
    }
    __syncthreads();
}

struct Args {
    const float* in[21]; float* out; unsigned char* ws; int ph_lo, ph_hi;
};
enum { I_X = 0, I_MEM, I_GMIX, I_WIN, I_BGATE, I_GQ, I_GK, I_WATTN, I_POOLW, I_PSCALE, I_WPOOL, I_WOUT, I_GCROSS, I_GMEM, I_WXQ, I_WXKV, I_WXO, I_GFFN, I_WFF1, I_WFF2, I_GFINAL };
constexpr int N_PHASES = 12;

__global__ void __launch_bounds__(NWAVES * 64, 2) mega_fwd(Args args) {
    extern __shared__ __attribute__((aligned(16))) unsigned char lds[];
    LAS unsigned char* ldsp = (LAS unsigned char*)lds;
    LAS float* xch = (LAS float*)(ldsp + XCH_OFF);
    const int tid = threadIdx.x, lane = tid & 63, wave = __builtin_amdgcn_readfirstlane(tid >> 6);
    const int G = gridDim.x; const int bx = blockIdx.x;
    const int vcu = (G % 8 == 0) ? (bx % 8) * (G / 8) + bx / 8 : bx;
    unsigned char* ws = args.ws;
    const int lo = args.ph_lo, hi = args.ph_hi;
    bf16* Win_t = (bf16*)(ws + WS_WIN); bf16* Wxkv_t = (bf16*)(ws + WS_WXKV); bf16* Wcat_t = (bf16*)(ws + WS_WCAT); bf16* Wout_t = (bf16*)(ws + WS_WOUT);
    bf16* Wxq_t = (bf16*)(ws + WS_WXQ); bf16* Wxo_t = (bf16*)(ws + WS_WXO); bf16* Wff1_t = (bf16*)(ws + WS_WFF1); bf16* Wff2_t = (bf16*)(ws + WS_WFF2);
    float* ROPE = (float*)(ws + WS_ROPE); float* SS = (float*)(ws + WS_SS);
    bf16* MNb = (bf16*)(ws + WS_MN); bf16* XK = (bf16*)(ws + WS_XK); bf16* XVT = (bf16*)(ws + WS_XVT); bf16* HB = (bf16*)(ws + WS_HB);
    bf16* N1 = (bf16*)(ws + WS_R1); bf16* AP = (bf16*)(ws + WS_R1); bf16* Pm = (bf16*)(ws + WS_R1);
    bf16* Qb = (bf16*)(ws + WS_R2); bf16* Kb = (bf16*)(ws + WS_R2 + 32 * MiB); bf16* Vb = (bf16*)(ws + WS_R2 + 40 * MiB); bf16* MIX = (bf16*)(ws + WS_R2); bf16* XO = (bf16*)(ws + WS_R2);
    bf16* Ub = (bf16*)(ws + WS_R3); bf16* XQ = (bf16*)(ws + WS_R3);
    bf16* Gt = (bf16*)(ws + WS_G); bf16* Fb = (bf16*)(ws + WS_F);
    float* OUT = args.out;

    volatile LAS unsigned* MISC = (volatile LAS unsigned*)(ldsp + MISC_OFF);
    if (tid < 32) MISC[tid] = 0u;
    __syncthreads();
    XcdBarrier bar; bar.bar = (unsigned*)(ws + WS_CTL); bar.x = 0; bar.st = nullptr;
    if (!MK_PER_PHASE) bar = xcd_barrier_post((unsigned*)(ws + WS_CTL), MISC + 8);
    if (hi > 1000) cg::this_grid().sync();
#ifndef PHASE_MASK
#define PHASE_MASK 0xFFF
#endif
#define IN(k) (((PHASE_MASK >> (k)) & 1) && lo <= (k) && (k) < hi)
#ifndef REPEAT_MASK
#define REPEAT_MASK 0
#endif
#ifndef EXTRA_SYNCS
#define EXTRA_SYNCS 0
#endif
#define PHASE(k) if (IN(k)) _Pragma("unroll") for (int rep_ = 0; rep_ <= ((REPEAT_MASK >> (k)) & 1); ++rep_)
#define REP_SYNC() do { if (rep_) xcd_barrier(bar); } while (0)
#define LOCAL_SEAM(k) do { if (IN(k) && IN((k) + 1)) { asm volatile("s_waitcnt vmcnt(0)" ::: "memory"); __syncthreads(); __builtin_amdgcn_fence(__ATOMIC_ACQUIRE, "agent"); asm volatile("s_waitcnt vmcnt(0)" ::: "memory"); __syncthreads(); } } while (0)
#define SEAM(k) do { if (IN(k) && IN((k) + 1)) { xcd_barrier(bar); } } while (0)
    const int gw = vcu * NWAVES + wave, NGW = G * NWAVES;

    PHASE(0) { REP_SYNC();
        {
            LAS float* T = (LAS float*)ldsp;
            constexpr int B0 = 16 * 13, B1 = 16 * 8, B2 = 8 * 4, B3 = 16 * 4, B4 = 16 * 4, B5 = 16 * 4, B6 = 16 * 16, B7 = 64 * 4;
            constexpr int NBLK = B0 + B1 + B2 + B3 + B4 + B5 + B6 + B7;
            for (int bi = vcu; bi < NBLK; bi += G) {
                int r = bi;
                if (r < B0) { p0_transpose_block(args.in[I_WIN], INW, Win_t, 1024, T, (r / 13) * 64, (r % 13) * 256, tid, nullptr); continue; } r -= B0;
                if (r < B1) { p0_transpose_block(args.in[I_WXKV], 2048, Wxkv_t, 1024, T, (r >> 3) * 64, (r & 7) * 256, tid, nullptr); continue; } r -= B1;
                if (r < B2) { p0_transpose_block(args.in[I_WATTN], 1024, Wcat_t, 1024, T, (r >> 2) * 64, (r & 3) * 256, tid, nullptr); continue; } r -= B2;
                if (r < B3) { p0_transpose_block(args.in[I_WOUT], 1024, Wout_t, 1024, T, (r >> 2) * 64, (r & 3) * 256, tid, nullptr); continue; } r -= B3;
                if (r < B4) { p0_transpose_block(args.in[I_WXQ], 1024, Wxq_t, 1024, T, (r >> 2) * 64, (r & 3) * 256, tid, args.in[I_GCROSS]); continue; } r -= B4;
                if (r < B5) { p0_transpose_block(args.in[I_WXO], 1024, Wxo_t, 1024, T, (r >> 2) * 64, (r & 3) * 256, tid, nullptr); continue; } r -= B5;
                if (r < B6) { p0_transpose_block(args.in[I_WFF1], 4096, Wff1_t, 1024, T, (r >> 4) * 64, (r & 15) * 256, tid, args.in[I_GFFN]); continue; } r -= B6;
                p0_transpose_block(args.in[I_WFF2], 1024, Wff2_t, 4096, T, (r >> 2) * 64, (r & 3) * 256, tid, nullptr);
            }
        }
        for (int r = gw; r < 2048; r += NGW) {
                const int g = r >> 9, cb = (r >> 4) & 31, nb = r & 15, n = nb * 64 + lane, c0 = cb * 4;
                const float* pw = args.in[I_POOLW] + (size_t)g * 128 * 128 + (size_t)c0 * 128; const float* ps = args.in[I_PSCALE] + g * 128; const float* wp = args.in[I_WPOOL] + (size_t)g * 128 * 1024 + n;
                float a[4];
#pragma unroll
                for (int cc = 0; cc < 4; ++cc) a[cc] = 0.f;
                for (int d0 = 0; d0 < 128; d0 += 32) { float w[32];
#pragma unroll
                    for (int dd = 0; dd < 32; ++dd) w[dd] = wp[(size_t)(d0 + dd) * 1024];
#pragma unroll
                    for (int dd = 0; dd < 32; ++dd) { const float ws_ = w[dd] * ps[d0 + dd];
#pragma unroll
                        for (int cc = 0; cc < 4; ++cc) a[cc] += pw[cc * 128 + d0 + dd] * ws_; } }
                *(unsigned long long*)(Wcat_t + (size_t)n * 1024 + 512 + g * 128 + c0) = (unsigned long long)pk2(a[0], a[1]) | ((unsigned long long)pk2(a[2], a[3]) << 32);
        }
        {
            const int gt = vcu * NWAVES * 64 + tid;
            if (gt < 1024) { const int pos = gt >> 4, f = gt & 15; const float inv = exp2f(-(float)f * (13.287712379549449f / 16.0f));
                const float ang = (float)pos * inv; float rev = ang * 0.15915494309189535f; rev -= floorf(rev);
                ROPE[gt] = __builtin_amdgcn_cosf(rev); ROPE[1024 + gt] = __builtin_amdgcn_sinf(rev); }
        }
        for (int m4 = gw; m4 < (TOK + MTOK) / 4; m4 += NGW) { const int m = m4 * 4;
            if (m < TOK) rms_rows_to_bf16<4>(args.in[I_X] + (size_t)m * DM, args.in[I_GMIX], N1 + (size_t)m * DM, lane);
            else rms_rows_to_bf16<4>(args.in[I_MEM] + (size_t)(m - TOK) * DM, args.in[I_GMEM], MNb + (size_t)(m - TOK) * DM, lane);
        }
    }
    SEAM(0);

    PHASE(1) { REP_SYNC();
        typedef pg8::ProbP1<(long)WS_R1, (long)WS_WIN, (long)WS_MN, (long)WS_WXKV> P1; P1 S; S.ws = (const char*)ws; S.G = G; S.c = bx; S.K = 1024; S.lda = 1024; S.ldb = 1024; S.mid = -1;
        pg8::EpiP1 E{Qb, Kb, Vb, Ub, Gt, XK, XVT, args.in[I_BGATE], args.in[I_GQ], args.in[I_GK], ROPE};
        pg8::gemm_phase<pg8::EpiP1, P1, true, true>(ldsp, xch, S, E);
    }
    SEAM(1);

    PHASE(2) { REP_SYNC();
        attn_body::attn_phase((char*)lds, (const attn_body::bf16*)Qb, (const attn_body::bf16*)Kb, (const attn_body::bf16*)Vb, (attn_body::bf16*)AP, vcu, G);
        const int grp = lane >> 4, hw = 1 << grp;
        for (int ch = gw; ch < TOK / 16; ch += NGW) {
            const int t0 = ch * 16, s0 = t0 & (SEQ - 1);
            const bf16* ub = Ub + (size_t)(t0 - s0) * 512 + lane * 8;
            float a[8];
#pragma unroll
            for (int j = 0; j < 8; ++j) a[j] = 0.f;
#pragma unroll
            for (int k = 0; k < 16; ++k) { const int r = s0 - hw + k;
                if (k < 2 * hw && r >= 0 && r < SEQ) { const v4u w = *(const v4u*)(ub + (size_t)r * 512);
                    a[0] += pg8::bf_lo(w.x); a[1] += pg8::bf_hi(w.x); a[2] += pg8::bf_lo(w.y); a[3] += pg8::bf_hi(w.y); a[4] += pg8::bf_lo(w.z); a[5] += pg8::bf_hi(w.z); a[6] += pg8::bf_lo(w.w); a[7] += pg8::bf_hi(w.w); } }
#pragma unroll 4
            for (int i = 0; i < 16; ++i) { const int s = s0 + i; const int lo_s = max(s - hw, 0), hi_s = min(s + hw, SEQ);
                const v4u w = *(const v4u*)(ub + (size_t)s * 512); const float ic = 1.0f / (float)(hi_s - lo_s);
                v4u o; o.x = pk2(a[0] * ic - pg8::bf_lo(w.x), a[1] * ic - pg8::bf_hi(w.x)); o.y = pk2(a[2] * ic - pg8::bf_lo(w.y), a[3] * ic - pg8::bf_hi(w.y));
                o.z = pk2(a[4] * ic - pg8::bf_lo(w.z), a[5] * ic - pg8::bf_hi(w.z)); o.w = pk2(a[6] * ic - pg8::bf_lo(w.w), a[7] * ic - pg8::bf_hi(w.w));
                *(v4u*)(AP + (size_t)(t0 + i) * 1024 + 512 + lane * 8) = o;
                if (s + hw < SEQ) { const v4u p = *(const v4u*)(ub + (size_t)(s + hw) * 512);
                    a[0] += pg8::bf_lo(p.x); a[1] += pg8::bf_hi(p.x); a[2] += pg8::bf_lo(p.y); a[3] += pg8::bf_hi(p.y); a[4] += pg8::bf_lo(p.z); a[5] += pg8::bf_hi(p.z); a[6] += pg8::bf_lo(p.w); a[7] += pg8::bf_hi(p.w); }
                if (s - hw >= 0) { const v4u q = *(const v4u*)(ub + (size_t)(s - hw) * 512);
                    a[0] -= pg8::bf_lo(q.x); a[1] -= pg8::bf_hi(q.x); a[2] -= pg8::bf_lo(q.y); a[3] -= pg8::bf_hi(q.y); a[4] -= pg8::bf_lo(q.z); a[5] -= pg8::bf_hi(q.z); a[6] -= pg8::bf_lo(q.w); a[7] -= pg8::bf_hi(q.w); }
            }
        }
    }
    SEAM(2);

    PHASE(3) { REP_SYNC();
        pg8::ProbMN S = pg8::make_plain(AP, Wcat_t, TOK, 1024, 1024, G, bx); S.mid = 8;
        pg8::EpiMix E{Gt, MIX};
        pg8::gemm_phase<pg8::EpiMix, pg8::ProbMN, true, true>(ldsp, xch, S, E);
    }
    SEAM(3);

    PHASE(4) { REP_SYNC();
        pg8::ProbMN S = pg8::make_plain(MIX, Wout_t, TOK, 1024, 1024, G, bx);
        pg8::EpiRes<0> E{args.in[I_X], HB, SS};
        pg8::gemm_phase<pg8::EpiRes<0>, pg8::ProbMN, true, true>(ldsp, xch, S, E);
    }
    SEAM(4);

    PHASE(5) { REP_SYNC();
        pg8::ProbMN S = pg8::make_plain(HB, Wxq_t, TOK, 1024, 1024, G, bx);
        pg8::EpiRowScale<0> E{SS, XQ, 1024, XSCALE};
        pg8::gemm_phase<pg8::EpiRowScale<0>, pg8::ProbMN, true, true>(ldsp, xch, S, E);
    }
    SEAM(5);

    PHASE(6) { REP_SYNC();
        pg8::ProbMN S; S.A = XQ; S.B = XK; S.nM = TOK / 256; S.nN = 4; S.G = G; S.c = bx; S.K = 256; S.lda = 1024; S.ldb = 1024; S.mid = -1;
        S.a_pm = 256L * 1024; S.a_pn = 256; S.b_pb = 256L * 1024; S.b_pn = 256;
        pg8::EpiSoftmax E{Pm};
        pg8::gemm_phase<pg8::EpiSoftmax, pg8::ProbMN, true, true>(ldsp, xch, S, E);
    }
    SEAM(6);

    PHASE(7) { REP_SYNC();
        pg8::ProbMN S; S.A = Pm; S.B = XVT; S.nM = TOK / 256; S.nN = 4; S.G = G; S.c = bx; S.K = 256; S.lda = 1024; S.ldb = 4096; S.mid = -1;
        S.a_pm = 256L * 1024; S.a_pn = 256; S.b_pb = 256; S.b_pn = 256L * 4096;
        pg8::EpiPlain E{XO, 1024};
        pg8::gemm_phase<pg8::EpiPlain, pg8::ProbMN, true, true>(ldsp, xch, S, E);
    }
    SEAM(7);

    PHASE(8) { REP_SYNC();
        pg8::ProbMN S = pg8::make_plain(XO, Wxo_t, TOK, 1024, 1024, G, bx);
        pg8::EpiRes<1> E{nullptr, HB, SS};
        pg8::gemm_phase<pg8::EpiRes<1>, pg8::ProbMN, true, true>(ldsp, xch, S, E);
    }
    SEAM(8);

    PHASE(9) { REP_SYNC();
        pg8::ProbMN S = pg8::make_plain(HB, Wff1_t, TOK, 4096, 1024, G, bx);
        pg8::EpiRowScale<1> E{SS, Fb, 4096, 1.0f};
        pg8::gemm_phase<pg8::EpiRowScale<1>, pg8::ProbMN, true, true>(ldsp, xch, S, E);
    }
    SEAM(9);

    PHASE(10) { REP_SYNC();
        pg8::ProbMN S = pg8::make_plain(Fb, Wff2_t, TOK, 1024, 4096, G, bx);
        pg8::EpiRes<1> E{nullptr, HB, SS};
        pg8::gemm_phase<pg8::EpiRes<1>, pg8::ProbMN, true, true>(ldsp, xch, S, E);
    }
    SEAM(10);

    PHASE(11) { REP_SYNC();
        const f32x4* gf = (const f32x4*)args.in[I_GFINAL];
        const f32x4 g0 = gf[2 * lane], g1 = gf[2 * lane + 1], g2 = gf[128 + 2 * lane], g3 = gf[128 + 2 * lane + 1];
        for (int m4 = gw; m4 < TOK / 4; m4 += NGW) { const int m = m4 * 4;
            v4u w0[4], w1[4]; float sp[4];
#pragma unroll
            for (int r = 0; r < 4; ++r) { const bf16* hr = HB + (size_t)(m + r) * DM + lane * 8; w0[r] = *(const v4u*)hr; w1[r] = *(const v4u*)(hr + 512); sp[r] = (lane < 16) ? SS[(size_t)(m + r) * 16 + lane] : 0.f; }
#pragma unroll
            for (int r = 0; r < 4; ++r) { const float rs = 1.0f / sqrtf(wave_sum(sp[r]) * (1.f / 1024.f) + EPS);
                f32x4* orow = (f32x4*)(OUT + (size_t)(m + r) * DM) + 2 * lane;
                orow[0] = (f32x4){pg8::bf_lo(w0[r].x), pg8::bf_hi(w0[r].x), pg8::bf_lo(w0[r].y), pg8::bf_hi(w0[r].y)} * rs * g0;
                orow[1] = (f32x4){pg8::bf_lo(w0[r].z), pg8::bf_hi(w0[r].z), pg8::bf_lo(w0[r].w), pg8::bf_hi(w0[r].w)} * rs * g1;
                orow[128] = (f32x4){pg8::bf_lo(w1[r].x), pg8::bf_hi(w1[r].x), pg8::bf_lo(w1[r].y), pg8::bf_hi(w1[r].y)} * rs * g2;
                orow[129] = (f32x4){pg8::bf_lo(w1[r].z), pg8::bf_hi(w1[r].z), pg8::bf_lo(w1[r].w), pg8::bf_hi(w1[r].w)} * rs * g3; }
        }
    }
    for (int e_ = 0; e_ < EXTRA_SYNCS; ++e_) xcd_barrier(bar);
#undef IN
#undef SEAM
#undef LOCAL_SEAM
}

extern "C" void kernel_launch(void* const* d_in, const int* in_sizes, int n_in, void* d_out, int out_size, void* d_ws, size_t ws_size, hipStream_t stream) {
    static int grid = 0;
    if (grid == 0) {
        if (n_in != 21 || in_sizes[0] != TOK * DM || out_size != TOK * DM || ws_size < WS_END) {
            fprintf(stderr, "kernel_launch: unexpected shapes: n_in %d in0 %d out %d ws %zu (need >= %zu)\n", n_in, n_in > 0 ? in_sizes[0] : -1, out_size, ws_size, (size_t)WS_END); grid = -1; return; }
        int dev = 0, cus = 0, per_cu = 0;
        if (hipGetDevice(&dev) != hipSuccess || hipDeviceGetAttribute(&cus, hipDeviceAttributeMultiprocessorCount, dev) != hipSuccess) { grid = -1; return; }
        if (hipFuncSetAttribute((const void*)mega_fwd, hipFuncAttributeMaxDynamicSharedMemorySize, LDS_BYTES) != hipSuccess) { fprintf(stderr, "kernel_launch: hipFuncSetAttribute failed\n"); grid = -1; return; }
        if (hipOccupancyMaxActiveBlocksPerMultiprocessor(&per_cu, (const void*)mega_fwd, NWAVES * 64, LDS_BYTES) != hipSuccess || per_cu < 1) { fprintf(stderr, "kernel_launch: occupancy query says %d\n", per_cu); per_cu = 1; }
        (void)hipGetLastError();
        grid = cus * per_cu;
    }
    if (grid < 0) return;
    if (hipMemsetAsync((char*)d_ws + WS_CTL, 0, CTL_ZERO_BYTES, stream) != hipSuccess) { fprintf(stderr, "kernel_launch: memset failed\n"); return; }
    Args a{};
    for (int i = 0; i < 21; ++i) a.in[i] = (const float*)d_in[i];
    a.out = (float*)d_out; a.ws = (unsigned char*)d_ws;
#if MK_PER_PHASE
    for (int p = 0; p < N_PHASES; ++p) { a.ph_lo = p; a.ph_hi = p + 1; hipLaunchKernelGGL(mega_fwd, dim3(grid), dim3(NWAVES * 64), LDS_BYTES, stream, a); }
#else
    a.ph_lo = 0; a.ph_hi = N_PHASES;
    void* kargs[] = {&a};
    hipError_t e = hipLaunchCooperativeKernel((const void*)mega_fwd, dim3(grid), dim3(NWAVES * 64), kargs, LDS_BYTES, stream);
    if (e != hipSuccess) fprintf(stderr, "kernel_launch: cooperative launch failed: %s (grid %d)\n", hipGetErrorString(e), grid);
#endif
}
```

```cpp
#include <hip/hip_runtime.h>
#include <hip/hip_cooperative_groups.h>
#include <hip/hip_bf16.h>
#include <cstdio>
#include <cstdint>
#include <cmath>
namespace cg = cooperative_groups;

#ifndef MK_PER_PHASE
#define MK_PER_PHASE 0
#endif

constexpr int DM = 1024, NB = 16, SEQ = 2048, TOK = NB * SEQ, NMEM = 256, MTOK = NB * NMEM;
constexpr int INW = 3328, DFF = 4096;
constexpr float EPS = 1e-6f;
constexpr float LOG2E = 1.4426950408889634f;
constexpr float QSCALE = 0.125f * LOG2E;
constexpr float XSCALE = 0.0625f * LOG2E;

namespace pg8 {
#define PG8_LAS __attribute__((address_space(3)))
typedef unsigned short bf16_t;
typedef short bf16x8 __attribute__((ext_vector_type(8)));
typedef float f32x4 __attribute__((ext_vector_type(4)));
typedef float f32x2 __attribute__((ext_vector_type(2)));
typedef unsigned u32x4 __attribute__((ext_vector_type(4)));
typedef unsigned u32x2 __attribute__((ext_vector_type(2)));
typedef __bf16 bf16x2_t __attribute__((ext_vector_type(2)));
constexpr int BM = 256, BK = 64, HALF = 128, HTB = HALF * BK * 2, STAGE_BYTES = 8 * HTB, NXCD = 8, WGM = 4;

__host__ __device__ __forceinline__ int lds_byte(int r, int c) { const int st = (r >> 4) * 2 + (c >> 5), rr = r & 15, cc = c & 31, ob = rr * 64 + cc * 2; return st * 1024 + (ob ^ (((ob >> 9) & 1) << 5)); }
__host__ __device__ __forceinline__ void stage_rc(int b, int& R, int& C) { const int st = b / 1024, sb = b % 1024, swz = sb ^ (((sb >> 9) & 1) << 5); R = (st >> 1) * 16 + swz / 64; C = (st & 1) * 32 + (swz % 64) / 2; }
__host__ __device__ __forceinline__ int perm32(int rho) { const int n = rho >> 4, i = rho & 15; return 8 * (i >> 2) + 4 * n + (i & 3); }

struct Unit { int pm, pn, id; };
#define PG8_OPAQUE(x) asm volatile("" : "+v"(x))

__device__ __forceinline__ unsigned pk_bf16(float lo, float hi) { f32x2 v = {lo, hi}; bf16x2_t b = __builtin_convertvector(v, bf16x2_t); return __builtin_bit_cast(unsigned, b); }
__device__ __forceinline__ float bf_lo(unsigned w) { return __uint_as_float(w << 16); }
__device__ __forceinline__ float bf_hi(unsigned w) { return __uint_as_float(w & 0xffff0000u); }
#define PG8_FENCE() asm volatile("" ::: "memory")

__device__ __forceinline__ void remap_tile(int wgid, int nM, int nN, int& pm, int& pn) {
    const int nwg = nM * nN;
    { const int q = nwg / NXCD, r = nwg % NXCD, xcd = wgid % NXCD, off = wgid / NXCD; wgid = (xcd < r ? xcd * (q + 1) : r * (q + 1) + (xcd - r) * q) + off; }
    const int nig = WGM * nN, gid = wgid / nig, fm = gid * WGM, gsz = (nM - fm) < WGM ? (nM - fm) : WGM;
    pm = fm + ((wgid % nig) % gsz); pn = (wgid % nig) / gsz;
}

struct ProbMN {
    const bf16_t* A; const bf16_t* B; int nM, nN, G, c; int K, lda, ldb, mid; long a_pm, a_pn, b_pb, b_pn;
    __device__ __forceinline__ bool next(int i, Unit& u) const {
        const long L = (long)i * G + c; if (L >= (long)nM * nN) return false;
        remap_tile((int)L, nM, nN, u.pm, u.pn); u.id = 0; return true; }
    __device__ __forceinline__ const char* aptr(const Unit& u) const { return (const char*)(A + (size_t)u.pm * a_pm + (size_t)u.pn * a_pn); }
    __device__ __forceinline__ const char* bptr(const Unit& u) const { return (const char*)(B + (size_t)(u.pm >> 3) * b_pb + (size_t)u.pn * b_pn); }
};
__device__ __forceinline__ ProbMN make_plain(const bf16_t* A, const bf16_t* Bt, int M, int N, int K, int G, int c) {
    ProbMN p; p.A = A; p.B = Bt; p.nM = M / BM; p.nN = N / BM; p.G = G; p.c = c; p.K = K; p.lda = K; p.ldb = K; p.mid = -1;
    p.a_pm = (long)BM * K; p.a_pn = 0; p.b_pb = 0; p.b_pn = (long)BM * K; return p; }

template <long OFF_N1, long OFF_WIN, long OFF_MN, long OFF_WXKV> struct ProbP1 {
    const char* ws; int G, c; int K, lda, ldb, mid;
    static constexpr int NPROJ = 128 * 13, NXKV = 128;
    __device__ __forceinline__ bool next(int i, Unit& u) const {
        const int L = i * G + c; if (L >= NPROJ + NXKV) return false;
        if (L < NPROJ) { remap_tile(L, 128, 13, u.pm, u.pn); u.id = 0; }
        else { const int e = L - NPROJ; u.pm = e >> 3; u.pn = e & 7; u.id = 1; }
        return true; }
    __device__ __forceinline__ const char* aptr(const Unit& u) const { const long off = u.id == 0 ? OFF_N1 : OFF_MN; return ws + off + (long)u.pm * (256 * 1024 * 2); }
    __device__ __forceinline__ const char* bptr(const Unit& u) const { const long off = u.id == 0 ? OFF_WIN : OFF_WXKV; return ws + off + (long)u.pn * (256 * 1024 * 2); }
};
struct ProbKW {
    const bf16_t* XKV; const bf16_t* WqB; int G, c; int K, lda, ldb, mid;
    __device__ __forceinline__ bool next(int i, Unit& u) const { const int L = i * G + c; if (L >= 256) return false; u.pm = L >> 4; u.pn = L & 15; u.id = 0; return true; }
    __device__ __forceinline__ const char* aptr(const Unit& u) const { return (const char*)(XKV + (size_t)u.pm * 256 * 2048 + (u.pn >> 2) * 256); }
    __device__ __forceinline__ const char* bptr(const Unit& u) const { return (const char*)(WqB + (size_t)(u.pn & 3) * 256 * 1024 + (u.pn >> 2) * 256); }
};
struct ProbVW {
    const bf16_t* Wxo_t; const bf16_t* XKV; int G, c; int K, lda, ldb, mid;
    __device__ __forceinline__ bool next(int i, Unit& u) const { const int L = i * G + c; if (L >= 256) return false; u.pm = L >> 6; u.pn = L & 63; u.id = 0; return true; }
    __device__ __forceinline__ const char* aptr(const Unit& u) const { return (const char*)(Wxo_t + (size_t)u.pm * 256 * 1024 + (u.pn & 3) * 256); }
    __device__ __forceinline__ const char* bptr(const Unit& u) const { return (const char*)(XKV + (size_t)(u.pn >> 2) * 256 * 2048 + 1024 + (u.pn & 3) * 256); }
};

typedef f32x4 Acc[2][2][4][2];

__device__ __forceinline__ void store_tile_bf16_np(const Acc& acc, bf16_t* base, int ldc, int wr, int wc, int fr, int fq) {
#pragma unroll
    for (int ai = 0; ai < 2; ++ai)
#pragma unroll
        for (int m = 0; m < 4; ++m) { bf16_t* rowp = base + (size_t)(ai * HALF + wr * 64 + m * 16 + fr) * ldc + wc * 32 + 4 * fq;
#pragma unroll
            for (int bj = 0; bj < 2; ++bj)
#pragma unroll
                for (int n = 0; n < 2; ++n) { const f32x4 v = acc[ai][bj][m][n]; u32x2 w; w.x = pk_bf16(v[0], v[1]); w.y = pk_bf16(v[2], v[3]); *(u32x2*)(rowp + bj * HALF + n * 16) = w; } }
}

struct EpiP1 {
    static constexpr bool PERM = false, AFTER_DRAIN = false, HAS_MID = false;
    bf16_t *Q, *Kb, *Vb, *U, *Gt, *XKV; const float *bgate, *gq, *gk, *rope;
    __device__ __forceinline__ void mid(Acc&, const Unit&, int, int, int, int) const {}
    __device__ __forceinline__ void qk_rope(Acc& acc, const Unit& u, int wr, int wc, int fr, int fq, PG8_LAS float* xch, int wid, int bj, const float* gain, float oscale, bf16_t* out, int ldo, int ocol0) const {
#pragma unroll
        for (int ai = 0; ai < 2; ++ai)
#pragma unroll
            for (int m = 0; m < 4; ++m) {
                const f32x4 a = acc[ai][bj][m][0], b = acc[ai][bj][m][1];
                float s = (a[0] * a[0] + a[1] * a[1]) + (a[2] * a[2] + a[3] * a[3]) + (b[0] * b[0] + b[1] * b[1]) + (b[2] * b[2] + b[3] * b[3]);
                s += __shfl_xor(s, 16); s += __shfl_xor(s, 32);
                if (fq == 0) xch[wid * 128 + (ai * 4 + m) * 16 + fr] = s;
            }
        asm volatile("s_waitcnt lgkmcnt(0)" ::: "memory"); __builtin_amdgcn_s_barrier(); PG8_FENCE();
        const int axis = wc & 1;
        const int d0 = axis * 32 + 4 * fq;
        const f32x4 g0 = *(const f32x4*)(gain + d0), g1 = *(const f32x4*)(gain + d0 + 16);
        const int gridrow0 = (u.pm & 7) * 4 + wr;
#pragma unroll
        for (int ai = 0; ai < 2; ++ai)
#pragma unroll
            for (int m = 0; m < 4; ++m) {
                const int xi = (ai * 4 + m) * 16 + fr;
                const float tot = xch[wid * 128 + xi] + xch[(wid ^ 1) * 128 + xi];
                const float rs = __builtin_amdgcn_rsqf(tot * (1.0f / 64.0f) + EPS) ;
                const int pos = axis ? (m * 16 + fr) : (gridrow0 + 2 * ai);
                const f32x4 cs = *(const f32x4*)(rope + pos * 16 + 4 * fq), sn = *(const f32x4*)(rope + 1024 + pos * 16 + 4 * fq);
                const f32x4 x0 = acc[ai][bj][m][0] * rs * g0, x1 = acc[ai][bj][m][1] * rs * g1;
                const f32x4 y0 = (x0 * cs - x1 * sn) * oscale, y1 = (x1 * cs + x0 * sn) * oscale;
                bf16_t* rowp = out + (size_t)(u.pm * BM + ai * HALF + wr * 64 + m * 16 + fr) * ldo + ocol0 + wc * 32 + 4 * fq;
                u32x2 w0, w1; w0.x = pk_bf16(y0[0], y0[1]); w0.y = pk_bf16(y0[2], y0[3]); w1.x = pk_bf16(y1[0], y1[1]); w1.y = pk_bf16(y1[2], y1[3]);
                *(u32x2*)(rowp) = w0; *(u32x2*)(rowp + 16) = w1;
            }
        asm volatile("s_waitcnt lgkmcnt(0)" ::: "memory"); __builtin_amdgcn_s_barrier(); PG8_FENCE();
    }
    __device__ __forceinline__ void operator()(Acc& acc, const Unit& u, int wr, int wc, int fr, int fq, PG8_LAS float* xch, int wid) const { PG8_OPAQUE(fr);
        if (u.id == 0) {
            if (u.pn < 2) {
                qk_rope(acc, u, wr, wc, fr, fq, xch, wid, 0, gq, QSCALE, Q, 512, u.pn * 256);
                qk_rope(acc, u, wr, wc, fr, fq, xch, wid, 1, gq, QSCALE, Q, 512, u.pn * 256 + 128);
            } else if (u.pn == 2) {
                qk_rope(acc, u, wr, wc, fr, fq, xch, wid, 0, gk, 1.0f, Kb, 128, 0);
#pragma unroll
                for (int ai = 0; ai < 2; ++ai)
#pragma unroll
                    for (int m = 0; m < 4; ++m) { bf16_t* rowp = Vb + (size_t)(u.pm * BM + ai * HALF + wr * 64 + m * 16 + fr) * 128 + wc * 32 + 4 * fq;
#pragma unroll
                        for (int n = 0; n < 2; ++n) { const f32x4 v = acc[ai][1][m][n]; u32x2 w; w.x = pk_bf16(v[0], v[1]); w.y = pk_bf16(v[2], v[3]); *(u32x2*)(rowp + n * 16) = w; } }
            } else if (u.pn < 5) {
                store_tile_bf16_np(acc, U + (size_t)u.pm * BM * 512 + (u.pn - 3) * 256, 512, wr, wc, fr, fq);
            } else {
                const int gc0 = (u.pn - 5) * 256 + wc * 32 + 4 * fq;
                f32x4 bv[2][2];
#pragma unroll
                for (int bj = 0; bj < 2; ++bj)
#pragma unroll
                    for (int n = 0; n < 2; ++n) bv[bj][n] = *(const f32x4*)(bgate + gc0 + bj * HALF + n * 16);
#pragma unroll
                for (int ai = 0; ai < 2; ++ai)
#pragma unroll
                    for (int m = 0; m < 4; ++m) { bf16_t* rowp = Gt + (size_t)(u.pm * BM + ai * HALF + wr * 64 + m * 16 + fr) * 2048 + gc0;
#pragma unroll
                        for (int bj = 0; bj < 2; ++bj)
#pragma unroll
                            for (int n = 0; n < 2; ++n) { f32x4 z = acc[ai][bj][m][n] + bv[bj][n]; f32x4 s;
#pragma unroll
                                for (int j = 0; j < 4; ++j) { const float zz = fminf(fmaxf(z[j], -30.f), 30.f); s[j] = __builtin_amdgcn_rcpf(1.0f + __builtin_amdgcn_exp2f(-zz * LOG2E)); }
                                u32x2 w; w.x = pk_bf16(s[0], s[1]); w.y = pk_bf16(s[2], s[3]); *(u32x2*)(rowp + bj * HALF + n * 16) = w; }
                        PG8_FENCE(); }
            }
        } else {
            store_tile_bf16_np(acc, XKV + (size_t)u.pm * BM * 2048 + u.pn * 256, 2048, wr, wc, fr, fq);
        }
    }
};

struct EpiMix {
    static constexpr bool PERM = true, AFTER_DRAIN = false, HAS_MID = true;
    const bf16_t* Gt; bf16_t* MIX;
    __device__ __forceinline__ void mid(Acc& acc, const Unit& u, int wr, int wc, int fr, int fq) const { PG8_OPAQUE(fr);
#pragma unroll
        for (int ai = 0; ai < 2; ++ai) {
            u32x4 ga[4][2], gp[4][2];
#pragma unroll
            for (int m = 0; m < 4; ++m) { const bf16_t* grow = Gt + (size_t)(u.pm * BM + ai * HALF + wr * 64 + m * 16 + fr) * 2048 + u.pn * 256 + wc * 32 + 8 * fq;
#pragma unroll
                for (int bj = 0; bj < 2; ++bj) { ga[m][bj] = *(const u32x4*)(grow + bj * HALF); gp[m][bj] = *(const u32x4*)(grow + 1024 + bj * HALF); } }
#pragma unroll
            for (int m = 0; m < 4; ++m)
#pragma unroll
                for (int bj = 0; bj < 2; ++bj) { const u32x4 a = ga[m][bj], p = gp[m][bj];
                    f32x4 r0, r1;
                    r0[0] = bf_lo(a.x) * __builtin_amdgcn_rcpf(bf_lo(p.x)); r0[1] = bf_hi(a.x) * __builtin_amdgcn_rcpf(bf_hi(p.x));
                    r0[2] = bf_lo(a.y) * __builtin_amdgcn_rcpf(bf_lo(p.y)); r0[3] = bf_hi(a.y) * __builtin_amdgcn_rcpf(bf_hi(p.y));
                    r1[0] = bf_lo(a.z) * __builtin_amdgcn_rcpf(bf_lo(p.z)); r1[1] = bf_hi(a.z) * __builtin_amdgcn_rcpf(bf_hi(p.z));
                    r1[2] = bf_lo(a.w) * __builtin_amdgcn_rcpf(bf_lo(p.w)); r1[3] = bf_hi(a.w) * __builtin_amdgcn_rcpf(bf_hi(p.w));
                    acc[ai][bj][m][0] *= r0; acc[ai][bj][m][1] *= r1; }
            PG8_FENCE(); }
    }
    __device__ __forceinline__ void operator()(Acc& acc, const Unit& u, int wr, int wc, int fr, int fq, PG8_LAS float*, int) const { PG8_OPAQUE(fr);
        u32x4 gp[2][4][2];
#pragma unroll
        for (int ai = 0; ai < 2; ++ai)
#pragma unroll
            for (int m = 0; m < 4; ++m) { const bf16_t* grow = Gt + (size_t)(u.pm * BM + ai * HALF + wr * 64 + m * 16 + fr) * 2048 + 1024 + u.pn * 256 + wc * 32 + 8 * fq;
#pragma unroll
                for (int bj = 0; bj < 2; ++bj) gp[ai][m][bj] = *(const u32x4*)(grow + bj * HALF); }
#pragma unroll
        for (int ai = 0; ai < 2; ++ai)
#pragma unroll
            for (int m = 0; m < 4; ++m) { bf16_t* mrow = MIX + (size_t)(u.pm * BM + ai * HALF + wr * 64 + m * 16 + fr) * 1024 + u.pn * 256 + wc * 32 + 8 * fq;
#pragma unroll
                for (int bj = 0; bj < 2; ++bj) { const u32x4 g = gp[ai][m][bj];
                    const f32x4 a = acc[ai][bj][m][0], b = acc[ai][bj][m][1]; u32x4 w;
                    w.x = pk_bf16(a[0] * bf_lo(g.x), a[1] * bf_hi(g.x)); w.y = pk_bf16(a[2] * bf_lo(g.y), a[3] * bf_hi(g.y));
                    w.z = pk_bf16(b[0] * bf_lo(g.z), b[1] * bf_hi(g.z)); w.w = pk_bf16(b[2] * bf_lo(g.w), b[3] * bf_hi(g.w));
                    *(u32x4*)(mrow + bj * HALF) = w; } }
    }
};

template <int MODE> struct EpiRes {
    static constexpr bool PERM = true, AFTER_DRAIN = false, HAS_MID = false;
    const float* basef; bf16_t* HB; float* SS;
    __device__ __forceinline__ void mid(Acc&, const Unit&, int, int, int, int) const {}
    __device__ __forceinline__ void operator()(Acc& acc, const Unit& u, int wr, int wc, int fr, int fq, PG8_LAS float*, int) const { PG8_OPAQUE(fr);
        const int col0 = u.pn * BM + wc * 32 + 8 * fq;
#pragma unroll
        for (int ai = 0; ai < 2; ++ai) {
            f32x4 bf[MODE == 0 ? 4 : 1][2][2]; u32x4 bh[MODE == 1 ? 4 : 1][2];
#pragma unroll
            for (int m = 0; m < 4; ++m) { const size_t off = (size_t)(u.pm * BM + ai * HALF + wr * 64 + m * 16 + fr) * 1024 + col0;
#pragma unroll
                for (int bj = 0; bj < 2; ++bj) {
                    if (MODE == 0) { bf[m][bj][0] = *(const f32x4*)(basef + off + bj * HALF); bf[m][bj][1] = *(const f32x4*)(basef + off + bj * HALF + 4); }
                    else bh[m][bj] = *(const u32x4*)(HB + off + bj * HALF); } }
#pragma unroll
            for (int m = 0; m < 4; ++m) { const size_t row = (size_t)(u.pm * BM + ai * HALF + wr * 64 + m * 16 + fr); const size_t off = row * 1024 + col0; float ss = 0.f;
#pragma unroll
                for (int bj = 0; bj < 2; ++bj) { f32x4 b0, b1;
                    if (MODE == 0) { b0 = bf[m][bj][0]; b1 = bf[m][bj][1]; }
                    else { const u32x4 w = bh[m][bj]; b0 = (f32x4){bf_lo(w.x), bf_hi(w.x), bf_lo(w.y), bf_hi(w.y)}; b1 = (f32x4){bf_lo(w.z), bf_hi(w.z), bf_lo(w.w), bf_hi(w.w)}; }
                    const f32x4 h0 = b0 + acc[ai][bj][m][0], h1 = b1 + acc[ai][bj][m][1];
                    ss += (h0[0] * h0[0] + h0[1] * h0[1]) + (h0[2] * h0[2] + h0[3] * h0[3]) + (h1[0] * h1[0] + h1[1] * h1[1]) + (h1[2] * h1[2] + h1[3] * h1[3]);
                    u32x4 o; o.x = pk_bf16(h0[0], h0[1]); o.y = pk_bf16(h0[2], h0[3]); o.z = pk_bf16(h1[0], h1[1]); o.w = pk_bf16(h1[2], h1[3]);
                    *(u32x4*)(HB + off + bj * HALF) = o; }
                ss += __shfl_xor(ss, 16); ss += __shfl_xor(ss, 32);
                if (fq == 0) SS[row * 16 + u.pn * 4 + wc] = ss; }
            PG8_FENCE(); }
    }
};

template <int ACT> struct EpiRowScale {
    static constexpr bool PERM = true, AFTER_DRAIN = false, HAS_MID = false;
    const float* SS; bf16_t* O; int ldc; float scale;
    __device__ __forceinline__ void mid(Acc&, const Unit&, int, int, int, int) const {}
    __device__ __forceinline__ void operator()(Acc& acc, const Unit& u, int wr, int wc, int fr, int fq, PG8_LAS float*, int) const { PG8_OPAQUE(fr);
        f32x4 p4[2][4]; float rsv[2][4];
#pragma unroll
        for (int ai = 0; ai < 2; ++ai)
#pragma unroll
            for (int m = 0; m < 4; ++m) p4[ai][m] = *(const f32x4*)(SS + (size_t)(u.pm * BM + ai * HALF + wr * 64 + m * 16 + fr) * 16 + 4 * fq);
#pragma unroll
        for (int ai = 0; ai < 2; ++ai)
#pragma unroll
            for (int m = 0; m < 4; ++m) { const f32x4 q = p4[ai][m]; float s = (q[0] + q[1]) + (q[2] + q[3]); s += __shfl_xor(s, 16); s += __shfl_xor(s, 32);
                rsv[ai][m] = __builtin_amdgcn_rsqf(s * (1.0f / 1024.0f) + EPS) * scale; }
#pragma unroll
        for (int ai = 0; ai < 2; ++ai)
#pragma unroll
            for (int m = 0; m < 4; ++m) { const float rs = rsv[ai][m];
                bf16_t* rowp = O + (size_t)(u.pm * BM + ai * HALF + wr * 64 + m * 16 + fr) * ldc + u.pn * 256 + wc * 32 + 8 * fq;
#pragma unroll
                for (int bj = 0; bj < 2; ++bj) { f32x4 a = acc[ai][bj][m][0] * rs, b = acc[ai][bj][m][1] * rs;
                    if (ACT == 1) {
#pragma unroll
                        for (int j = 0; j < 4; ++j) { const float x = fmaxf(a[j], 0.f), y = fmaxf(b[j], 0.f); a[j] = x * x; b[j] = y * y; } }
                    u32x4 w; w.x = pk_bf16(a[0], a[1]); w.y = pk_bf16(a[2], a[3]); w.z = pk_bf16(b[0], b[1]); w.w = pk_bf16(b[2], b[3]);
                    *(u32x4*)(rowp + bj * HALF) = w; } }
    }
};

struct EpiPlain {
    static constexpr bool PERM = true, AFTER_DRAIN = false, HAS_MID = false;
    bf16_t* O; int ldc; long o_pm;
    __device__ __forceinline__ void mid(Acc&, const Unit&, int, int, int, int) const {}
    __device__ __forceinline__ void operator()(Acc& acc, const Unit& u, int wr, int wc, int fr, int fq, PG8_LAS float*, int) const { PG8_OPAQUE(fr);
#pragma unroll
        for (int ai = 0; ai < 2; ++ai)
#pragma unroll
            for (int m = 0; m < 4; ++m) { bf16_t* rowp = O + (size_t)u.pm * o_pm + (size_t)(ai * HALF + wr * 64 + m * 16 + fr) * ldc + u.pn * 256 + wc * 32 + 8 * fq;
#pragma unroll
                for (int bj = 0; bj < 2; ++bj) { const f32x4 a = acc[ai][bj][m][0], b = acc[ai][bj][m][1];
                    u32x4 w; w.x = pk_bf16(a[0], a[1]); w.y = pk_bf16(a[2], a[3]); w.z = pk_bf16(b[0], b[1]); w.w = pk_bf16(b[2], b[3]);
                    *(u32x4*)(rowp + bj * HALF) = w; } }
    }
};

struct EpiSoftmax {
    static constexpr bool PERM = true, AFTER_DRAIN = false, HAS_MID = false;
    bf16_t* P; const float* SS; float scale;
    __device__ __forceinline__ void mid(Acc&, const Unit&, int, int, int, int) const {}
    __device__ __forceinline__ void operator()(Acc& acc, const Unit& u, int wr, int wc, int fr, int fq, PG8_LAS float* xch, int) const { PG8_OPAQUE(fr);
        PG8_LAS float* xmax = xch; PG8_LAS float* xsum = xch + 1024;
        {
            f32x4 p4[2][4];
#pragma unroll
            for (int ai = 0; ai < 2; ++ai)
#pragma unroll
                for (int m = 0; m < 4; ++m) p4[ai][m] = *(const f32x4*)(SS + (size_t)(u.pm * BM + ai * HALF + wr * 64 + m * 16 + fr) * 16 + 4 * fq);
#pragma unroll
            for (int ai = 0; ai < 2; ++ai)
#pragma unroll
                for (int m = 0; m < 4; ++m) { const f32x4 q = p4[ai][m]; float s = (q[0] + q[1]) + (q[2] + q[3]); s += __shfl_xor(s, 16); s += __shfl_xor(s, 32);
                    const float rs = __builtin_amdgcn_rsqf(s * (1.0f / 1024.0f) + EPS) * scale;
#pragma unroll
                    for (int bj = 0; bj < 2; ++bj) { acc[ai][bj][m][0] *= rs; acc[ai][bj][m][1] *= rs; } }
        }
#pragma unroll
        for (int ai = 0; ai < 2; ++ai)
#pragma unroll
            for (int m = 0; m < 4; ++m) { float mx = -INFINITY;
#pragma unroll
                for (int bj = 0; bj < 2; ++bj)
#pragma unroll
                    for (int n = 0; n < 2; ++n) { const f32x4 v = acc[ai][bj][m][n]; mx = fmaxf(mx, fmaxf(fmaxf(v[0], v[1]), fmaxf(v[2], v[3]))); }
                mx = fmaxf(mx, __shfl_xor(mx, 16)); mx = fmaxf(mx, __shfl_xor(mx, 32));
                if (fq == 0) xmax[(ai * HALF + wr * 64 + m * 16 + fr) * 4 + wc] = mx; }
        asm volatile("s_waitcnt lgkmcnt(0)" ::: "memory"); __builtin_amdgcn_s_barrier(); PG8_FENCE();
#pragma unroll
        for (int ai = 0; ai < 2; ++ai)
#pragma unroll
            for (int m = 0; m < 4; ++m) { const int rl = ai * HALF + wr * 64 + m * 16 + fr; const f32x4 m4 = *(const PG8_LAS f32x4*)(xmax + rl * 4);
                const float mx = fmaxf(fmaxf(m4[0], m4[1]), fmaxf(m4[2], m4[3])); float s = 0.f;
#pragma unroll
                for (int bj = 0; bj < 2; ++bj)
#pragma unroll
                    for (int n = 0; n < 2; ++n) { f32x4 v = acc[ai][bj][m][n];
#pragma unroll
                        for (int j = 0; j < 4; ++j) { v[j] = __builtin_amdgcn_exp2f(v[j] - mx); s += v[j]; }
                        acc[ai][bj][m][n] = v; }
                s += __shfl_xor(s, 16); s += __shfl_xor(s, 32);
                if (fq == 0) xsum[rl * 4 + wc] = s; }
        asm volatile("s_waitcnt lgkmcnt(0)" ::: "memory"); __builtin_amdgcn_s_barrier(); PG8_FENCE();
#pragma unroll
        for (int ai = 0; ai < 2; ++ai)
#pragma unroll
            for (int m = 0; m < 4; ++m) { const int rl = ai * HALF + wr * 64 + m * 16 + fr; const f32x4 s4 = *(const PG8_LAS f32x4*)(xsum + rl * 4);
                const float inv = __builtin_amdgcn_rcpf((s4[0] + s4[1]) + (s4[2] + s4[3]));
                bf16_t* rowp = P + (size_t)(u.pm * BM + rl) * 1024 + u.pn * 256 + wc * 32 + 8 * fq;
#pragma unroll
                for (int bj = 0; bj < 2; ++bj) { const f32x4 a = acc[ai][bj][m][0] * inv, b = acc[ai][bj][m][1] * inv;
                    u32x4 w; w.x = pk_bf16(a[0], a[1]); w.y = pk_bf16(a[2], a[3]); w.z = pk_bf16(b[0], b[1]); w.w = pk_bf16(b[2], b[3]);
                    *(u32x4*)(rowp + bj * HALF) = w; } }
        asm volatile("s_waitcnt lgkmcnt(0)" ::: "memory"); __builtin_amdgcn_s_barrier(); PG8_FENCE();
    }
};

template <class Epi, class Sched, bool ALIGN_EPI, bool SP2>
__device__ __forceinline__ void gemm_phase(PG8_LAS unsigned char* lds, PG8_LAS float* xch, const Sched& S, const Epi& E) {
    const int tid = threadIdx.x, wid = __builtin_amdgcn_readfirstlane(tid >> 6), lane = tid & 63, wr = wid >> 2, wc = wid & 3, fr = lane & 15, fq = lane >> 4;
    const int K = S.K, nt = K / BK, lda = S.lda, ldb = S.ldb; (void)K;
    unsigned voffA[2], voffB[2];
#pragma unroll
    for (int i = 0; i < 2; ++i) { int R, C; stage_rc(tid * 16 + i * 8192, R, C); const int Rb = Epi::PERM ? ((R & ~31) + perm32(R & 31)) : R;
        voffA[i] = (unsigned)(R * lda + C) * 2u; voffB[i] = (unsigned)(Rb * ldb + C) * 2u; }
    const size_t kstep = (size_t)(BK * 2);
    const size_t hstepA = (size_t)HALF * lda * 2, hstepB = (size_t)HALF * ldb * 2;
    const unsigned ldsw = (unsigned)wid * 1024u;
    const int aoff = lds_byte(wr * 64 + fr, fq * 8), boff = lds_byte(wc * 32 + fr, fq * 8);
#define PG8_SA(b, h) (((b) * 2 + (h)) * HTB)
#define PG8_SB(b, h) ((4 + (b) * 2 + (h)) * HTB)
#define PG8_STAGE(bufoff, gbase, voff) do { _Pragma("unroll") for (int _i = 0; _i < 2; ++_i) \
        __builtin_amdgcn_global_load_lds((const unsigned*)((const char*)(gbase) + (voff)[_i]), (PG8_LAS unsigned*)(lds + (bufoff) + ldsw + _i * 8192), 16, 0, 0); } while (0)
#define PG8_LDA(dst, b, h) do { _Pragma("unroll") for (int m = 0; m < 4; ++m) _Pragma("unroll") for (int k = 0; k < 2; ++k) dst[m][k] = *(const PG8_LAS bf16x8*)(lds + PG8_SA(b, h) + aoff + m * 2048 + k * 1024); } while (0)
#define PG8_LDB(dst, b, h) do { _Pragma("unroll") for (int n = 0; n < 2; ++n) _Pragma("unroll") for (int k = 0; k < 2; ++k) dst[n][k] = *(const PG8_LAS bf16x8*)(lds + PG8_SB(b, h) + boff + n * 2048 + k * 1024); } while (0)
#define PG8_MMA(ai, bj, At, Bt) do { __builtin_amdgcn_s_setprio(1); _Pragma("unroll") for (int m = 0; m < 4; ++m) _Pragma("unroll") for (int n = 0; n < 2; ++n) _Pragma("unroll") for (int k = 0; k < 2; ++k) \
        acc[ai][bj][m][n] = __builtin_amdgcn_mfma_f32_16x16x32_bf16(Bt[n][k], At[m][k], acc[ai][bj][m][n], 0, 0, 0); __builtin_amdgcn_s_setprio(0); } while (0)
#define PG8_WAIT_V(n) asm volatile("s_waitcnt vmcnt(" #n ")" ::: "memory")
#define PG8_WAIT_L(n) asm volatile("s_waitcnt lgkmcnt(" #n ")" ::: "memory")
#define PG8_BAR __builtin_amdgcn_s_barrier()
#define PG8_SCHED __builtin_amdgcn_sched_barrier(0)
    Unit cur, nxt; int ui = 0;
    if (!S.next(0, cur)) return;
    f32x4 acc[2][2][4][2];
#pragma unroll
    for (int a = 0; a < 2; ++a)
#pragma unroll
        for (int b = 0; b < 2; ++b)
#pragma unroll
            for (int m = 0; m < 4; ++m)
#pragma unroll
                for (int n = 0; n < 2; ++n) acc[a][b][m][n] = (f32x4){0.f, 0.f, 0.f, 0.f};
    bf16x8 At[4][2], B0[2][2], B1[2][2];
    const char* cA = S.aptr(cur); const char* cB = S.bptr(cur);
    if constexpr (SP2) {
        PG8_STAGE(PG8_SB(0, 0), cB, voffB); PG8_STAGE(PG8_SB(0, 1), cB + hstepB, voffB); PG8_STAGE(PG8_SA(0, 0), cA, voffA); PG8_STAGE(PG8_SA(0, 1), cA + hstepA, voffA);
        if (wr == 1) PG8_BAR;
        PG8_WAIT_V(2); PG8_BAR;
        PG8_STAGE(PG8_SB(1, 0), cB + kstep, voffB); PG8_STAGE(PG8_SA(1, 0), cA + kstep, voffA); PG8_STAGE(PG8_SB(1, 1), cB + hstepB + kstep, voffB);
        PG8_WAIT_V(6); PG8_BAR;
    } else {
        PG8_STAGE(PG8_SB(0, 0), cB, voffB); PG8_STAGE(PG8_SA(0, 0), cA, voffA); PG8_STAGE(PG8_SB(0, 1), cB + hstepB, voffB); PG8_STAGE(PG8_SA(0, 1), cA + hstepA, voffA);
        if (wr == 1) PG8_BAR;
        PG8_WAIT_V(4); PG8_BAR;
        PG8_STAGE(PG8_SB(1, 0), cB + kstep, voffB); PG8_STAGE(PG8_SA(1, 0), cA + kstep, voffA); PG8_STAGE(PG8_SB(1, 1), cB + hstepB + kstep, voffB);
        PG8_WAIT_V(6); PG8_BAR;
    }
    for (;;) {
        const bool has_next = S.next(ui + 1, nxt);
        const char* nA = has_next ? S.aptr(nxt) : cA; const char* nB = has_next ? S.bptr(nxt) : cB;
        for (int t = 0; t < nt; t += 2) {
            const bool last = (t == nt - 2);
            const char* a1 = cA + (size_t)(t + 1) * kstep;
            const char* a2 = last ? nA : cA + (size_t)(t + 2) * kstep; const char* b2 = last ? nB : cB + (size_t)(t + 2) * kstep;
            const char* a3 = a2 + kstep; const char* b3 = b2 + kstep;
            if constexpr (Epi::HAS_MID) { if (t == S.mid) E.mid(acc, cur, wr, wc, fr, fq); }
            if constexpr (SP2) {
            PG8_LDB(B0, 0, 0); PG8_LDB(B1, 0, 1); PG8_SCHED; PG8_LDA(At, 0, 0); PG8_STAGE(PG8_SA(1, 1), a1 + hstepA, voffA);
            PG8_WAIT_V(8); PG8_WAIT_L(0); PG8_BAR; PG8_MMA(0, 0, At, B0); PG8_MMA(0, 1, At, B1); PG8_BAR; PG8_SCHED;
            PG8_LDA(At, 0, 1); PG8_STAGE(PG8_SB(0, 0), b2, voffB); PG8_STAGE(PG8_SB(0, 1), b2 + hstepB, voffB); PG8_STAGE(PG8_SA(0, 0), a2, voffA);
            PG8_WAIT_V(8); PG8_WAIT_L(0); PG8_BAR; PG8_MMA(1, 0, At, B0); PG8_MMA(1, 1, At, B1); PG8_BAR; PG8_SCHED;
            PG8_LDB(B0, 1, 0); PG8_LDB(B1, 1, 1); PG8_SCHED; PG8_LDA(At, 1, 0); PG8_STAGE(PG8_SA(0, 1), a2 + hstepA, voffA);
            PG8_WAIT_V(8); PG8_WAIT_L(0); PG8_BAR; PG8_MMA(0, 0, At, B0); PG8_MMA(0, 1, At, B1); PG8_BAR; PG8_SCHED;
            PG8_LDA(At, 1, 1); PG8_STAGE(PG8_SB(1, 0), b3, voffB); PG8_STAGE(PG8_SB(1, 1), b3 + hstepB, voffB); PG8_STAGE(PG8_SA(1, 0), a3, voffA);
            PG8_WAIT_V(8); PG8_WAIT_L(0); PG8_BAR; PG8_MMA(1, 0, At, B0); PG8_MMA(1, 1, At, B1); PG8_BAR; PG8_SCHED;
            } else {
            PG8_LDB(B0, 0, 0); PG8_SCHED; PG8_LDA(At, 0, 0); PG8_STAGE(PG8_SA(1, 1), a1 + hstepA, voffA);
            PG8_WAIT_L(8); PG8_BAR; PG8_WAIT_L(0); PG8_MMA(0, 0, At, B0); PG8_BAR; PG8_SCHED;
            PG8_LDB(B1, 0, 1); PG8_STAGE(PG8_SB(0, 0), b2, voffB);
            PG8_BAR; PG8_WAIT_L(0); PG8_MMA(0, 1, At, B1); PG8_BAR;
            PG8_LDA(At, 0, 1); PG8_STAGE(PG8_SA(0, 0), a2, voffA);
            PG8_BAR; PG8_WAIT_L(0); PG8_MMA(1, 0, At, B0); PG8_BAR; PG8_SCHED;
            PG8_STAGE(PG8_SB(0, 1), b2 + hstepB, voffB);
            PG8_WAIT_V(6); PG8_BAR; PG8_MMA(1, 1, At, B1); PG8_BAR;
            PG8_LDB(B0, 1, 0); PG8_SCHED; PG8_LDA(At, 1, 0); PG8_STAGE(PG8_SA(0, 1), a2 + hstepA, voffA);
            PG8_WAIT_L(8); PG8_BAR; PG8_WAIT_L(0); PG8_MMA(0, 0, At, B0); PG8_BAR; PG8_SCHED;
            PG8_LDB(B1, 1, 1); PG8_STAGE(PG8_SB(1, 0), b3, voffB);
            PG8_BAR; PG8_WAIT_L(0); PG8_MMA(0, 1, At, B1); PG8_BAR;
            PG8_LDA(At, 1, 1); PG8_STAGE(PG8_SA(1, 0), a3, voffA);
            PG8_BAR; PG8_WAIT_L(0); PG8_MMA(1, 0, At, B0); PG8_BAR; PG8_SCHED;
            PG8_STAGE(PG8_SB(1, 1), b3 + hstepB, voffB);
            PG8_WAIT_V(6); PG8_BAR; PG8_MMA(1, 1, At, B1); PG8_BAR;
            }
        }
        if constexpr (ALIGN_EPI) { if (wr == 0) PG8_BAR; }
        E(acc, cur, wr, wc, fr, fq, xch, wid);
        if (!has_next) break;
#pragma unroll
        for (int a = 0; a < 2; ++a)
#pragma unroll
            for (int b = 0; b < 2; ++b)
#pragma unroll
                for (int m = 0; m < 4; ++m)
#pragma unroll
                    for (int n = 0; n < 2; ++n) acc[a][b][m][n] = (f32x4){0.f, 0.f, 0.f, 0.f};
        cur = nxt; cA = nA; cB = nB; ++ui;
        if constexpr (ALIGN_EPI) { if (wr == 1) PG8_BAR; }
    }
    PG8_WAIT_V(0);
    if constexpr (!ALIGN_EPI) { if (wr == 0) PG8_BAR; }
    PG8_BAR;
#undef PG8_SA
#undef PG8_SB
#undef PG8_STAGE
#undef PG8_LDA
#undef PG8_LDB
#undef PG8_MMA
#undef PG8_WAIT_V
#undef PG8_WAIT_L
#undef PG8_BAR
#undef PG8_SCHED
}
}

#include <hip/hip_bf16.h>
#include <cmath>
namespace attn_body {
using bf16=__hip_bfloat16;
using bf16x8=__attribute__((ext_vector_type(8)))short;
using s16x4=__attribute__((ext_vector_type(4)))short;
using f32x16=__attribute__((ext_vector_type(16)))float;
using u32x4=__attribute__((ext_vector_type(4)))unsigned;
constexpr int BATCH=16,NHEAD=8,SEQ=2048,D=64,QP=512,KP=128,OP=1024;
constexpr int NW=8,QBLK=32,QB=QBLK*NW,KVBLK=64,NQB=SEQ/QB;
__device__ __forceinline__ int crow(int r,int hi){return (r&3)+8*(r>>2)+4*hi;}
#define SBAR() __builtin_amdgcn_sched_barrier(0)
__device__ __forceinline__ void cmask(f32x16&p0,f32x16&p1,int jb,int qrel,int hi){
  const float NEG=-INFINITY; int kb=64*jb+4*hi;
  #pragma unroll
  for(int r=0;r<16;++r){int kv=kb+(r&3)+8*(r>>2); if(kv>qrel)p0[r]=NEG; if(kv+32>qrel)p1[r]=NEG;}
}

constexpr int NSLOT=3, SLOTB=8192;
constexpr int LDS_K=0, LDS_V=NSLOT*SLOTB, LDS_WS=2*NSLOT*SLOTB, LDS_OST=LDS_WS+NW*64*4, LDS_BYTES=LDS_OST+NW*4096;
constexpr float C2=0.125f*1.4426950408889634f;
__device__ __forceinline__ void glds16(const void*gsrc,unsigned lds_dst){unsigned keep;
  asm volatile("s_mov_b32 %0, m0\n\ts_mov_b32 m0, %2\n\ts_nop 0\n\tglobal_load_lds_dwordx4 %1, off\n\ts_mov_b32 m0, %0":"=&s"(keep):"v"(gsrc),"s"(lds_dst):"memory");}
__device__ __forceinline__ float max3f(float a,float b,float c){float r;asm("v_max3_f32 %0, %1, %2, %3":"=v"(r):"v"(a),"v"(b),"v"(c));return r;}
__device__ __forceinline__ float max2f(float a,float b){float r;asm("v_max_f32_e32 %0, %1, %2":"=v"(r):"v"(a),"v"(b));return r;}
__device__ __forceinline__ float fadd_s(float a,float b){float r;asm("v_add_f32_e32 %0, %1, %2":"=v"(r):"v"(a),"v"(b));return r;}
__device__ __forceinline__ float fsub_s(float a,float b){float r;asm("v_sub_f32_e32 %0, %1, %2":"=v"(r):"v"(a),"v"(b));return r;}
typedef float f32x2_t __attribute__((ext_vector_type(2))); typedef __bf16 bf16x2_t __attribute__((ext_vector_type(2)));
__device__ __forceinline__ unsigned cvtpk_s(float lo,float hi){f32x2_t v={lo,hi};bf16x2_t b=__builtin_convertvector(v,bf16x2_t);return __builtin_bit_cast(unsigned,b);}
#define WAIT_BAR(N) asm volatile("s_waitcnt vmcnt(" #N ") lgkmcnt(0)\n\ts_barrier":::"memory")

__device__ __forceinline__ void qkt(f32x16&p0,f32x16&p1,const char*Kslot,const bf16x8*qr,const f32x16&negm,int r32,int hi){
  const char*kb=Kslot+hi*1024+r32*16;
  #pragma unroll
  for(int d0=0;d0<4;++d0){
    const bf16x8 b0=*reinterpret_cast<const bf16x8*>(kb+d0*2048);
    const bf16x8 b1=*reinterpret_cast<const bf16x8*>(kb+d0*2048+512);
    if(d0==0){p0=__builtin_amdgcn_mfma_f32_32x32x16_bf16(b0,qr[0],negm,0,0,0);p1=__builtin_amdgcn_mfma_f32_32x32x16_bf16(b1,qr[0],negm,0,0,0);}
    else{p0=__builtin_amdgcn_mfma_f32_32x32x16_bf16(b0,qr[d0],p0,0,0,0);p1=__builtin_amdgcn_mfma_f32_32x32x16_bf16(b1,qr[d0],p1,0,0,0);}}
}
typedef __attribute__((address_space(3))) const char* lds_cptr;
typedef short v4i16_t __attribute__((ext_vector_type(4)));
__device__ __forceinline__ void kload8(bf16x8*kf,lds_cptr kp){
  kf[0]=*(const __attribute__((address_space(3))) bf16x8*)(kp);      kf[1]=*(const __attribute__((address_space(3))) bf16x8*)(kp+512);
  kf[2]=*(const __attribute__((address_space(3))) bf16x8*)(kp+2048); kf[3]=*(const __attribute__((address_space(3))) bf16x8*)(kp+2560);
  kf[4]=*(const __attribute__((address_space(3))) bf16x8*)(kp+4096); kf[5]=*(const __attribute__((address_space(3))) bf16x8*)(kp+4608);
  kf[6]=*(const __attribute__((address_space(3))) bf16x8*)(kp+6144); kf[7]=*(const __attribute__((address_space(3))) bf16x8*)(kp+6656);
}
__device__ __forceinline__ void kload2(bf16x8*kf,lds_cptr kp,int j){ kf[2*j]=*(const __attribute__((address_space(3))) bf16x8*)(kp+j*2048); kf[2*j+1]=*(const __attribute__((address_space(3))) bf16x8*)(kp+j*2048+512); }
__device__ __forceinline__ s16x4 vtr(lds_cptr p){ return __builtin_bit_cast(s16x4,__builtin_amdgcn_ds_read_tr16_b64_v4i16((__attribute__((address_space(3))) v4i16_t*)p)); }
__device__ __forceinline__ float rowmax(const f32x16&p0,const f32x16&p1){
  float a=max3f(p0[0],p0[1],p1[0]),b=max3f(p0[2],p0[3],p1[1]);a=max3f(a,p1[2],p1[3]);
  #pragma unroll
  for(int r=4;r<16;r+=4){a=max3f(a,p0[r],p0[r+1]);b=max3f(b,p0[r+2],p0[r+3]);a=max3f(a,p1[r],p1[r+1]);b=max3f(b,p1[r+2],p1[r+3]);}
  const float m=max2f(a,b);
  auto rr=__builtin_amdgcn_permlane32_swap(__float_as_uint(m),__float_as_uint(m),false,false);
  return max2f(__uint_as_float(rr[0]),__uint_as_float(rr[1]));
}
__device__ __forceinline__ void pv(f32x16*o,int vb,bf16x8 pa0,bf16x8 pa1,bf16x8 pa2,bf16x8 pa3){
  #pragma unroll
  for(int d0=0;d0<2;++d0){s16x4 lo[4],hi[4];
    #pragma unroll
    for(int ks=0;ks<4;++ks){
      asm volatile("ds_read_b64_tr_b16 %0,%1 offset:%c2":"=&v"(lo[ks]):"v"(vb),"i"(d0*4096+ks*1024):"memory");
      asm volatile("ds_read_b64_tr_b16 %0,%1 offset:%c2":"=&v"(hi[ks]):"v"(vb),"i"(d0*4096+ks*1024+512):"memory");}
    asm volatile("s_waitcnt lgkmcnt(0)":::"memory");SBAR();
    #define PK(k) (bf16x8){lo[k][0],lo[k][1],lo[k][2],lo[k][3],hi[k][0],hi[k][1],hi[k][2],hi[k][3]}
    o[d0]=__builtin_amdgcn_mfma_f32_32x32x16_bf16(pa0,PK(0),o[d0],0,0,0);
    o[d0]=__builtin_amdgcn_mfma_f32_32x32x16_bf16(pa1,PK(1),o[d0],0,0,0);
    o[d0]=__builtin_amdgcn_mfma_f32_32x32x16_bf16(pa2,PK(2),o[d0],0,0,0);
    o[d0]=__builtin_amdgcn_mfma_f32_32x32x16_bf16(pa3,PK(3),o[d0],0,0,0);
    #undef PK
  }
}

#ifndef ATTN_STORE16
#define ATTN_STORE16(p,v) (*(u32x4*)(p)=(v))
#endif
template<int THRL> __device__ __forceinline__ void attn_unit(int b,int h,int qb,const bf16*Q,const bf16*__restrict__ K,const bf16*__restrict__ V,bf16*O,char*shm){
  const int tid=threadIdx.x,lane=tid&63,r32=lane&31,hi=lane>>5; const int wid=__builtin_amdgcn_readfirstlane(tid>>6);
  const long rowbase=(long)b*SEQ; const int q0=qb*QB;
  const bf16*Qw=Q+(rowbase+q0+wid*QBLK)*QP+h*D;
  const bf16*Kh=K+rowbase*KP+(h>>2)*D,*Vh=V+rowbase*KP+(h>>2)*D;
  const unsigned lds0=(unsigned)(uintptr_t)shm;
  float*wsf=(float*)(shm+LDS_WS)+wid*64;
  const bf16*ksrc=Kh+(long)lane*KP+wid*8;
  const bf16*vsrc=Vh+(long)(16*(wid&3)+(lane>>2))*KP+(wid>>2)*32+(lane&3)*8;
  const unsigned kdst=lds0+LDS_K+wid*1024, vdst=lds0+LDS_V+wid*1024;
  #define DMA_K(t,slot) glds16(ksrc+(long)(t)*KVBLK*KP,(unsigned)__builtin_amdgcn_readfirstlane(kdst+(slot)))
  #define DMA_V(t,slot) glds16(vsrc+(long)(t)*KVBLK*KP,(unsigned)__builtin_amdgcn_readfirstlane(vdst+(slot)))
  const int vb0=(int)(lds0+LDS_V)+((lane>>4)&1)*32+(lane&3)*8+(4*hi+((lane&15)>>2))*64;
  const char*Kbase=shm+LDS_K; bf16x8 kf[8];
  const lds_cptr shm3=(lds_cptr)shm; const lds_cptr kp0=shm3+LDS_K+hi*1024+r32*16; const lds_cptr vp0=shm3+LDS_V+((lane>>4)&1)*32+(lane&3)*8+(4*hi+((lane&15)>>2))*64;
  constexpr int NT=SEQ/KVBLK;
  DMA_K(0,0);DMA_V(0,0);DMA_K(1,SLOTB);
  bf16x8 qr[4];
  #pragma unroll
  for(int d0=0;d0<4;++d0)qr[d0]=*reinterpret_cast<const bf16x8*>(&Qw[(long)r32*QP+d0*16+hi*8]);
  float mhat=0.f,l_reg=0.f;f32x16 o[2];o[0]=f32x16{};o[1]=f32x16{};f32x16 negm=f32x16{};asm volatile("":"+v"(negm));
  #define CMASK(P0,P1,t) do{}while(0)
  bool resc=false;
  #define START(P0,P1) do{ const float rm=rowmax(P0,P1); resc=false; \
    { const float dl=rm; mhat=fadd_s(mhat,dl); \
      _Pragma("unroll") for(int r=0;r<16;++r){P0[r]=fsub_s(P0[r],dl);P1[r]=fsub_s(P1[r],dl);} \
      _Pragma("unroll") for(int r=0;r<16;++r)negm[r]=-mhat; asm volatile("":"+v"(negm)); } \
    _Pragma("unroll") for(int r=0;r<16;++r)P0[r]=__builtin_amdgcn_exp2f(P0[r]); }while(0)
  #define RESC() do{ if(resc){ asm volatile("s_waitcnt lgkmcnt(0)":::"memory"); \
      _Pragma("unroll") for(int d_=0;d_<2;++d_) _Pragma("unroll") for(int r=0;r<16;++r)o[d_][r]*=wsf[crow(r,hi)]; } }while(0)
  f32x16 pA0,pA1,pB0,pB1;
  int sl_prev=0,sl_cur=0,sl_next=SLOTB;
  #define ROT() do{sl_prev=sl_cur;sl_cur=sl_next;sl_next=(sl_next==(NSLOT-1)*SLOTB)?0:sl_next+SLOTB;}while(0)
  DMA_K(2,2*SLOTB);
  WAIT_BAR(3);
  qkt(pA0,pA1,Kbase,qr,negm,r32,hi);asm volatile("s_nop 15\n\ts_nop 7":"+v"(pA0),"+v"(pA1));CMASK(pA0,pA1,0);
  START(pA0,pA1);
  _Pragma("unroll") for(int r=0;r<16;++r)pA1[r]=__builtin_amdgcn_exp2f(pA1[r]);
  WAIT_BAR(0);
  DMA_K(3,0);DMA_V(1,SLOTB);
  ROT();
  kload8(kf,kp0+sl_cur);
  WAIT_BAR(2);
  s16x4 vlo[8],vhi[8]; u32x4 pw0,pw1,pw2,pw3;
  #define PKW(P,B) cvtpk_s(P[B],P[B+1])
  #define PAF(k) __builtin_bit_cast(bf16x8,pw##k)
  #define VFR(i) (bf16x8){vlo[i][0],vlo[i][1],vlo[i][2],vlo[i][3],vhi[i][0],vhi[i][1],vhi[i][2],vhi[i][3]}
  #define PIN(x) asm volatile("":"+v"(x))
  #define MX3(a,b,c) __builtin_fmaxf(__builtin_fmaxf((a),(b)),(c))
  #define GAPA(MF,A0,A1,A2,A3,W0,W1,PW) do{ MF; sacc+=A0; sacc+=A1; sacc+=A2; sacc+=A3; PIN(sacc); W0; W1; PIN(PW); SBAR(); }while(0)
  #define EX(v) __builtin_amdgcn_exp2f(v)
  #define GAPB(MF,X,B) do{ MF; X[B]=EX(X[B]); X[B+1]=EX(X[B+1]); X[B+2]=EX(X[B+2]); X[B+3]=EX(X[B+3]); PIN(X); SBAR(); }while(0)
  #define VRD(i) do{ vlo[i]=vtr(vp_+(((i)>>2)*4096+((i)&3)*1024)); vhi[i]=vtr(vp_+(((i)>>2)*4096+((i)&3)*1024+512)); }while(0)
  #define KRD(G,j) do{ if(G){ kload2(kf,kp0+sl_next,j); SBAR(); } }while(0)
  #define STEP(C0,C1,P0,P1,t,GK,GV,GL) do{ SBAR(); \
    const lds_cptr vp_=vp0+sl_prev; \
    VRD(0); SBAR(); float sacc=(P0[0]+P0[1]); \
    GAPA(C0=__builtin_amdgcn_mfma_f32_32x32x16_bf16(kf[0],qr[0],negm,0,0,0), P0[2],P0[3],P0[4],P0[5],     pw0[0]=PKW(P0,0), pw0[1]=PKW(P0,2), pw0); \
    VRD(4); SBAR(); GAPA(C1=__builtin_amdgcn_mfma_f32_32x32x16_bf16(kf[1],qr[0],negm,0,0,0), P0[6],P0[7],P0[8],P0[9],     pw0[2]=PKW(P0,4), pw0[3]=PKW(P0,6), pw0); \
    VRD(1); SBAR(); GAPA(C0=__builtin_amdgcn_mfma_f32_32x32x16_bf16(kf[2],qr[1],C0,0,0,0),   P0[10],P0[11],P0[12],P0[13], pw1[0]=PKW(P0,8), pw1[1]=PKW(P0,10), pw1); \
    VRD(5); SBAR(); GAPA(C1=__builtin_amdgcn_mfma_f32_32x32x16_bf16(kf[3],qr[1],C1,0,0,0),   P0[14],P0[15],P1[0],P1[1],   pw1[2]=PKW(P0,12),pw1[3]=PKW(P0,14), pw1); \
    VRD(2); SBAR(); GAPA(C0=__builtin_amdgcn_mfma_f32_32x32x16_bf16(kf[4],qr[2],C0,0,0,0),   P1[2],P1[3],P1[4],P1[5],     pw2[0]=PKW(P1,0), pw2[1]=PKW(P1,2), pw2); \
    VRD(6); SBAR(); GAPA(C1=__builtin_amdgcn_mfma_f32_32x32x16_bf16(kf[5],qr[2],C1,0,0,0),   P1[6],P1[7],P1[8],P1[9],     pw2[2]=PKW(P1,4), pw2[3]=PKW(P1,6), pw2); \
    VRD(3); SBAR(); GAPA(C0=__builtin_amdgcn_mfma_f32_32x32x16_bf16(kf[6],qr[3],C0,0,0,0),   P1[10],P1[11],P1[12],P1[13], pw3[0]=PKW(P1,8), pw3[1]=PKW(P1,10), pw3); \
    VRD(7); SBAR(); GAPA(C1=__builtin_amdgcn_mfma_f32_32x32x16_bf16(kf[7],qr[3],C1,0,0,0),   P1[14],P1[15],0.f,0.f,       pw3[2]=PKW(P1,12),pw3[3]=PKW(P1,14), pw3); \
    l_reg+=sacc; \
    if(GK){DMA_K((t)+3,sl_cur);} if(GV){DMA_V((t)+1,sl_next);} \
    CMASK(C0,C1,t); \
    { float a=MX3(C0[0],C0[1],C1[0]),b=MX3(C0[2],C0[3],C1[1]); a=MX3(a,C1[2],C1[3]); \
      _Pragma("unroll") for(int r=4;r<16;r+=4){a=MX3(a,C0[r],C0[r+1]);b=MX3(b,C0[r+2],C0[r+3]);a=MX3(a,C1[r],C1[r+1]);b=MX3(b,C1[r+2],C1[r+3]);} \
      float rm=__builtin_fmaxf(a,b); { auto rr=__builtin_amdgcn_permlane32_swap(__float_as_uint(rm),__float_as_uint(rm),false,false); rm=__builtin_fmaxf(__uint_as_float(rr[0]),__uint_as_float(rr[1])); } \
      resc=false; \
      if(__builtin_expect(__any(rm>(float)THRL),0)){ const float dl=__builtin_fmaxf(rm,0.f); mhat+=dl; \
        _Pragma("unroll") for(int r=0;r<16;++r){C0[r]-=dl;C1[r]-=dl;} \
        _Pragma("unroll") for(int r=0;r<16;++r)negm[r]=-mhat; asm volatile("":"+v"(negm)); \
        const float f=__builtin_amdgcn_exp2f(-dl); l_reg*=f; if(hi==0)wsf[r32]=f; resc=true; } } \
    SBAR(); \
    GAPB(o[0]=__builtin_amdgcn_mfma_f32_32x32x16_bf16(PAF(0),VFR(0),o[0],0,0,0), C0,0); \
    GAPB(o[1]=__builtin_amdgcn_mfma_f32_32x32x16_bf16(PAF(0),VFR(4),o[1],0,0,0), C0,4); \
    KRD(GL,0); GAPB(o[0]=__builtin_amdgcn_mfma_f32_32x32x16_bf16(PAF(1),VFR(1),o[0],0,0,0), C0,8); \
    KRD(GL,1); GAPB(o[1]=__builtin_amdgcn_mfma_f32_32x32x16_bf16(PAF(1),VFR(5),o[1],0,0,0), C0,12); \
    KRD(GL,2); GAPB(o[0]=__builtin_amdgcn_mfma_f32_32x32x16_bf16(PAF(2),VFR(2),o[0],0,0,0), C1,0); \
    KRD(GL,3); GAPB(o[1]=__builtin_amdgcn_mfma_f32_32x32x16_bf16(PAF(2),VFR(6),o[1],0,0,0), C1,4); \
    GAPB(o[0]=__builtin_amdgcn_mfma_f32_32x32x16_bf16(PAF(3),VFR(3),o[0],0,0,0), C1,8); \
    GAPB(o[1]=__builtin_amdgcn_mfma_f32_32x32x16_bf16(PAF(3),VFR(7),o[1],0,0,0), C1,12); \
    }while(0)
  int t=1;
  #undef CMASK
  #define CMASK(P0,P1,t) do{}while(0)
  for(;t+5<NT;t+=2){
    STEP(pB0,pB1,pA0,pA1,t,true,true,true);     WAIT_BAR(2); RESC(); ROT();
    STEP(pA0,pA1,pB0,pB1,t+1,true,true,true);   WAIT_BAR(2); RESC(); ROT();
  }
  #undef CMASK
  #define CMASK(P0,P1,t) do{}while(0)
  #define ENDW(tt) do{ if((tt)+3<NT){WAIT_BAR(2);} else if((tt)+2<NT){WAIT_BAR(1);} else {WAIT_BAR(0);} }while(0)
  for(;t+1<NT;t+=2){
    STEP(pB0,pB1,pA0,pA1,t,(t+3<NT),(t+1<NT),(t+1<NT));       ENDW(t);   RESC(); ROT();
    STEP(pA0,pA1,pB0,pB1,t+1,(t+4<NT),(t+2<NT),(t+2<NT));     ENDW(t+1); RESC(); ROT();
  }
  STEP(pB0,pB1,pA0,pA1,NT-1,false,false,false); RESC();
  { float sacc=pB0[0]+pB0[1]; _Pragma("unroll") for(int r=2;r<16;++r)sacc+=pB0[r]; _Pragma("unroll") for(int r=0;r<16;++r)sacc+=pB1[r]; l_reg+=sacc;
    pw0=(u32x4){PKW(pB0,0),PKW(pB0,2),PKW(pB0,4),PKW(pB0,6)};pw1=(u32x4){PKW(pB0,8),PKW(pB0,10),PKW(pB0,12),PKW(pB0,14)};pw2=(u32x4){PKW(pB1,0),PKW(pB1,2),PKW(pB1,4),PKW(pB1,6)};pw3=(u32x4){PKW(pB1,8),PKW(pB1,10),PKW(pB1,12),PKW(pB1,14)};
    SBAR(); pv(o,vb0+sl_cur,PAF(0),PAF(1),PAF(2),PAF(3)); }
  #undef PKW
  #undef PAF
  #undef VFR
  #undef PIN
  #undef MX3
  #undef GAPA
  #undef GAPB
  #undef EX
  #undef VRD
  #undef KRD
  #undef STEP
  #undef ENDW
  {auto rr=__builtin_amdgcn_permlane32_swap(__float_as_uint(l_reg),__float_as_uint(l_reg),false,false);l_reg=__uint_as_float(rr[0])+__uint_as_float(rr[1]);}
  if(hi==0)wsf[32+r32]=l_reg;asm volatile("s_waitcnt lgkmcnt(0)":::"memory");
  float rli[16];
  #pragma unroll
  for(int r=0;r<16;++r)rli[r]=__builtin_amdgcn_rcpf(wsf[32+crow(r,hi)]);
  bf16*Ow=O+(rowbase+q0+wid*QBLK)*OP+h*D;
  { bf16*stg=(bf16*)(shm+LDS_OST)+wid*2048;
    #pragma unroll
    for(int r=0;r<16;++r){const int orow=crow(r,hi);
      #pragma unroll
      for(int d0=0;d0<2;++d0)stg[orow*64+d0*32+r32]=__float2bfloat16(o[d0][r]*rli[r]);}
    asm volatile("s_waitcnt lgkmcnt(0)":::"memory");
    #pragma unroll
    for(int i=0;i<4;++i){const int row=i*8+(lane>>3),ch=lane&7; const u32x4 v=*(const u32x4*)(stg+row*64+ch*8); ATTN_STORE16(Ow+(long)row*OP+ch*8,v);} }
  asm volatile("s_waitcnt lgkmcnt(0)\n\ts_barrier":::"memory");
  #undef DMA_K
  #undef DMA_V
  #undef CMASK
  #undef START
  #undef RESC
  #undef ROT
}
constexpr int ATTN_LDS_BYTES=LDS_BYTES;
template<int THRL=8> __device__ __forceinline__ void attn_phase(char*lds,const bf16*Q,const bf16*K,const bf16*V,bf16*O,int vcu,int G){
  for(int u=vcu;u<BATCH*NHEAD*(SEQ/QB);u+=G){ const int grp=u>>5, r=u&31; const int b=grp>>1, kvh=grp&1, hq=r>>3, qb=r&7; attn_unit<THRL>(b,kvh*4+hq,qb,Q,K,V,O,lds); }
}
#undef SBAR
#undef WAIT_BAR
}

constexpr size_t MiB = 1u << 20;
constexpr size_t WS_CTL = 0, CTL_ZERO_BYTES = 16384;
constexpr size_t WS_ROPE = 1 * MiB, WS_SS = 2 * MiB;
constexpr size_t WS_WIN = 4 * MiB, WS_WXKV = 11 * MiB, WS_WCAT = 15 * MiB, WS_WOUT = 17 * MiB, WS_WXQ = 19 * MiB, WS_WXO = 21 * MiB, WS_WFF1 = 23 * MiB, WS_WFF2 = 31 * MiB;
constexpr size_t WS_MN = 40 * MiB, WS_XKV = 48 * MiB, WS_HB = 64 * MiB;
constexpr size_t WS_R1 = 128 * MiB;
constexpr size_t WS_R2 = 192 * MiB;
constexpr size_t WS_R3 = 256 * MiB;
constexpr size_t WS_G = 320 * MiB;
constexpr size_t WS_F = 128 * MiB;
constexpr size_t WS_END = 448 * MiB;

constexpr int NWAVES = 8;
constexpr int RING_BYTES = 131072, XCH_OFF = RING_BYTES, MISC_OFF = XCH_OFF + 8192, LDS_BYTES = 147456;
#define GAS __attribute__((address_space(1)))
#define LAS __attribute__((address_space(3)))
typedef unsigned short bf16;
typedef unsigned v4u __attribute__((ext_vector_type(4)));
typedef float f32x4 __attribute__((ext_vector_type(4)));

__device__ __forceinline__ unsigned f2bf(float f) { unsigned u = __builtin_bit_cast(unsigned, f); return (u + 0x7fffu + ((u >> 16) & 1u)) >> 16; }
__device__ __forceinline__ unsigned pk2(float lo, float hi) { return f2bf(lo) | (f2bf(hi) << 16); }
__device__ __forceinline__ float wave_sum(float v) {
#pragma unroll
    for (int o = 1; o < 64; o <<= 1) v += __shfl_xor(v, o);
    return v;
}
#define LDS_WAIT() asm volatile("s_waitcnt lgkmcnt(0)" ::: "memory")

__device__ __forceinline__ void p0_transpose_item(const float* W, int ldw, bf16* WT, int ldt, LAS float* scr, int item, int nblk, int lane, const float* gk) {
    const int kb = item / nblk, nb = item % nblk, k0 = 64 * kb, n0 = 32 * nb;
#pragma unroll
    for (int i = 0; i < 32; ++i) { const int kk = 2 * i + (lane >> 5); float v = W[(size_t)(k0 + kk) * ldw + n0 + (lane & 31)]; if (gk) v *= gk[k0 + kk]; scr[kk * 33 + (lane & 31)] = v; }
    LDS_WAIT(); asm volatile("" ::: "memory");
    const int c = lane & 7;
#pragma unroll
    for (int j = 0; j < 4; ++j) { const int n = (lane >> 3) + 8 * j; const LAS float* s = scr + (8 * c) * 33 + n;
        v4u o; o.x = pk2(s[0 * 33], s[1 * 33]); o.y = pk2(s[2 * 33], s[3 * 33]); o.z = pk2(s[4 * 33], s[5 * 33]); o.w = pk2(s[6 * 33], s[7 * 33]);
        *(v4u*)(WT + (size_t)(n0 + n) * ldt + k0 + 8 * c) = o; }
    LDS_WAIT(); asm volatile("" ::: "memory");
}
__device__ __forceinline__ void p0_transpose_block(const float* W, int ldw, bf16* WT, int ldt, LAS float* T, int k0, int n0, int tid, const float* gk) {
    f32x4 v[8];
#pragma unroll
    for (int i = 0; i < 8; ++i) { const int row = (tid >> 6) + 8 * i; v[i] = *(const f32x4*)(W + (size_t)(k0 + row) * ldw + n0 + (tid & 63) * 4); }
    if (gk) {
#pragma unroll
        for (int i = 0; i < 8; ++i) v[i] = v[i] * gk[k0 + (tid >> 6) + 8 * i]; }
#pragma unroll
    for (int i = 0; i < 8; ++i) { LAS float* d = T + ((tid >> 6) + 8 * i) * 257 + (tid & 63) * 4; d[0] = v[i].x; d[1] = v[i].y; d[2] = v[i].z; d[3] = v[i].w; }
    LDS_WAIT(); __builtin_amdgcn_s_barrier(); asm volatile("" ::: "memory");
#pragma unroll
    for (int j = 0; j < 4; ++j) { const int p = tid + 512 * j, n = p >> 3, c = p & 7; const LAS float* s = T + (8 * c) * 257 + n;
        v4u o; o.x = pk2(s[0 * 257], s[1 * 257]); o.y = pk2(s[2 * 257], s[3 * 257]); o.z = pk2(s[4 * 257], s[5 * 257]); o.w = pk2(s[6 * 257], s[7 * 257]);
        *(v4u*)(WT + (size_t)(n0 + n) * ldt + k0 + 8 * c) = o; }
    LDS_WAIT(); __builtin_amdgcn_s_barrier(); asm volatile("" ::: "memory");
}
template <int R> __device__ __forceinline__ void rms_rows_to_bf16(const float* xrow, const float* g, bf16* orow, int lane) {
    const f32x4* gr = (const f32x4*)g + lane;
    f32x4 v[R][4]; float s[R];
#pragma unroll
    for (int r = 0; r < R; ++r) { const f32x4* xr = (const f32x4*)(xrow + (size_t)r * 1024) + lane;
#pragma unroll
        for (int j = 0; j < 4; ++j) v[r][j] = xr[64 * j]; }
#pragma unroll
    for (int r = 0; r < R; ++r) { s[r] = 0.f;
#pragma unroll
        for (int j = 0; j < 4; ++j) s[r] += (v[r][j].x * v[r][j].x + v[r][j].y * v[r][j].y) + (v[r][j].z * v[r][j].z + v[r][j].w * v[r][j].w); }
#pragma unroll
    for (int r = 0; r < R; ++r) { const float rs = 1.0f / sqrtf(wave_sum(s[r]) * (1.f / 1024.f) + EPS);
        unsigned long long* o8 = (unsigned long long*)(orow + (size_t)r * 1024) + lane;
#pragma unroll
        for (int j = 0; j < 4; ++j) { const f32x4 gg = gr[64 * j]; o8[64 * j] = (unsigned long long)pk2(v[r][j].x * rs * gg.x, v[r][j].y * rs * gg.y) | ((unsigned long long)pk2(v[r][j].z * rs * gg.z, v[r][j].w * rs * gg.w) << 32); } }
}

typedef GAS unsigned gu32;
#define RLX_AGENT __ATOMIC_RELAXED, __HIP_MEMORY_SCOPE_AGENT
#define XB_TMO      128
#define XB_XCNT(j)  (256  + 64 * (j))
#define XB_XSUB(j)  (1280 + 64 * (j))
#define XB_XGEN(j)  (2304 + 64 * (j))
#define XB_TOP      3328
#define XB_TOPGEN   3392
#define XCD_BAR_WORDS 3456
#define XB_SPIN_CAP (1u << 18)

__device__ __forceinline__ unsigned xb_ld(unsigned* p)              { return __hip_atomic_load(p, __ATOMIC_RELAXED, __HIP_MEMORY_SCOPE_AGENT); }
__device__ __forceinline__ unsigned xb_add(unsigned* p, unsigned v) { return __hip_atomic_fetch_add(p, v, __ATOMIC_RELAXED, __HIP_MEMORY_SCOPE_AGENT); }
__device__ __forceinline__ unsigned xb_xcc_id() { return (unsigned)__builtin_amdgcn_s_getreg((3 << 11) | 20) & 0xFu; }
#define XB_SPIN(cond, bar) do { unsigned _sp = 0; while (cond) { __builtin_amdgcn_s_sleep(1); \
    if ((++_sp & 255u) == 0u) { if (xb_ld(&(bar)[XB_TMO])) break; if (_sp > XB_SPIN_CAP) { atomicAdd(&(bar)[XB_TMO], 1u); break; } } } } while (0)

struct XcdBarrier {
    unsigned* bar; unsigned x;
    volatile LAS unsigned* st;
};

__device__ __forceinline__ XcdBarrier xcd_barrier_post(unsigned* bar, volatile LAS unsigned* st) {
    XcdBarrier b; b.bar = bar; b.x = xb_xcc_id(); b.st = st;
    if (threadIdx.x == 0) (void)xb_add(&bar[XB_XCNT(b.x)], 1u);
    return b;
}
__device__ __forceinline__ void xcd_barrier_complete(unsigned* bar, unsigned x, unsigned& nloc, unsigned& nx) {
    const unsigned G = gridDim.x * gridDim.y * gridDim.z;
    unsigned sum, cnt, mine, sp = 0u;
    for (;;) {
        sum = 0u; cnt = 0u; mine = 0u;
#pragma unroll
        for (unsigned j = 0; j < 16; ++j) { const unsigned c = xb_ld(&bar[XB_XCNT(j)]); sum += c; cnt += (c > 0u) ? 1u : 0u; mine = (j == x) ? c : mine; }
        if (sum == G) break;
        __builtin_amdgcn_s_sleep(1);
        if ((++sp & 255u) == 0u) { if (xb_ld(&bar[XB_TMO])) break; if (sp > XB_SPIN_CAP) { atomicAdd(&bar[XB_TMO], 1u); break; } }
    }
    nloc = mine > 0u ? mine : 1u; nx = cnt > 0u ? cnt : 1u;
}

__device__ __forceinline__ void xcd_barrier(const XcdBarrier& b) {
    asm volatile("s_waitcnt vmcnt(0)" ::: "memory");
    __syncthreads();
    if (threadIdx.x == 0) {
        unsigned* bar = b.bar;
        __builtin_amdgcn_s_waitcnt(0);
        unsigned nloc = b.st[0], nx = b.st[1];
        if (nloc == 0u) { xcd_barrier_complete(bar, b.x, nloc, nx); b.st[0] = nloc; b.st[1] = nx; }
        const unsigned old = xb_add(&bar[XB_XSUB(b.x)], 1u);
        const unsigned gen = old / nloc;
        if (old + 1u == (gen + 1u) * nloc) {
            __builtin_amdgcn_fence(__ATOMIC_RELEASE, "agent");
            asm volatile("s_waitcnt vmcnt(0)" ::: "memory");
            const unsigned og = xb_add(&bar[XB_TOP], 1u);
            const unsigned tg = og / nx;
            if (og + 1u == (tg + 1u) * nx) xb_add(&bar[XB_TOPGEN], 1u);
            else XB_SPIN(xb_ld(&bar[XB_TOPGEN]) == tg, bar);
            __builtin_amdgcn_fence(__ATOMIC_ACQUIRE, "agent");
            xb_add(&bar[XB_XGEN(b.x)], 1u);
            asm volatile("s_waitcnt vmcnt(0)" ::: "memory");
        } else {
            XB_SPIN(xb_ld(&bar[XB_XGEN(b.x)]) == gen, bar);
            __builtin_amdgcn_fence(__ATOMIC_ACQUIRE, "agent");
            asm volatile("s_waitcnt vmcnt(0)" ::: "memory");
        }
    }
    __syncthreads();
}

struct Args {
    const float* in[21]; float* out; unsigned char* ws; int ph_lo, ph_hi;
};
enum { I_X = 0, I_MEM, I_GMIX, I_WIN, I_BGATE, I_GQ, I_GK, I_WATTN, I_POOLW, I_PSCALE, I_WPOOL, I_WOUT, I_GCROSS, I_GMEM, I_WXQ, I_WXKV, I_WXO, I_GFFN, I_WFF1, I_WFF2, I_GFINAL };
constexpr int N_PHASES = 10;

__global__ void __launch_bounds__(NWAVES * 64, 2) mega_fwd(Args args) {
    extern __shared__ __attribute__((aligned(16))) unsigned char lds[];
    LAS unsigned char* ldsp = (LAS unsigned char*)lds;
    LAS float* xch = (LAS float*)(ldsp + XCH_OFF);
    const int tid = threadIdx.x, lane = tid & 63, wave = __builtin_amdgcn_readfirstlane(tid >> 6);
    const int G = gridDim.x; const int bx = blockIdx.x;
    const int vcu = (G % 8 == 0) ? (bx % 8) * (G / 8) + bx / 8 : bx;
    unsigned char* ws = args.ws;
    const int lo = args.ph_lo, hi = args.ph_hi;
    bf16* Win_t = (bf16*)(ws + WS_WIN); bf16* Wxkv_t = (bf16*)(ws + WS_WXKV); bf16* Wcat_t = (bf16*)(ws + WS_WCAT); bf16* Wout_t = (bf16*)(ws + WS_WOUT);
    bf16* WqB = (bf16*)(ws + WS_WXQ); bf16* Wxo_t = (bf16*)(ws + WS_WXO); bf16* Wff1_t = (bf16*)(ws + WS_WFF1); bf16* Wff2_t = (bf16*)(ws + WS_WFF2);
    float* ROPE = (float*)(ws + WS_ROPE); float* SS = (float*)(ws + WS_SS);
    bf16* MNb = (bf16*)(ws + WS_MN); bf16* XKV = (bf16*)(ws + WS_XKV); bf16* HB = (bf16*)(ws + WS_HB);
    bf16* N1 = (bf16*)(ws + WS_R1); bf16* AP = (bf16*)(ws + WS_R1); bf16* Pm = (bf16*)(ws + WS_R1);
    bf16* Qb = (bf16*)(ws + WS_R2); bf16* Kb = (bf16*)(ws + WS_R2 + 32 * MiB); bf16* Vb = (bf16*)(ws + WS_R2 + 40 * MiB); bf16* MIX = (bf16*)(ws + WS_R2);
    bf16* Ub = (bf16*)(ws + WS_R3); bf16* KWt = (bf16*)(ws + WS_R3); bf16* VWt = (bf16*)(ws + WS_R3 + 32 * MiB);
    bf16* Gt = (bf16*)(ws + WS_G); bf16* Fb = (bf16*)(ws + WS_F);
    float* OUT = args.out;

    volatile LAS unsigned* MISC = (volatile LAS unsigned*)(ldsp + MISC_OFF);
    if (tid < 32) MISC[tid] = 0u;
    __syncthreads();
    XcdBarrier bar; bar.bar = (unsigned*)(ws + WS_CTL); bar.x = 0; bar.st = nullptr;
    if (!MK_PER_PHASE) bar = xcd_barrier_post((unsigned*)(ws + WS_CTL), MISC + 8);
    if (hi > 1000) cg::this_grid().sync();
#ifndef PHASE_MASK
#define PHASE_MASK 0xFFF
#endif
#define IN(k) (((PHASE_MASK >> (k)) & 1) && lo <= (k) && (k) < hi)
#ifndef REPEAT_MASK
#define REPEAT_MASK 0
#endif
#ifndef EXTRA_SYNCS
#define EXTRA_SYNCS 0
#endif
#define PHASE(k) if (IN(k)) _Pragma("unroll") for (int rep_ = 0; rep_ <= ((REPEAT_MASK >> (k)) & 1); ++rep_)
#define REP_SYNC() do { if (rep_) xcd_barrier(bar); } while (0)
#define LOCAL_SEAM(k) do { if (IN(k) && IN((k) + 1)) { asm volatile("s_waitcnt vmcnt(0)" ::: "memory"); __syncthreads(); __builtin_amdgcn_fence(__ATOMIC_ACQUIRE, "agent"); asm volatile("s_waitcnt vmcnt(0)" ::: "memory"); __syncthreads(); } } while (0)
#define SEAM(k) do { if (IN(k) && IN((k) + 1)) { xcd_barrier(bar); } } while (0)
    const int gw = vcu * NWAVES + wave, NGW = G * NWAVES;

    PHASE(0) { REP_SYNC();
        {
            LAS float* T = (LAS float*)ldsp;
            constexpr int B0 = 16 * 13, B1 = 16 * 8, B2 = 8 * 4, B3 = 16 * 4, B5 = 16 * 4, B6 = 16 * 16, B7 = 64 * 4;
            constexpr int NBLK = B0 + B1 + B2 + B3 + B5 + B6 + B7;
            for (int bi = vcu; bi < NBLK; bi += G) {
                int r = bi;
                if (r < B0) { p0_transpose_block(args.in[I_WIN], INW, Win_t, 1024, T, (r / 13) * 64, (r % 13) * 256, tid, nullptr); continue; } r -= B0;
                if (r < B1) { p0_transpose_block(args.in[I_WXKV], 2048, Wxkv_t, 1024, T, (r >> 3) * 64, (r & 7) * 256, tid, nullptr); continue; } r -= B1;
                if (r < B2) { p0_transpose_block(args.in[I_WATTN], 1024, Wcat_t, 1024, T, (r >> 2) * 64, (r & 3) * 256, tid, nullptr); continue; } r -= B2;
                if (r < B3) { p0_transpose_block(args.in[I_WOUT], 1024, Wout_t, 1024, T, (r >> 2) * 64, (r & 3) * 256, tid, nullptr); continue; } r -= B3;
                if (r < B5) { p0_transpose_block(args.in[I_WXO], 1024, Wxo_t, 1024, T, (r >> 2) * 64, (r & 3) * 256, tid, nullptr); continue; } r -= B5;
                if (r < B6) { p0_transpose_block(args.in[I_WFF1], 4096, Wff1_t, 1024, T, (r >> 4) * 64, (r & 15) * 256, tid, args.in[I_GFFN]); continue; } r -= B6;
                p0_transpose_block(args.in[I_WFF2], 1024, Wff2_t, 4096, T, (r >> 2) * 64, (r & 3) * 256, tid, nullptr);
            }
        }
        for (int r = gw; r < 1024; r += NGW) {
            const float gsc = args.in[I_GCROSS][r]; const f32x4* xr = (const f32x4*)(args.in[I_WXQ] + (size_t)r * 1024) + lane; unsigned long long* o8 = (unsigned long long*)(WqB + (size_t)r * 1024) + lane;
#pragma unroll
            for (int j = 0; j < 4; ++j) { const f32x4 v = xr[64 * j] * gsc; o8[64 * j] = (unsigned long long)pk2(v.x, v.y) | ((unsigned long long)pk2(v.z, v.w) << 32); }
        }
        for (int r = gw; r < 2048; r += NGW) {
                const int g = r >> 9, cb = (r >> 4) & 31, nb = r & 15, n = nb * 64 + lane, c0 = cb * 4;
                const float* pw = args.in[I_POOLW] + (size_t)g * 128 * 128 + (size_t)c0 * 128; const float* ps = args.in[I_PSCALE] + g * 128; const float* wp = args.in[I_WPOOL] + (size_t)g * 128 * 1024 + n;
                float a[4];
#pragma unroll
                for (int cc = 0; cc < 4; ++cc) a[cc] = 0.f;
                for (int d0 = 0; d0 < 128; d0 += 32) { float w[32];
#pragma unroll
                    for (int dd = 0; dd < 32; ++dd) w[dd] = wp[(size_t)(d0 + dd) * 1024];
#pragma unroll
                    for (int dd = 0; dd < 32; ++dd) { const float ws_ = w[dd] * ps[d0 + dd];
#pragma unroll
                        for (int cc = 0; cc < 4; ++cc) a[cc] += pw[cc * 128 + d0 + dd] * ws_; } }
                *(unsigned long long*)(Wcat_t + (size_t)n * 1024 + 512 + g * 128 + c0) = (unsigned long long)pk2(a[0], a[1]) | ((unsigned long long)pk2(a[2], a[3]) << 32);
        }
        {
            const int gt = vcu * NWAVES * 64 + tid;
            if (gt < 1024) { const int pos = gt >> 4, f = gt & 15; const float inv = exp2f(-(float)f * (13.287712379549449f / 16.0f));
                const float ang = (float)pos * inv; float rev = ang * 0.15915494309189535f; rev -= floorf(rev);
                ROPE[gt] = __builtin_amdgcn_cosf(rev); ROPE[1024 + gt] = __builtin_amdgcn_sinf(rev); }
        }
        for (int m4 = gw; m4 < (TOK + MTOK) / 4; m4 += NGW) { const int m = m4 * 4;
            if (m < TOK) rms_rows_to_bf16<4>(args.in[I_X] + (size_t)m * DM, args.in[I_GMIX], N1 + (size_t)m * DM, lane);
            else rms_rows_to_bf16<4>(args.in[I_MEM] + (size_t)(m - TOK) * DM, args.in[I_GMEM], MNb + (size_t)(m - TOK) * DM, lane);
        }
    }
    SEAM(0);

    PHASE(1) { REP_SYNC();
        typedef pg8::ProbP1<(long)WS_R1, (long)WS_WIN, (long)WS_MN, (long)WS_WXKV> P1; P1 S; S.ws = (const char*)ws; S.G = G; S.c = bx; S.K = 1024; S.lda = 1024; S.ldb = 1024; S.mid = -1;
        pg8::EpiP1 E{Qb, Kb, Vb, Ub, Gt, XKV, args.in[I_BGATE], args.in[I_GQ], args.in[I_GK], ROPE};
        pg8::gemm_phase<pg8::EpiP1, P1, true, true>(ldsp, xch, S, E);
    }
    SEAM(1);

    PHASE(2) { REP_SYNC();
        attn_body::attn_phase((char*)lds, (const attn_body::bf16*)Qb, (const attn_body::bf16*)Kb, (const attn_body::bf16*)Vb, (attn_body::bf16*)AP, vcu, G);
        const int grp = lane >> 4, hw = 1 << grp;
        for (int ch = gw; ch < TOK / 16; ch += NGW) {
            const int t0 = ch * 16, s0 = t0 & (SEQ - 1);
            const bf16* ub = Ub + (size_t)(t0 - s0) * 512 + lane * 8;
            float a[8];
#pragma unroll
            for (int j = 0; j < 8; ++j) a[j] = 0.f;
#pragma unroll
            for (int k = 0; k < 16; ++k) { const int r = s0 - hw + k;
                if (k < 2 * hw && r >= 0 && r < SEQ) { const v4u w = *(const v4u*)(ub + (size_t)r * 512);
                    a[0] += pg8::bf_lo(w.x); a[1] += pg8::bf_hi(w.x); a[2] += pg8::bf_lo(w.y); a[3] += pg8::bf_hi(w.y); a[4] += pg8::bf_lo(w.z); a[5] += pg8::bf_hi(w.z); a[6] += pg8::bf_lo(w.w); a[7] += pg8::bf_hi(w.w); } }
#pragma unroll 4
            for (int i = 0; i < 16; ++i) { const int s = s0 + i; const int lo_s = max(s - hw, 0), hi_s = min(s + hw, SEQ);
                const v4u w = *(const v4u*)(ub + (size_t)s * 512); const float ic = 1.0f / (float)(hi_s - lo_s);
                v4u o; o.x = pk2(a[0] * ic - pg8::bf_lo(w.x), a[1] * ic - pg8::bf_hi(w.x)); o.y = pk2(a[2] * ic - pg8::bf_lo(w.y), a[3] * ic - pg8::bf_hi(w.y));
                o.z = pk2(a[4] * ic - pg8::bf_lo(w.z), a[5] * ic - pg8::bf_hi(w.z)); o.w = pk2(a[6] * ic - pg8::bf_lo(w.w), a[7] * ic - pg8::bf_hi(w.w));
                *(v4u*)(AP + (size_t)(t0 + i) * 1024 + 512 + lane * 8) = o;
                if (s + hw < SEQ) { const v4u p = *(const v4u*)(ub + (size_t)(s + hw) * 512);
                    a[0] += pg8::bf_lo(p.x); a[1] += pg8::bf_hi(p.x); a[2] += pg8::bf_lo(p.y); a[3] += pg8::bf_hi(p.y); a[4] += pg8::bf_lo(p.z); a[5] += pg8::bf_hi(p.z); a[6] += pg8::bf_lo(p.w); a[7] += pg8::bf_hi(p.w); }
                if (s - hw >= 0) { const v4u q = *(const v4u*)(ub + (size_t)(s - hw) * 512);
                    a[0] -= pg8::bf_lo(q.x); a[1] -= pg8::bf_hi(q.x); a[2] -= pg8::bf_lo(q.y); a[3] -= pg8::bf_hi(q.y); a[4] -= pg8::bf_lo(q.z); a[5] -= pg8::bf_hi(q.z); a[6] -= pg8::bf_lo(q.w); a[7] -= pg8::bf_hi(q.w); }
            }
        }
    }
    SEAM(2);

    PHASE(3) { REP_SYNC();
        pg8::ProbMN S = pg8::make_plain(AP, Wcat_t, TOK, 1024, 1024, G, bx); S.mid = 8;
        pg8::EpiMix E{Gt, MIX};
        pg8::gemm_phase<pg8::EpiMix, pg8::ProbMN, true, true>(ldsp, xch, S, E);
        {
            pg8::ProbKW S1; S1.XKV = XKV; S1.WqB = WqB; S1.G = G; S1.c = bx; S1.K = 256; S1.lda = 2048; S1.ldb = 1024; S1.mid = -1;
            pg8::EpiPlain E1{KWt, 4096, 256L * 4096};
            pg8::gemm_phase<pg8::EpiPlain, pg8::ProbKW, true, true>(ldsp, xch, S1, E1);
            pg8::ProbVW S2; S2.Wxo_t = Wxo_t; S2.XKV = XKV; S2.G = G; S2.c = bx; S2.K = 256; S2.lda = 1024; S2.ldb = 2048; S2.mid = -1;
            pg8::EpiPlain E2{VWt, 16384, 256L * 16384};
            pg8::gemm_phase<pg8::EpiPlain, pg8::ProbVW, true, true>(ldsp, xch, S2, E2);
        }
    }
    SEAM(3);

    PHASE(4) { REP_SYNC();
        pg8::ProbMN S = pg8::make_plain(MIX, Wout_t, TOK, 1024, 1024, G, bx);
        pg8::EpiRes<0> E{args.in[I_X], HB, SS};
        pg8::gemm_phase<pg8::EpiRes<0>, pg8::ProbMN, true, true>(ldsp, xch, S, E);
    }
    SEAM(4);

    PHASE(5) { REP_SYNC();
        pg8::ProbMN S; S.A = HB; S.B = KWt; S.nM = TOK / 256; S.nN = 4; S.G = G; S.c = bx; S.K = 1024; S.lda = 1024; S.ldb = 4096; S.mid = -1;
        S.a_pm = 256L * 1024; S.a_pn = 0; S.b_pb = 256L * 4096; S.b_pn = 1024;
        pg8::EpiSoftmax E{Pm, SS, XSCALE};
        pg8::gemm_phase<pg8::EpiSoftmax, pg8::ProbMN, true, true>(ldsp, xch, S, E);
    }
    SEAM(5);

    PHASE(6) { REP_SYNC();
        pg8::ProbMN S; S.A = Pm; S.B = VWt; S.nM = TOK / 256; S.nN = 4; S.G = G; S.c = bx; S.K = 1024; S.lda = 1024; S.ldb = 16384; S.mid = -1;
        S.a_pm = 256L * 1024; S.a_pn = 0; S.b_pb = 1024; S.b_pn = 256L * 16384;
        pg8::EpiRes<1> E{nullptr, HB, SS};
        pg8::gemm_phase<pg8::EpiRes<1>, pg8::ProbMN, true, true>(ldsp, xch, S, E);
    }
    SEAM(6);

    PHASE(7) { REP_SYNC();
        pg8::ProbMN S = pg8::make_plain(HB, Wff1_t, TOK, 4096, 1024, G, bx);
        pg8::EpiRowScale<1> E{SS, Fb, 4096, 1.0f};
        pg8::gemm_phase<pg8::EpiRowScale<1>, pg8::ProbMN, true, true>(ldsp, xch, S, E);
    }
    SEAM(7);

    PHASE(8) { REP_SYNC();
        pg8::ProbMN S = pg8::make_plain(Fb, Wff2_t, TOK, 1024, 4096, G, bx);
        pg8::EpiRes<1> E{nullptr, HB, SS};
        pg8::gemm_phase<pg8::EpiRes<1>, pg8::ProbMN, true, true>(ldsp, xch, S, E);
    }
    SEAM(8);

    PHASE(9) { REP_SYNC();
        const f32x4* gf = (const f32x4*)args.in[I_GFINAL];
        const f32x4 g0 = gf[2 * lane], g1 = gf[2 * lane + 1], g2 = gf[128 + 2 * lane], g3 = gf[128 + 2 * lane + 1];
        for (int m4 = gw; m4 < TOK / 4; m4 += NGW) { const int m = m4 * 4;
            v4u w0[4], w1[4]; float sp[4];
#pragma unroll
            for (int r = 0; r < 4; ++r) { const bf16* hr = HB + (size_t)(m + r) * DM + lane * 8; w0[r] = *(const v4u*)hr; w1[r] = *(const v4u*)(hr + 512); sp[r] = (lane < 16) ? SS[(size_t)(m + r) * 16 + lane] : 0.f; }
#pragma unroll
            for (int r = 0; r < 4; ++r) { const float rs = 1.0f / sqrtf(wave_sum(sp[r]) * (1.f / 1024.f) + EPS);
                f32x4* orow = (f32x4*)(OUT + (size_t)(m + r) * DM) + 2 * lane;
                orow[0] = (f32x4){pg8::bf_lo(w0[r].x), pg8::bf_hi(w0[r].x), pg8::bf_lo(w0[r].y), pg8::bf_hi(w0[r].y)} * rs * g0;
                orow[1] = (f32x4){pg8::bf_lo(w0[r].z), pg8::bf_hi(w0[r].z), pg8::bf_lo(w0[r].w), pg8::bf_hi(w0[r].w)} * rs * g1;
                orow[128] = (f32x4){pg8::bf_lo(w1[r].x), pg8::bf_hi(w1[r].x), pg8::bf_lo(w1[r].y), pg8::bf_hi(w1[r].y)} * rs * g2;
                orow[129] = (f32x4){pg8::bf_lo(w1[r].z), pg8::bf_hi(w1[r].z), pg8::bf_lo(w1[r].w), pg8::bf_hi(w1[r].w)} * rs * g3; }
        }
    }
    for (int e_ = 0; e_ < EXTRA_SYNCS; ++e_) xcd_barrier(bar);
#undef IN
#undef SEAM
#undef LOCAL_SEAM
}

extern "C" void kernel_launch(void* const* d_in, const int* in_sizes, int n_in, void* d_out, int out_size, void* d_ws, size_t ws_size, hipStream_t stream) {
    static int grid = 0;
    if (grid == 0) {
        if (n_in != 21 || in_sizes[0] != TOK * DM || out_size != TOK * DM || ws_size < WS_END) {
            fprintf(stderr, "kernel_launch: unexpected shapes: n_in %d in0 %d out %d ws %zu (need >= %zu)\n", n_in, n_in > 0 ? in_sizes[0] : -1, out_size, ws_size, (size_t)WS_END); grid = -1; return; }
        int dev = 0, cus = 0, per_cu = 0;
        if (hipGetDevice(&dev) != hipSuccess || hipDeviceGetAttribute(&cus, hipDeviceAttributeMultiprocessorCount, dev) != hipSuccess) { grid = -1; return; }
        if (hipFuncSetAttribute((const void*)mega_fwd, hipFuncAttributeMaxDynamicSharedMemorySize, LDS_BYTES) != hipSuccess) { fprintf(stderr, "kernel_launch: hipFuncSetAttribute failed\n"); grid = -1; return; }
        if (hipOccupancyMaxActiveBlocksPerMultiprocessor(&per_cu, (const void*)mega_fwd, NWAVES * 64, LDS_BYTES) != hipSuccess || per_cu < 1) { fprintf(stderr, "kernel_launch: occupancy query says %d\n", per_cu); per_cu = 1; }
        (void)hipGetLastError();
        grid = cus * per_cu;
    }
    if (grid < 0) return;
    if (hipMemsetAsync((char*)d_ws + WS_CTL, 0, CTL_ZERO_BYTES, stream) != hipSuccess) { fprintf(stderr, "kernel_launch: memset failed\n"); return; }
    Args a{};
    for (int i = 0; i < 21; ++i) a.in[i] = (const float*)d_in[i];
    a.out = (float*)d_out; a.ws = (unsigned char*)d_ws;
#if MK_PER_PHASE
    for (int p = 0; p < N_PHASES; ++p) { a.ph_lo = p; a.ph_hi = p + 1; hipLaunchKernelGGL(mega_fwd, dim3(grid), dim3(NWAVES * 64), LDS_BYTES, stream, a); }
#else
    a.ph_lo = 0; a.ph_hi = N_PHASES;
    void* kargs[] = {&a};
    hipError_t e = hipLaunchCooperativeKernel((const void*)mega_fwd, dim3(grid), dim3(NWAVES * 64), kargs, LDS_BYTES, stream);
    if (e != hipSuccess) fprintf(stderr, "kernel_launch: cooperative launch failed: %s (grid %d)\n", hipGetErrorString(e), grid);
#endif
}
```
